# Optimizing an MI355X kernel written in HIP

```python
import math
import jax
import jax.numpy as jnp
from jax import lax
import numpy as np

D_MODEL = 1024
BATCH = 8
SEQ = 8192
DEPTH = 2

CTX_LEN = 256
GRID_W = 64

S5_W = D_MODEL // 4
S5_GC = 16
S5_G = S5_W // S5_GC
S5_P = 64

MLA_H = D_MODEL // 128
MLA_NOPE = 64
MLA_ROPE = 32
MLA_V = 64
MLA_QR = D_MODEL // 4
MLA_KVR = D_MODEL // 8
MLA_W = MLA_H * MLA_V
MLA_SCALE = (MLA_NOPE + MLA_ROPE) ** -0.5
ROPE_AXIS = MLA_ROPE // 2
ROPE_BASE = 10000.0
Q_BLOCK = 128

ML_H = D_MODEL // 256
ML_D = 64
ML_W = ML_H * ML_D
ML_CHUNK = 64
ML_CONV = 3

MIX_W = S5_W + MLA_W + ML_W
IN_SIZES = (S5_W, MLA_QR, MLA_KVR, MLA_ROPE, ML_W, ML_W, ML_W, ML_W, 4 * ML_H)
N_IN = sum(IN_SIZES)

N_EXPERTS = 64
TOP_K = 8
N_EXPERT_GROUPS = 8
TOP_GROUPS = 4
EPG = N_EXPERTS // N_EXPERT_GROUPS
EXPERT_F = D_MODEL // 4
SHARED_F = D_MODEL // 4
ROUTED_SCALE = 2.5
ROUTE_BLOCK = 128

DEEPNORM_ALPHA = (2 * DEPTH) ** 0.25
DEEPNORM_BETA = (8 * DEPTH) ** -0.25
LN_EPS = 1e-5

kernel_name = 'hybrid_s5_mla_mlstm_moe_diffusion_trunk'


def _layer_norm(x, gain=None, bias=None):
    xf = x.astype(jnp.float32)
    mu = jnp.mean(xf, -1, keepdims=True)
    var = jnp.mean(jnp.square(xf - mu), -1, keepdims=True)
    y = (xf - mu) * lax.rsqrt(var + LN_EPS)
    if gain is not None:
        y = y * gain.astype(jnp.float32) + bias.astype(jnp.float32)
    return y.astype(x.dtype)


def _rms_norm(x, gain):
    xf = x.astype(jnp.float32)
    y = xf * lax.rsqrt(jnp.mean(xf * xf, -1, keepdims=True) + 1e-6) * gain.astype(jnp.float32)
    return y.astype(x.dtype)


def _split_cols(z):
    parts, off = [], 0
    for size in IN_SIZES:
        parts.append(z[..., off:off + size])
        off += size
    return parts


def _axial_angles(n_tokens):
    rows = n_tokens // GRID_W
    row_ids = jnp.repeat(jnp.arange(rows), GRID_W).astype(jnp.float32)
    col_ids = jnp.tile(jnp.arange(GRID_W), rows).astype(jnp.float32)
    half = ROPE_AXIS // 2
    inv_freq = ROPE_BASE ** (-jnp.arange(half, dtype=jnp.float32) / half)
    ang_r = row_ids[:, None] * inv_freq
    ang_c = col_ids[:, None] * inv_freq
    return jnp.cos(ang_r), jnp.sin(ang_r), jnp.cos(ang_c), jnp.sin(ang_c)


def _rot_half(v, cos, sin):
    v1, v2 = jnp.split(v, 2, axis=-1)
    return jnp.concatenate([v1 * cos - v2 * sin, v1 * sin + v2 * cos], axis=-1)


def _rope2d(v, cr, sr, cc, sc):
    vr, vc = jnp.split(v, 2, axis=-1)
    out = jnp.concatenate([_rot_half(vr, cr, sr), _rot_half(vc, cc, sc)], axis=-1)
    return out.astype(v.dtype)


def _linear_recurrence_combine(left, right):
    a_l, b_l = left
    a_r, b_r = right
    return a_r * a_l, a_r * b_l + b_r


def _s5_discretise(lam_re, lam_im, log_step, b_re, b_im, c_re, c_im):
    lam = lax.complex(lam_re.astype(jnp.float32), lam_im.astype(jnp.float32))
    step = jnp.exp(log_step.astype(jnp.float32))[..., None]
    a_bar = jnp.exp(lam * step)
    b_mat = lax.complex(b_re.astype(jnp.float32), b_im.astype(jnp.float32))
    b_bar = ((a_bar - 1.0) / lam)[..., None] * b_mat
    c_mat = lax.complex(c_re.astype(jnp.float32), c_im.astype(jnp.float32))
    return a_bar, b_bar, c_mat


def _s5_direction(ug, a_bar, b_bar, s0, reverse):
    bu = jnp.einsum('blgc,gpc->blgp', ug.astype(jnp.complex64), b_bar)
    if reverse:
        bu = bu[:, ::-1]
    bu = bu.at[:, 0].add(a_bar * s0)
    decay = jnp.broadcast_to(a_bar, (1,) + bu.shape[1:])
    _, states = lax.associative_scan(_linear_recurrence_combine, (decay, bu), axis=1)
    final = states[:, -1]
    if reverse:
        states = states[:, ::-1]
    return states, final


def _s5_readout(ug, st_f, st_b, c_mat, d_skip, glu_w, glu_b, dtype):
    y = (jnp.einsum('blgp,gcp->blgc', st_f, c_mat[0]).real
         + jnp.einsum('blgp,gcp->blgc', st_b, c_mat[1]).real
         + ug * d_skip.astype(jnp.float32).reshape(S5_G, S5_GC))
    y = y.reshape(y.shape[0], y.shape[1], S5_W)
    g = jax.nn.gelu(y)
    out = g * jax.nn.sigmoid(g @ glu_w.astype(jnp.float32) + glu_b.astype(jnp.float32))
    return out.astype(dtype)


def _s5_mixer(u_ctx, u_lat, lam_re, lam_im, log_step, b_re, b_im, c_re, c_im, d_skip, glu_w, glu_b, with_ctx_out):
    a_bar, b_bar, c_mat = _s5_discretise(lam_re, lam_im, log_step, b_re, b_im, c_re, c_im)
    bsz, n_ctx, _ = u_ctx.shape
    n_lat = u_lat.shape[1]
    zero = jnp.zeros((bsz, S5_G, S5_P), jnp.complex64)
    uc = u_ctx.astype(jnp.float32).reshape(bsz, n_ctx, S5_G, S5_GC)
    ul = u_lat.astype(jnp.float32).reshape(bsz, n_lat, S5_G, S5_GC)
    st_cf, fin_cf = _s5_direction(uc, a_bar[0], b_bar[0], zero, False)
    st_cb, fin_cb = _s5_direction(uc, a_bar[1], b_bar[1], zero, True)
    st_lf, _ = _s5_direction(ul, a_bar[0], b_bar[0], fin_cf, False)
    st_lb, _ = _s5_direction(ul, a_bar[1], b_bar[1], fin_cb, True)
    out_lat = _s5_readout(ul, st_lf, st_lb, c_mat, d_skip, glu_w, glu_b, u_lat.dtype)
    out_ctx = _s5_readout(uc, st_cf, st_cb, c_mat, d_skip, glu_w, glu_b, u_ctx.dtype) if with_ctx_out else None
    return out_lat, out_ctx


def _mla_queries(q_c, q_norm_g, w_q_up):
    q = _rms_norm(q_c, q_norm_g) @ w_q_up
    q = q.reshape(q.shape[0], q.shape[1], MLA_H, MLA_NOPE + MLA_ROPE)
    return q[..., :MLA_NOPE], q[..., MLA_NOPE:]


def _mla_keys_values(kv_c, kv_norm_g, w_kv_up):
    kv = _rms_norm(kv_c, kv_norm_g) @ w_kv_up
    kv = kv.reshape(kv.shape[0], kv.shape[1], MLA_H, MLA_NOPE + MLA_V)
    return kv[..., :MLA_NOPE], kv[..., MLA_NOPE:]


def _attend(q_nope, q_rope, k_nope, k_rope, v):
    s = (jnp.einsum('bqhd,bkhd->bhqk', q_nope, k_nope)
         + jnp.einsum('bqhr,bkr->bhqk', q_rope, k_rope))
    p = jax.nn.softmax(s.astype(jnp.float32) * MLA_SCALE, axis=-1).astype(v.dtype)
    return jnp.einsum('bhqk,bkhd->bqhd', p, v)


def _mla_mixer(qc_ctx, kvc_ctx, kr_ctx, qc_lat, kvc_lat, kr_lat, q_norm_g, w_q_up, kv_norm_g, w_kv_up, with_ctx_out):
    bsz, n_lat, _ = qc_lat.shape
    n_ctx = kvc_ctx.shape[1]
    cr, sr, cc, sc = _axial_angles(n_lat)
    kn_c, v_c = _mla_keys_values(kvc_ctx, kv_norm_g, w_kv_up)
    kn_l, v_l = _mla_keys_values(kvc_lat, kv_norm_g, w_kv_up)
    kr_l = _rope2d(kr_lat, cr, sr, cc, sc)
    qn_l, qr_l = _mla_queries(qc_lat, q_norm_g, w_q_up)
    qr_l = _rope2d(qr_l, cr[:, None], sr[:, None], cc[:, None], sc[:, None])
    k_nope = jnp.concatenate([kn_c, kn_l], axis=1)
    k_rope = jnp.concatenate([kr_ctx, kr_l], axis=1)
    v_all = jnp.concatenate([v_c, v_l], axis=1)
    n_blocks = n_lat // Q_BLOCK

    def to_blocks(t):
        return jnp.moveaxis(t.reshape(bsz, n_blocks, Q_BLOCK, *t.shape[2:]), 1, 0)

    o = lax.map(lambda qs: _attend(qs[0], qs[1], k_nope, k_rope, v_all), (to_blocks(qn_l), to_blocks(qr_l)))
    out_lat = jnp.moveaxis(o, 0, 1).reshape(bsz, n_lat, MLA_W)
    if with_ctx_out:
        qn_c, qr_c = _mla_queries(qc_ctx, q_norm_g, w_q_up)
        out_ctx = _attend(qn_c, qr_c, kn_c, kr_ctx, v_c).reshape(bsz, n_ctx, MLA_W)
    else:
        out_ctx = None
    return out_lat, out_ctx


def _centred_dwconv(x, w, b):
    n = x.shape[1]
    half = ML_CONV // 2
    xp = jnp.pad(x, ((0, 0), (half, half), (0, 0)))
    y = b
    for j in range(ML_CONV):
        y = y + xp[:, j:j + n] * w[j]
    return y


def _mlstm_inputs(q_in, k_in, v_in, g_in, conv_w, conv_b, gate_b):
    bsz, n, _ = q_in.shape
    qk = jax.nn.silu(_centred_dwconv(jnp.concatenate([q_in, k_in], -1), conv_w, conv_b).astype(jnp.float32))
    q = qk[..., :ML_W].reshape(bsz, n, ML_H, ML_D)
    k = qk[..., ML_W:].reshape(bsz, n, ML_H, ML_D) * (ML_D ** -0.5)
    v = v_in.astype(jnp.float32).reshape(bsz, n, ML_H, ML_D)
    g = (g_in.astype(jnp.float32) + gate_b.astype(jnp.float32).reshape(4 * ML_H)).reshape(bsz, n, 4, ML_H)
    fwd = (g[:, :, 0], jax.nn.log_sigmoid(g[:, :, 2]))
    bwd = (g[:, :, 1], jax.nn.log_sigmoid(g[:, :, 3]))
    return q, k, v, fwd, bwd


def _to_chunks(t):
    bsz, n = t.shape[:2]
    t = t.reshape(bsz, n // ML_CHUNK, ML_CHUNK, *t.shape[2:])
    return jnp.moveaxis(t, 3, 1)


def _mlstm_chunk_step(carry, inp):
    c_prev, n_prev, m_prev = carry
    c_loc, n_loc, m_loc, b_last = inp
    m_new = jnp.maximum(b_last + m_prev, m_loc)
    a = jnp.exp(b_last + m_prev - m_new)
    s = jnp.exp(m_loc - m_new)
    c_new = a[..., None, None] * c_prev + s[..., None, None] * c_loc
    n_new = a[..., None] * n_prev + s[..., None] * n_loc
    return (c_new, n_new, m_new), (c_prev, n_prev, m_prev)


def _mlstm_direction(q, k, v, log_i, log_f, state, reverse, with_out):
    if reverse:
        q, k, v, log_i, log_f = (t[:, ::-1] for t in (q, k, v, log_i, log_f))
    kc, vc, ic, fc = (_to_chunks(t) for t in (k, v, log_i, log_f))
    b = jnp.cumsum(fc, axis=-1)
    b_last = b[..., -1]
    w_end = b_last[..., None] - b + ic
    m_loc = jnp.max(w_end, axis=-1)
    e = jnp.exp(w_end - m_loc[..., None])
    c_loc = jnp.einsum('bhcs,bhcsd,bhcse->bhcde', e, vc, kc)
    n_loc = jnp.einsum('bhcs,bhcse->bhce', e, kc)
    final, incoming = lax.scan(_mlstm_chunk_step, state,
                               tuple(jnp.moveaxis(t, 2, 0) for t in (c_loc, n_loc, m_loc, b_last)))
    if not with_out:
        return None, final
    c_in, n_in, m_in = (jnp.moveaxis(t, 0, 2) for t in incoming)
    qc = _to_chunks(q)
    order = jnp.tril(jnp.ones((ML_CHUNK, ML_CHUNK), bool))
    log_d = jnp.where(order, b[..., :, None] - b[..., None, :] + ic[..., None, :], -jnp.inf)
    log_inter = b + m_in[..., None]
    m_t = jnp.maximum(log_inter, jnp.max(log_d, axis=-1))
    dw = jnp.exp(log_d - m_t[..., None])
    w_inter = jnp.exp(log_inter - m_t)
    s = jnp.einsum('bhctd,bhcsd->bhcts', qc, kc) * dw
    num = (jnp.einsum('bhcts,bhcsd->bhctd', s, vc)
           + w_inter[..., None] * jnp.einsum('bhcde,bhcte->bhctd', c_in, qc))
    den = jnp.sum(s, axis=-1) + w_inter * jnp.einsum('bhce,bhcte->bhct', n_in, qc)
    h = num / jnp.maximum(jnp.abs(den), jnp.exp(-m_t))[..., None]
    h = jnp.moveaxis(h, 1, 3).reshape(q.shape)
    if reverse:
        h = h[:, ::-1]
    return h, final


def _mlstm_output(h_f, h_b, o_in, norm_g, dtype):
    bsz, n = o_in.shape[:2]
    h = jax.nn.sigmoid(o_in.astype(jnp.float32)).reshape(bsz, n, ML_H, ML_D) * (h_f + h_b)
    mu = jnp.mean(h, -1, keepdims=True)
    var = jnp.mean(jnp.square(h - mu), -1, keepdims=True)
    h = ((h - mu) * lax.rsqrt(var + LN_EPS)).reshape(bsz, n, ML_W) * norm_g.astype(jnp.float32)
    return h.astype(dtype)


def _mlstm_mixer(parts_ctx, parts_lat, conv_w, conv_b, gate_b, norm_g, with_ctx_out):
    qc, kc, vc, g_fc, g_bc = _mlstm_inputs(parts_ctx[0], parts_ctx[1], parts_ctx[2], parts_ctx[4], conv_w, conv_b, gate_b)
    ql, kl, vl, g_fl, g_bl = _mlstm_inputs(parts_lat[0], parts_lat[1], parts_lat[2], parts_lat[4], conv_w, conv_b, gate_b)
    bsz = ql.shape[0]
    zero = (jnp.zeros((bsz, ML_H, ML_D, ML_D), jnp.float32),
            jnp.zeros((bsz, ML_H, ML_D), jnp.float32),
            jnp.zeros((bsz, ML_H), jnp.float32))
    h_cf, st_f = _mlstm_direction(qc, kc, vc, g_fc[0], g_fc[1], zero, False, with_ctx_out)
    h_cb, st_b = _mlstm_direction(qc, kc, vc, g_bc[0], g_bc[1], zero, True, with_ctx_out)
    h_lf, _ = _mlstm_direction(ql, kl, vl, g_fl[0], g_fl[1], st_f, False, True)
    h_lb, _ = _mlstm_direction(ql, kl, vl, g_bl[0], g_bl[1], st_b, True, True)
    out_lat = _mlstm_output(h_lf, h_lb, parts_lat[3], norm_g, parts_lat[3].dtype)
    out_ctx = _mlstm_output(h_cf, h_cb, parts_ctx[3], norm_g, parts_ctx[3].dtype) if with_ctx_out else None
    return out_lat, out_ctx


def _moe(h, router_w, router_bias, w_gate, w_up, w_down, sw_gate, sw_up, sw_down):
    n_tok = h.shape[0]
    scores = jax.nn.sigmoid((h @ router_w).astype(jnp.float32))
    biased = scores + router_bias.astype(jnp.float32)
    group_score = jnp.sum(lax.top_k(biased.reshape(n_tok, N_EXPERT_GROUPS, EPG), 2)[0], -1)
    kth = lax.top_k(group_score, TOP_GROUPS)[0][:, -1:]
    allowed = jnp.repeat(group_score >= kth, EPG, axis=1)
    _, top_e = lax.top_k(jnp.where(allowed, biased, -jnp.inf), TOP_K)
    gate = jnp.take_along_axis(scores, top_e, axis=1)
    gate = gate / jnp.sum(gate, -1, keepdims=True) * ROUTED_SCALE
    n_assign = n_tok * TOP_K
    e_flat = top_e.reshape(n_assign)
    tok_flat = jnp.repeat(jnp.arange(n_tok, dtype=jnp.int32), TOP_K)
    g_flat = gate.reshape(n_assign).astype(h.dtype)
    order = jnp.argsort(e_flat)
    e_sorted = e_flat[order]
    counts = jnp.bincount(e_flat, length=N_EXPERTS)
    starts = jnp.cumsum(counts) - counts
    padded = (counts + ROUTE_BLOCK - 1) // ROUTE_BLOCK * ROUTE_BLOCK
    pad_end = jnp.cumsum(padded)
    pad_start = pad_end - padded
    dest = pad_start[e_sorted] + jnp.arange(n_assign) - starts[e_sorted]
    n_rows = -(-(n_assign + N_EXPERTS * (ROUTE_BLOCK - 1)) // ROUTE_BLOCK) * ROUTE_BLOCK
    n_blocks = n_rows // ROUTE_BLOCK
    tok_rows = jnp.zeros((n_rows,), jnp.int32).at[dest].set(tok_flat[order])
    gate_rows = jnp.zeros((n_rows,), h.dtype).at[dest].set(g_flat[order])
    blk_expert = jnp.minimum(jnp.searchsorted(pad_end, jnp.arange(n_blocks) * ROUTE_BLOCK, side='right'), N_EXPERTS - 1)

    def expert_block(acc, blk):
        tok, g, e = blk
        xb = h[tok]
        ob = (jax.nn.silu(xb @ w_gate[e]) * (xb @ w_up[e])) @ w_down[e]
        return acc.at[tok].add(ob * g[:, None]), None

    routed, _ = lax.scan(expert_block, jnp.zeros_like(h),
                         (tok_rows.reshape(n_blocks, ROUTE_BLOCK), gate_rows.reshape(n_blocks, ROUTE_BLOCK), blk_expert))
    shared = (jax.nn.silu(h @ sw_gate) * (h @ sw_up)) @ sw_down
    return routed + shared


def setup_inputs(seed: int = 0) -> dict:
    key = jax.random.key(seed)
    ks = iter(jax.random.split(key, 48))
    f32 = jnp.float32
    L = DEPTH
    D = D_MODEL

    def nrm(shape, scale):
        return jax.random.normal(next(ks), shape, f32) * scale

    x = nrm((BATCH, SEQ, D), 1.0)
    c = nrm((BATCH, D), 1.0)
    ctx = nrm((BATCH, CTX_LEN, D), 1.0)
    c_ctx = nrm((D,), 1.0)
    ada_w = nrm((L, D, 6 * D), 0.5 * D ** -0.5)
    ada_b = nrm((L, 6 * D), 0.01)
    w_in = nrm((L, D, N_IN), D ** -0.5)
    s5_lambda_re = -0.5 + nrm((L, 2, S5_G, S5_P), 0.01)
    s5_lambda_im = math.pi * jnp.arange(S5_P, dtype=f32) + nrm((L, 2, S5_G, S5_P), 0.01)
    s5_log_step = jax.random.uniform(next(ks), (L, 2, S5_G), f32, math.log(1e-3), math.log(1e-1))
    s5_b_re = nrm((L, 2, S5_G, S5_P, S5_GC), (2 * S5_GC) ** -0.5)
    s5_b_im = nrm((L, 2, S5_G, S5_P, S5_GC), (2 * S5_GC) ** -0.5)
    s5_c_re = nrm((L, 2, S5_G, S5_GC, S5_P), (2 * S5_P) ** -0.5)
    s5_c_im = nrm((L, 2, S5_G, S5_GC, S5_P), (2 * S5_P) ** -0.5)
    s5_d = nrm((L, S5_W), 1.0)
    s5_glu_w = nrm((L, S5_W, S5_W), S5_W ** -0.5)
    s5_glu_b = nrm((L, S5_W), 0.01)
    mla_q_norm = 1.0 + nrm((L, MLA_QR), 0.01)
    mla_w_q_up = nrm((L, MLA_QR, MLA_H * (MLA_NOPE + MLA_ROPE)), MLA_QR ** -0.5)
    mla_kv_norm = 1.0 + nrm((L, MLA_KVR), 0.01)
    mla_w_kv_up = nrm((L, MLA_KVR, MLA_H * (MLA_NOPE + MLA_V)), MLA_KVR ** -0.5)
    ml_conv_w = nrm((L, ML_CONV, 2 * ML_W), ML_CONV ** -0.5)
    ml_conv_b = nrm((L, 2 * ML_W), 0.01)
    ml_i_bias = nrm((L, 2, ML_H), 0.1)
    ml_f_bias = jnp.linspace(3.0, 6.0, ML_H, dtype=f32) + nrm((L, 2, ML_H), 0.1)
    ml_gate_b = jnp.concatenate([ml_i_bias, ml_f_bias], axis=1)
    ml_norm_g = 1.0 + nrm((L, ML_W), 0.01)
    w_out = nrm((L, MIX_W, D), MIX_W ** -0.5 * DEEPNORM_BETA)
    ln1_g = 1.0 + nrm((L, D), 0.01)
    ln1_b = nrm((L, D), 0.01)
    ln2_g = 1.0 + nrm((L, D), 0.01)
    ln2_b = nrm((L, D), 0.01)
    router_w = nrm((L, D, N_EXPERTS), D ** -0.5)
    router_bias = nrm((L, N_EXPERTS), 0.01)
    exp_w_gate = nrm((L, N_EXPERTS, D, EXPERT_F), D ** -0.5)
    exp_w_up = nrm((L, N_EXPERTS, D, EXPERT_F), D ** -0.5)
    exp_w_down = nrm((L, N_EXPERTS, EXPERT_F, D), EXPERT_F ** -0.5 * DEEPNORM_BETA)
    sh_w_gate = nrm((L, D, SHARED_F), D ** -0.5)
    sh_w_up = nrm((L, D, SHARED_F), D ** -0.5)
    sh_w_down = nrm((L, SHARED_F, D), SHARED_F ** -0.5 * DEEPNORM_BETA)
    return {'x': x, 'c': c, 'ctx': ctx, 'c_ctx': c_ctx, 'ada_w': ada_w, 'ada_b': ada_b, 'w_in': w_in,
            's5_lambda_re': s5_lambda_re, 's5_lambda_im': s5_lambda_im, 's5_log_step': s5_log_step,
            's5_b_re': s5_b_re, 's5_b_im': s5_b_im, 's5_c_re': s5_c_re, 's5_c_im': s5_c_im, 's5_d': s5_d,
            's5_glu_w': s5_glu_w, 's5_glu_b': s5_glu_b, 'mla_q_norm': mla_q_norm, 'mla_w_q_up': mla_w_q_up,
            'mla_kv_norm': mla_kv_norm, 'mla_w_kv_up': mla_w_kv_up, 'ml_conv_w': ml_conv_w, 'ml_conv_b': ml_conv_b,
            'ml_gate_b': ml_gate_b, 'ml_norm_g': ml_norm_g, 'w_out': w_out, 'ln1_g': ln1_g, 'ln1_b': ln1_b,
            'ln2_g': ln2_g, 'ln2_b': ln2_b, 'router_w': router_w, 'router_bias': router_bias,
            'exp_w_gate': exp_w_gate, 'exp_w_up': exp_w_up, 'exp_w_down': exp_w_down,
            'sh_w_gate': sh_w_gate, 'sh_w_up': sh_w_up, 'sh_w_down': sh_w_down}


def reference(x, c, ctx, c_ctx, ada_w, ada_b, w_in, s5_lambda_re, s5_lambda_im, s5_log_step, s5_b_re, s5_b_im,
              s5_c_re, s5_c_im, s5_d, s5_glu_w, s5_glu_b, mla_q_norm, mla_w_q_up, mla_kv_norm, mla_w_kv_up,
              ml_conv_w, ml_conv_b, ml_gate_b, ml_norm_g, w_out, ln1_g, ln1_b, ln2_g, ln2_b, router_w, router_bias,
              exp_w_gate, exp_w_up, exp_w_down, sh_w_gate, sh_w_up, sh_w_down):
    x_lat, x_ctx = x, ctx
    d = x.shape[-1]
    n_lat_tok = x.shape[0] * x.shape[1]
    for layer in range(DEPTH):
        last = layer == DEPTH - 1
        mod_lat = jax.nn.silu(c) @ ada_w[layer] + ada_b[layer]
        mod_ctx = jax.nn.silu(c_ctx) @ ada_w[layer] + ada_b[layer]
        sh1, sc1, g1, sh2, sc2, g2 = jnp.split(mod_lat[:, None, :], 6, axis=-1)
        csh1, csc1, cg1, csh2, csc2, cg2 = jnp.split(mod_ctx, 6, axis=-1)

        h_lat = _layer_norm(x_lat) * (1 + sc1) + sh1
        h_ctx = _layer_norm(x_ctx) * (1 + csc1) + csh1
        z_lat = _split_cols(h_lat @ w_in[layer])
        z_ctx = _split_cols(h_ctx @ w_in[layer])
        s5_lat, s5_ctx = _s5_mixer(z_ctx[0], z_lat[0], s5_lambda_re[layer], s5_lambda_im[layer], s5_log_step[layer],
                                   s5_b_re[layer], s5_b_im[layer], s5_c_re[layer], s5_c_im[layer], s5_d[layer],
                                   s5_glu_w[layer], s5_glu_b[layer], not last)
        mla_lat, mla_ctx = _mla_mixer(z_ctx[1], z_ctx[2], z_ctx[3], z_lat[1], z_lat[2], z_lat[3],
                                      mla_q_norm[layer], mla_w_q_up[layer], mla_kv_norm[layer], mla_w_kv_up[layer],
                                      not last)
        ml_lat, ml_ctx = _mlstm_mixer(z_ctx[4:9], z_lat[4:9], ml_conv_w[layer], ml_conv_b[layer], ml_gate_b[layer],
                                      ml_norm_g[layer], not last)
        y_lat = jnp.concatenate([s5_lat, mla_lat, ml_lat], axis=-1) @ w_out[layer]
        x_lat = _layer_norm(DEEPNORM_ALPHA * x_lat + g1 * y_lat, ln1_g[layer], ln1_b[layer])

        f_lat = _layer_norm(x_lat) * (1 + sc2) + sh2
        if last:
            ffn_lat = _moe(f_lat.reshape(-1, d), router_w[layer], router_bias[layer], exp_w_gate[layer],
                           exp_w_up[layer], exp_w_down[layer], sh_w_gate[layer], sh_w_up[layer],
                           sh_w_down[layer]).reshape(x_lat.shape)
        else:
            y_ctx = jnp.concatenate([s5_ctx, mla_ctx, ml_ctx], axis=-1) @ w_out[layer]
            x_ctx = _layer_norm(DEEPNORM_ALPHA * x_ctx + cg1 * y_ctx, ln1_g[layer], ln1_b[layer])
            f_ctx = _layer_norm(x_ctx) * (1 + csc2) + csh2
            tokens = jnp.concatenate([f_lat.reshape(-1, d), f_ctx.reshape(-1, d)], axis=0)
            ffn = _moe(tokens, router_w[layer], router_bias[layer], exp_w_gate[layer], exp_w_up[layer],
                       exp_w_down[layer], sh_w_gate[layer], sh_w_up[layer], sh_w_down[layer])
            ffn_lat = ffn[:n_lat_tok].reshape(x_lat.shape)
            ffn_ctx = ffn[n_lat_tok:].reshape(x_ctx.shape)
            x_ctx = _layer_norm(DEEPNORM_ALPHA * x_ctx + cg2 * ffn_ctx, ln2_g[layer], ln2_b[layer])
        x_lat = _layer_norm(DEEPNORM_ALPHA * x_lat + g2 * ffn_lat, ln2_g[layer], ln2_b[layer])
    return x_lat
```

```cpp
#include <hip/hip_runtime.h>
#include <stdint.h>
#include <string.h>
#include <stdio.h>

#define DM 1024
#define NB 8
#define SEQL 8192
#define CTXL 256
#define SQ 8448
#define NTOK (NB * SQ)
#define NCH 132
#define NROW (NB * NCH)
#define NROWP 1152
#define NIN 1712
#define NINP 1792
#define ZW 1440
#define Z_QC 0
#define Z_KVC 256
#define Z_KR 384
#define Z_MLQ 416
#define Z_MLV 928
#define Z_MLO 1184
#define NUNIT (NB * 4 * 2 * NCH)
#define CLOC_STRIDE (65 * 64)
#define MOE_BM 128
#define MOE_TILES 722
#define MOE_SLOTS (MOE_TILES * MOE_BM)
#define UPU_STRIDE 384
#define ALPHA_DN 1.41421356237f
#define LN_EPS 1e-5f
#define QSCALE (0.10206207261596577f * 1.4426950408889634f)
#define LOG2E 1.4426950408889634f

typedef unsigned short bf16;
typedef short bf16x8 __attribute__((ext_vector_type(8)));
typedef float f32x16 __attribute__((ext_vector_type(16)));
typedef float f32x4 __attribute__((ext_vector_type(4)));
typedef unsigned u32x4 __attribute__((ext_vector_type(4)));
typedef unsigned u32x2 __attribute__((ext_vector_type(2)));

#define MFMA32(a, b, c) __builtin_amdgcn_mfma_f32_32x32x16_bf16((a), (b), (c), 0, 0, 0)
__device__ __forceinline__ int otid() { int t = (int)threadIdx.x; asm volatile("" : "+v"(t)); return t; }

typedef __bf16 bf2_t __attribute__((ext_vector_type(2)));
typedef float f2_t __attribute__((ext_vector_type(2)));
__device__ __forceinline__ unsigned pk2(float lo, float hi) { f2_t v = {lo, hi}; bf2_t b = __builtin_convertvector(v, bf2_t); return __builtin_bit_cast(unsigned, b); }
__device__ __forceinline__ bf16 f2bf(float x) { return (bf16)(pk2(x, 0.f) & 0xffffu); }
__device__ __forceinline__ float bf2f(bf16 x) { return __uint_as_float(((unsigned)x) << 16); }
__device__ __forceinline__ float bflo(unsigned u) { return __uint_as_float(u << 16); }
__device__ __forceinline__ float bfhi(unsigned u) { return __uint_as_float(u & 0xffff0000u); }
__device__ __forceinline__ float fexp2(float x) { return __builtin_amdgcn_exp2f(x); }
__device__ __forceinline__ float fexp(float x) { return __builtin_amdgcn_exp2f(x * LOG2E); }
__device__ __forceinline__ float frcp(float x) { return __builtin_amdgcn_rcpf(x); }
__device__ __forceinline__ float sigmoidf_(float x) { return frcp(1.f + fexp(-x)); }
__device__ __forceinline__ float siluf_(float x) { return x * sigmoidf_(x); }
__device__ __forceinline__ float gelu_tanh(float x) {
    const float u = 0.7978845608028654f * (x + 0.044715f * x * x * x);
    const float t = 1.f - 2.f * frcp(fexp(2.f * u) + 1.f);
    return 0.5f * x * (1.f + t);
}
template <int CTRL, int RM> __device__ __forceinline__ float dppf(float ident, float v) {
    return __int_as_float(__builtin_amdgcn_update_dpp(__float_as_int(ident), __float_as_int(v), CTRL, RM, 0xf, false));
}
template <int CTRL, int RM> __device__ __forceinline__ int dppi(int ident, int v) { return __builtin_amdgcn_update_dpp(ident, v, CTRL, RM, 0xf, false); }
__device__ __forceinline__ float dpp_scan_sum(float v) {
    v += dppf<0x111, 0xf>(0.f, v); v += dppf<0x112, 0xf>(0.f, v); v += dppf<0x114, 0xf>(0.f, v); v += dppf<0x118, 0xf>(0.f, v);
    v += dppf<0x142, 0xa>(0.f, v); v += dppf<0x143, 0xc>(0.f, v);
    return v;
}
__device__ __forceinline__ float dpp_scan_max(float v) {
    const float NI = -__builtin_inff();
    v = fmaxf(v, dppf<0x111, 0xf>(NI, v)); v = fmaxf(v, dppf<0x112, 0xf>(NI, v)); v = fmaxf(v, dppf<0x114, 0xf>(NI, v)); v = fmaxf(v, dppf<0x118, 0xf>(NI, v));
    v = fmaxf(v, dppf<0x142, 0xa>(NI, v)); v = fmaxf(v, dppf<0x143, 0xc>(NI, v));
    return v;
}
__device__ __forceinline__ float readlane_f(float v, int l) { return __int_as_float(__builtin_amdgcn_readlane(__float_as_int(v), l)); }
__device__ __forceinline__ float wave_sum(float v) { return readlane_f(dpp_scan_sum(v), 63); }
__device__ __forceinline__ float wave_max(float v) { return readlane_f(dpp_scan_max(v), 63); }

#define XB_TMO      128
#define XB_XCNT(j)  (256  + 64 * (j))
#define XB_XSUB(j)  (1280 + 64 * (j))
#define XB_XGEN(j)  (2304 + 64 * (j))
#define XB_TOP      3328
#define XB_TOPGEN   3392
#define XCD_BAR_WORDS 3456
#define XB_SPIN_CAP (1u << 21)
#define LAS __attribute__((address_space(3)))

__device__ __forceinline__ unsigned xb_ld(unsigned* p)              { return __hip_atomic_load(p, __ATOMIC_RELAXED, __HIP_MEMORY_SCOPE_AGENT); }
__device__ __forceinline__ unsigned xb_add(unsigned* p, unsigned v) { return __hip_atomic_fetch_add(p, v, __ATOMIC_RELAXED, __HIP_MEMORY_SCOPE_AGENT); }
__device__ __forceinline__ unsigned xb_xcc_id() { return (unsigned)__builtin_amdgcn_s_getreg((3 << 11) | 20) & 0xFu; }
#define XB_SPIN(cond, bar) do { unsigned _sp = 0; while (cond) { __builtin_amdgcn_s_sleep(1); \
    if ((++_sp & 255u) == 0u) { if (xb_ld(&(bar)[XB_TMO])) break; if (_sp > XB_SPIN_CAP) { atomicAdd(&(bar)[XB_TMO], 1u); break; } } } } while (0)

struct XcdBarrier { unsigned* bar; unsigned x; volatile LAS unsigned* st; };

__device__ __forceinline__ XcdBarrier xcd_barrier_post(unsigned* bar, volatile LAS unsigned* st) {
    XcdBarrier b; b.bar = bar; b.x = xb_xcc_id(); b.st = st;
    if (threadIdx.x == 0) (void)xb_add(&bar[XB_XCNT(b.x)], 1u);
    return b;
}
__device__ __forceinline__ void xcd_barrier_complete(unsigned* bar, unsigned x, unsigned& nloc, unsigned& nx) {
    const unsigned G = gridDim.x * gridDim.y * gridDim.z;
    unsigned sum, cnt, mine, sp = 0u;
    for (;;) {
        sum = 0u; cnt = 0u; mine = 0u;
#pragma unroll
        for (unsigned j = 0; j < 16; ++j) { const unsigned c = xb_ld(&bar[XB_XCNT(j)]); sum += c; cnt += (c > 0u) ? 1u : 0u; mine = (j == x) ? c : mine; }
        if (sum == G) break;
        __builtin_amdgcn_s_sleep(1);
        if ((++sp & 255u) == 0u) { if (xb_ld(&bar[XB_TMO])) break; if (sp > XB_SPIN_CAP) { atomicAdd(&bar[XB_TMO], 1u); break; } }
    }
    nloc = mine > 0u ? mine : 1u; nx = cnt > 0u ? cnt : 1u;
}
__device__ __forceinline__ void xcd_barrier(const XcdBarrier& b) {
    asm volatile("s_waitcnt vmcnt(0)" ::: "memory");
    __syncthreads();
    if (threadIdx.x == 0) {
        unsigned* bar = b.bar;
        __builtin_amdgcn_s_waitcnt(0);
        const unsigned bx = xb_xcc_id();
        unsigned nloc = b.st[0], nx = b.st[1];
        if (nloc == 0u) { xcd_barrier_complete(bar, bx, nloc, nx); b.st[0] = nloc; b.st[1] = nx; }
        const unsigned old = xb_add(&bar[XB_XSUB(bx)], 1u);
        const unsigned gen = old / nloc;
        if (old + 1u == (gen + 1u) * nloc) {
            __builtin_amdgcn_fence(__ATOMIC_RELEASE, "agent");
            asm volatile("s_waitcnt vmcnt(0)" ::: "memory");
            const unsigned og = xb_add(&bar[XB_TOP], 1u);
            const unsigned tg = og / nx;
            if (og + 1u == (tg + 1u) * nx) xb_add(&bar[XB_TOPGEN], 1u);
            else XB_SPIN(xb_ld(&bar[XB_TOPGEN]) == tg, bar);
            __builtin_amdgcn_fence(__ATOMIC_ACQUIRE, "agent");
            xb_add(&bar[XB_XGEN(bx)], 1u);
            asm volatile("s_waitcnt vmcnt(0)" ::: "memory");
        } else {
            XB_SPIN(xb_ld(&bar[XB_XGEN(bx)]) == gen, bar);
            __builtin_amdgcn_fence(__ATOMIC_ACQUIRE, "agent");
            asm volatile("s_waitcnt vmcnt(0)" ::: "memory");
        }
    }
    __syncthreads();
}

struct Params {
    const float *x, *c, *ctx, *c_ctx, *ada_w, *ada_b, *w_in, *lam_re, *lam_im, *log_step, *b_re, *b_im, *c_re, *c_im, *s5_d, *glu_w, *glu_b;
    const float *q_norm, *w_q_up, *kv_norm, *w_kv_up, *conv_w, *conv_b, *gate_b, *ml_norm_g, *w_out, *ln1_g, *ln1_b, *ln2_g, *ln2_b;
    const float *router_w, *router_bias, *ew_gate, *ew_up, *ew_down, *sw_gate, *sw_up, *sw_down;
    float* out;
    unsigned* bar; unsigned* ctr; int* moe_cnt;
    float *modv, *rope_tab, *klag, *pw, *bbar, *ctxres, *gates, *rq, *rkv, *mlstat;
    bf16 *bt_in, *bt_q, *bt_kv, *bt_glu, *bt_out, *bt_rhi, *bt_rlo, *bt_up, *bt_dn;
    bf16 *wg, *eg, *gg;
    bf16 *h;
    bf16 *qkc, *cloc;
    bf16 *z;
    bf16 *cat;
    bf16 *ug, *sin_; float* ff; bf16* gs;
    float* logits; int *tope, *pos, *tokslot, *slottok, *tile_e, *ntb, *xl_tile, *xl_cnt, *up_e, *up_row, *up_n; float *gatew, *slotgate;
    bf16 *q, *kf, *vt;
    bf16 *hc, *yc, *hc1, *yc1;
};

template <class F>
__device__ __forceinline__ void run_items(unsigned* ctr, int total, int* s_item, F&& f) {
    for (;;) {
        __syncthreads();
        if (threadIdx.x == 0) *s_item = (int)atomicAdd(ctr, 1u);
        __syncthreads();
        const int it = *s_item;
        if (it >= total) break;
        f(it);
    }
}

#define XL_STRIDE 672
template <class F>
__device__ __forceinline__ void run_items_xcd(unsigned* ctr8, const int* cnt8, int mult, int myx, int* s_item, F&& f) {
    for (int k = 0; k < 8; ++k) {
        const int x = (myx + k) & 7;
        const int total = cnt8[x] * mult;
        for (;;) {
            __syncthreads();
            if (threadIdx.x == 0) *s_item = (int)atomicAdd(ctr8 + x, 1u);
            __syncthreads();
            const int it = *s_item;
            if (it >= total) break;
            f(x, it);
        }
    }
}

struct Seg { const bf16* A; const bf16* B; int lda, ldb, K; };
#define GEMM_ROWB 144
#define STG_ROWB 144

template <int BM, int NSEG, int BN = 128, class Epi>
__device__ __forceinline__ void gemm_tile(const Seg (&seg)[NSEG], const int* __restrict__ rowidx, int m0, int n0, const Epi& epi, char* smem) {
    constexpr int AI = BM / 64, BI = BN / 64, WNW = BN / 64, WMW = 8 / WNW, WM = BM / WMW, MI = WM / 32;
    constexpr int BUFB = (BM + BN) * GEMM_ROWB;
    const int tid = otid(), lane = tid & 63, wave = tid >> 6;
    const int kc = tid & 7, r0 = tid >> 3;
    const int wm = wave / WNW, wn = wave % WNW;
    int arow[AI];
#pragma unroll
    for (int i = 0; i < AI; ++i) { const int r = m0 + r0 + 64 * i; arow[i] = rowidx ? rowidx[r] : r; }
    int total = 0;
#pragma unroll
    for (int s = 0; s < NSEG; ++s) total += seg[s].K >> 6;
    u32x4 ra0[AI], rb0[BI], ra1[AI], rb1[BI];
    const bf16* cA = seg[0].A; const bf16* cB = seg[0].B; int clda = seg[0].lda, cldb = seg[0].ldb, cnk = seg[0].K >> 6, ckt = 0, cs = 0;
    auto gload = [&](u32x4 (&ra)[AI], u32x4 (&rb)[BI]) {
        const int ko = ckt * 64 + kc * 8;
#pragma unroll
        for (int i = 0; i < AI; ++i) ra[i] = *(const u32x4*)(cA + (size_t)arow[i] * clda + ko);
#pragma unroll
        for (int i = 0; i < BI; ++i) rb[i] = *(const u32x4*)(cB + (size_t)(n0 + r0 + 64 * i) * cldb + ko);
        ++ckt;
        if (ckt == cnk) {
            ++cs; ckt = 0;
            if (NSEG > 1 && cs == 1) { cA = seg[NSEG > 1 ? 1 : 0].A; cB = seg[NSEG > 1 ? 1 : 0].B; clda = seg[NSEG > 1 ? 1 : 0].lda; cldb = seg[NSEG > 1 ? 1 : 0].ldb; cnk = seg[NSEG > 1 ? 1 : 0].K >> 6; }
            if (NSEG > 2 && cs == 2) { cA = seg[NSEG > 2 ? 2 : 0].A; cB = seg[NSEG > 2 ? 2 : 0].B; clda = seg[NSEG > 2 ? 2 : 0].lda; cldb = seg[NSEG > 2 ? 2 : 0].ldb; cnk = seg[NSEG > 2 ? 2 : 0].K >> 6; }
        }
    };
    auto lstore = [&](int buf, const u32x4 (&ra)[AI], const u32x4 (&rb)[BI]) {
        char* base = smem + buf * BUFB;
#pragma unroll
        for (int i = 0; i < AI; ++i) *(u32x4*)(base + (r0 + 64 * i) * GEMM_ROWB + kc * 16) = ra[i];
#pragma unroll
        for (int i = 0; i < BI; ++i) *(u32x4*)(base + (BM + r0 + 64 * i) * GEMM_ROWB + kc * 16) = rb[i];
    };
    f32x16 acc[MI][2];
#pragma unroll
    for (int i = 0; i < MI; ++i)
#pragma unroll
        for (int j = 0; j < 2; ++j)
#pragma unroll
            for (int q = 0; q < 16; ++q) acc[i][j][q] = 0.f;
    auto compute = [&](int buf) {
        const char* base = smem + buf * BUFB;
        const char* pa = base + (wm * WM + (lane & 31)) * GEMM_ROWB + (lane >> 5) * 16;
        const char* pb = base + (BM + wn * 64 + (lane & 31)) * GEMM_ROWB + (lane >> 5) * 16;
#pragma unroll
        for (int ks = 0; ks < 4; ++ks) {
            bf16x8 af[MI], bfr[2];
#pragma unroll
            for (int i = 0; i < MI; ++i) af[i] = *(const bf16x8*)(pa + i * 32 * GEMM_ROWB + ks * 32);
#pragma unroll
            for (int j = 0; j < 2; ++j) bfr[j] = *(const bf16x8*)(pb + j * 32 * GEMM_ROWB + ks * 32);
#pragma unroll
            for (int i = 0; i < MI; ++i)
#pragma unroll
                for (int j = 0; j < 2; ++j) acc[i][j] = MFMA32(bfr[j], af[i], acc[i][j]);
        }
    };
    gload(ra0, rb0);
    if (total > 1) gload(ra1, rb1);
    __syncthreads();
    lstore(0, ra0, rb0);
    if (total > 2) gload(ra0, rb0);
    __syncthreads();
    for (int t = 0; t < total; t += 2) {
        compute(0);
        if (t + 1 < total) lstore(1, ra1, rb1);
        if (t + 3 < total) gload(ra1, rb1);
        __syncthreads();
        if (t + 1 >= total) break;
        compute(1);
        if (t + 2 < total) lstore(0, ra0, rb0);
        if (t + 4 < total) gload(ra0, rb0);
        __syncthreads();
    }
    epi.template run<MI>(acc, m0 + wm * WM, n0 + wn * 64, lane);
}

#define ASTAT_SLAB (128 * GEMM_ROWB)
template <int KT, class Epi>
__device__ __forceinline__ void gemm_astat(const bf16* A, int lda, const int* __restrict__ rowidx, int m0, const bf16* B, int ldb, int NT, const Epi& epi, char* smem) {
    const int tid = otid(), lane = tid & 63, wave = tid >> 6;
    const int kc = tid & 7, r0 = tid >> 3;
    const int wm = wave >> 1, wn = wave & 1;
    char* sA = smem; char* sB = smem + KT * ASTAT_SLAB;
    {
        u32x4 ra[KT][2];
#pragma unroll
        for (int i = 0; i < 2; ++i) {
            const int r = m0 + r0 + 64 * i; const int gr = rowidx ? rowidx[r] : r;
#pragma unroll
            for (int kt = 0; kt < KT; ++kt) ra[kt][i] = *(const u32x4*)(A + (size_t)gr * lda + kt * 64 + kc * 8);
        }
        __syncthreads();
#pragma unroll
        for (int kt = 0; kt < KT; ++kt)
#pragma unroll
            for (int i = 0; i < 2; ++i) *(u32x4*)(sA + kt * ASTAT_SLAB + (r0 + 64 * i) * GEMM_ROWB + kc * 16) = ra[kt][i];
    }
    const int total = NT * KT;
    int gq = 0;
    constexpr int D = 4;
    u32x4 rb[D][2];
    auto gload = [&](u32x4 (&r)[2]) {
        const int nt = gq / KT, kt = gq - nt * KT;
#pragma unroll
        for (int i = 0; i < 2; ++i) r[i] = *(const u32x4*)(B + (size_t)(nt * 128 + r0 + 64 * i) * ldb + kt * 64 + kc * 8);
        ++gq;
    };
    auto lstore = [&](int buf, const u32x4 (&r)[2]) {
#pragma unroll
        for (int i = 0; i < 2; ++i) *(u32x4*)(sB + buf * ASTAT_SLAB + (r0 + 64 * i) * GEMM_ROWB + kc * 16) = r[i];
    };
    f32x16 acc[1][2];
#pragma unroll
    for (int j = 0; j < 2; ++j)
#pragma unroll
        for (int q = 0; q < 16; ++q) acc[0][j][q] = 0.f;
    auto compute = [&](int buf, int q) {
        const int nt = q / KT, kt = q - nt * KT;
        const char* pa = sA + kt * ASTAT_SLAB + (wm * 32 + (lane & 31)) * GEMM_ROWB + (lane >> 5) * 16;
        const char* pb = sB + buf * ASTAT_SLAB + (wn * 64 + (lane & 31)) * GEMM_ROWB + (lane >> 5) * 16;
#pragma unroll
        for (int ks = 0; ks < 4; ++ks) {
            const bf16x8 af = *(const bf16x8*)(pa + ks * 32);
#pragma unroll
            for (int j = 0; j < 2; ++j) { const bf16x8 bfr = *(const bf16x8*)(pb + j * 32 * GEMM_ROWB + ks * 32); acc[0][j] = MFMA32(bfr, af, acc[0][j]); }
        }
        if (kt == KT - 1) {
            epi.template run<1>(acc, m0 + wm * 32, nt * 128 + wn * 64, lane);
#pragma unroll
            for (int j = 0; j < 2; ++j)
#pragma unroll
                for (int qq = 0; qq < 16; ++qq) acc[0][j][qq] = 0.f;
        }
    };
#pragma unroll
    for (int i = 0; i < D; ++i) if (i < total) gload(rb[i]);
    lstore(0, rb[0]);
    if (D < total) gload(rb[0]);
    __syncthreads();
    for (int t = 0; t < total; t += D) {
#pragma unroll
        for (int u = 0; u < D; ++u) {
            const int q = t + u;
            if (q < total) {
                compute(u & 1, q);
                if (q + 1 < total) lstore((u + 1) & 1, rb[(u + 1) % D]);
                if (q + 1 + D < total) gload(rb[(u + 1) % D]);
                __syncthreads();
            }
        }
    }
}

template <int KT, bool FP8 = false>
__device__ __forceinline__ void gemm_astat256(const bf16* A, int lda, int m0, const bf16* B, int ldb, int NT, bf16* C, int ldc, char* smem) {
    const int tid = otid(), lane = tid & 63, wave = tid >> 6;
    const int kc = tid & 7, r0 = tid >> 3;
    const int wm = wave >> 2, wn = wave & 3;
    char* sA = smem; char* sB = smem + KT * ASTAT_SLAB;
    {
        u32x4 ra[KT][2];
#pragma unroll
        for (int i = 0; i < 2; ++i)
#pragma unroll
            for (int kt = 0; kt < KT; ++kt) ra[kt][i] = *(const u32x4*)(A + (size_t)(m0 + r0 + 64 * i) * lda + kt * 64 + kc * 8);
        __syncthreads();
#pragma unroll
        for (int kt = 0; kt < KT; ++kt)
#pragma unroll
            for (int i = 0; i < 2; ++i) *(u32x4*)(sA + kt * ASTAT_SLAB + (r0 + 64 * i) * GEMM_ROWB + kc * 16) = ra[kt][i];
    }
    const int total = NT * KT;
    int gq = 0;
    constexpr int D = 4;
    u32x4 rb[D][4];
    auto gload = [&](u32x4 (&r)[4]) {
        const int nt = gq / KT, kt = gq - nt * KT;
#pragma unroll
        for (int i = 0; i < 4; ++i) r[i] = *(const u32x4*)(B + (size_t)(nt * 256 + r0 + 64 * i) * ldb + kt * 64 + kc * 8);
        ++gq;
    };
    auto lstore = [&](int buf, const u32x4 (&r)[4]) {
#pragma unroll
        for (int i = 0; i < 4; ++i) *(u32x4*)(sB + buf * 2 * ASTAT_SLAB + (r0 + 64 * i) * GEMM_ROWB + kc * 16) = r[i];
    };
    f32x16 acc[2][2];
#pragma unroll
    for (int i = 0; i < 2; ++i)
#pragma unroll
        for (int j = 0; j < 2; ++j)
#pragma unroll
            for (int q = 0; q < 16; ++q) acc[i][j][q] = 0.f;
    auto compute = [&](int buf, int q) {
        const int nt = q / KT, kt = q - nt * KT;
        const char* pa = sA + kt * ASTAT_SLAB + (wm * 64 + (lane & 31)) * GEMM_ROWB + (lane >> 5) * 16;
        const char* pb = sB + buf * 2 * ASTAT_SLAB + (wn * 64 + (lane & 31)) * GEMM_ROWB + (lane >> 5) * 16;
#pragma unroll
        for (int ks = 0; ks < 4; ++ks) {
            bf16x8 af[2], bfr[2];
#pragma unroll
            for (int i = 0; i < 2; ++i) af[i] = *(const bf16x8*)(pa + i * 32 * GEMM_ROWB + ks * 32);
#pragma unroll
            for (int j = 0; j < 2; ++j) bfr[j] = *(const bf16x8*)(pb + j * 32 * GEMM_ROWB + ks * 32);
#pragma unroll
            for (int i = 0; i < 2; ++i)
#pragma unroll
                for (int j = 0; j < 2; ++j) acc[i][j] = MFMA32(bfr[j], af[i], acc[i][j]);
        }
        if (kt == KT - 1) {
            __syncthreads();
            char* st = sB + buf * 2 * ASTAT_SLAB + wave * (32 * STG_ROWB);
            if (FP8) {
#pragma unroll
                for (int i = 0; i < 2; ++i) {
#pragma unroll
                    for (int j = 0; j < 2; ++j)
#pragma unroll
                        for (int g = 0; g < 4; ++g) {
                            int w = 0;
                            w = __builtin_amdgcn_cvt_pk_fp8_f32(acc[i][j][4 * g] * 16.f, acc[i][j][4 * g + 1] * 16.f, w, false);
                            w = __builtin_amdgcn_cvt_pk_fp8_f32(acc[i][j][4 * g + 2] * 16.f, acc[i][j][4 * g + 3] * 16.f, w, true);
                            *(int*)(st + (lane & 31) * 80 + (j * 32 + 8 * g + 4 * (lane >> 5))) = w;
                        }
                    __builtin_amdgcn_wave_barrier();
#pragma unroll
                    for (int it = 0; it < 2; ++it) {
                        const int row = it * 16 + (lane >> 2), c4 = lane & 3;
                        const u32x4 v = *(const u32x4*)(st + row * 80 + c4 * 16);
                        *(u32x4*)((char*)C + (size_t)(m0 + wm * 64 + i * 32 + row) * ldc + nt * 256 + wn * 64 + c4 * 16) = v;
                    }
                    __builtin_amdgcn_wave_barrier();
                }
            } else
#pragma unroll
            for (int i = 0; i < 2; ++i) {
#pragma unroll
                for (int j = 0; j < 2; ++j)
#pragma unroll
                    for (int g = 0; g < 4; ++g) {
                        u32x2 v; v[0] = pk2(acc[i][j][4 * g], acc[i][j][4 * g + 1]); v[1] = pk2(acc[i][j][4 * g + 2], acc[i][j][4 * g + 3]);
                        *(u32x2*)(st + (lane & 31) * STG_ROWB + (j * 32 + 8 * g + 4 * (lane >> 5)) * 2) = v;
                    }
                __builtin_amdgcn_wave_barrier();
#pragma unroll
                for (int it = 0; it < 4; ++it) {
                    const int row = it * 8 + (lane >> 3), c8 = lane & 7;
                    const u32x4 v = *(const u32x4*)(st + row * STG_ROWB + c8 * 16);
                    *(u32x4*)(C + (size_t)(m0 + wm * 64 + i * 32 + row) * ldc + nt * 256 + wn * 64 + c8 * 8) = v;
                }
                __builtin_amdgcn_wave_barrier();
            }
#pragma unroll
            for (int i = 0; i < 2; ++i)
#pragma unroll
                for (int j = 0; j < 2; ++j)
#pragma unroll
                    for (int qq = 0; qq < 16; ++qq) acc[i][j][qq] = 0.f;
        }
    };
#pragma unroll
    for (int i = 0; i < D; ++i) if (i < total) gload(rb[i]);
    lstore(0, rb[0]);
    if (D < total) gload(rb[0]);
    __syncthreads();
    for (int t = 0; t < total; t += D) {
#pragma unroll
        for (int u = 0; u < D; ++u) {
            const int q = t + u;
            if (q < total) {
                compute(u & 1, q);
                if (q + 1 < total) lstore((u + 1) & 1, rb[(u + 1) % D]);
                if (q + 1 + D < total) gload(rb[(u + 1) % D]);
                __syncthreads();
            }
        }
    }
}

namespace g8 {
typedef float f32x4v __attribute__((ext_vector_type(4)));
constexpr int BK = 64, HALF = 128, HTB = HALF * BK * 2, STAGE_BYTES = 8 * HTB;
__device__ __forceinline__ int lds_byte(int r, int c) { const int st = (r >> 4) * 2 + (c >> 5), rr = r & 15, cc = c & 31, ob = rr * 64 + cc * 2; return st * 1024 + (ob ^ (((ob >> 9) & 1) << 5)); }
__device__ __forceinline__ void stage_rc(int b, int& R, int& C) { const int st = b / 1024, sb = b % 1024, swz = sb ^ (((sb >> 9) & 1) << 5); R = (st >> 1) * 16 + swz / 64; C = (st & 1) * 32 + (swz % 64) / 2; }
struct Unit { const char* A; const char* B; const int* rows; int pm, pn; };

template <bool GATHER, bool PERM = false, class Epi, class Sched>
__device__ __forceinline__ void gemm_phase(LAS unsigned char* lds, int K, const Sched& S, const Epi& E) {
    const int tid = otid(), wid = __builtin_amdgcn_readfirstlane(tid >> 6), lane = tid & 63, wr = wid >> 2, wc = wid & 3, fr = lane & 15, fq = lane >> 4;
    const int nt = K / BK;
    unsigned voffB[2];
#pragma unroll
    for (int i = 0; i < 2; ++i) { int R_, C_; stage_rc(tid * 16 + i * 8192, R_, C_);
        const int Rb = PERM ? ((R_ & ~31) + 8 * ((R_ & 15) >> 2) + 4 * ((R_ & 31) >> 4) + (R_ & 3)) : R_;
        voffB[i] = (unsigned)(Rb * K + C_) * 2u; }
    const size_t kstep = (size_t)(BK * 2);
    const size_t hstepB = (size_t)HALF * K * 2;
    const unsigned ldsw = (unsigned)wid * 1024u;
    const int aoff = lds_byte(wr * 64 + fr, fq * 8), boff = lds_byte(wc * 32 + fr, fq * 8);
#define G8_SA(b, h) (((b) * 2 + (h)) * HTB)
#define G8_SB(b, h) ((4 + (b) * 2 + (h)) * HTB)
#define G8_STAGE(bufoff, gbase, voff) do { _Pragma("unroll") for (int _i = 0; _i < 2; ++_i) \
        __builtin_amdgcn_global_load_lds((const unsigned*)((const char*)(gbase) + (voff)[_i]), (LAS unsigned*)(lds + (bufoff) + ldsw + _i * 8192), 16, 0, 0); } while (0)
#define G8_LDA(dst, b, h) do { _Pragma("unroll") for (int m = 0; m < 4; ++m) _Pragma("unroll") for (int k = 0; k < 2; ++k) dst[m][k] = *(const LAS bf16x8*)(lds + G8_SA(b, h) + aoff + m * 2048 + k * 1024); } while (0)
#define G8_LDB(dst, b, h) do { _Pragma("unroll") for (int n = 0; n < 2; ++n) _Pragma("unroll") for (int k = 0; k < 2; ++k) dst[n][k] = *(const LAS bf16x8*)(lds + G8_SB(b, h) + boff + n * 2048 + k * 1024); } while (0)
#define G8_MMA(ai, bj, At, Bt) do { __builtin_amdgcn_s_setprio(1); _Pragma("unroll") for (int m = 0; m < 4; ++m) _Pragma("unroll") for (int n = 0; n < 2; ++n) _Pragma("unroll") for (int k = 0; k < 2; ++k) \
        acc[ai][bj][m][n] = __builtin_amdgcn_mfma_f32_16x16x32_bf16(Bt[n][k], At[m][k], acc[ai][bj][m][n], 0, 0, 0); __builtin_amdgcn_s_setprio(0); } while (0)
#define G8_WAIT_V(n) asm volatile("s_waitcnt vmcnt(" #n ")" ::: "memory")
#define G8_WAIT_L(n) asm volatile("s_waitcnt lgkmcnt(" #n ")" ::: "memory")
#define G8_BAR __builtin_amdgcn_s_barrier()
#define G8_SCHED __builtin_amdgcn_sched_barrier(0)
    auto set_voffA = [&](const Unit& u, unsigned (&v)[2][2]) {
#pragma unroll
        for (int h2 = 0; h2 < 2; ++h2)
#pragma unroll
            for (int i = 0; i < 2; ++i) { int R_, C_; stage_rc(otid() * 16 + i * 8192, R_, C_); const int rr = h2 * HALF + R_; const int row = u.rows ? u.rows[rr] : rr; v[h2][i] = (unsigned)(row * K + C_) * 2u; }
    };
    Unit cur, nxt; int ui = 0;
    if (!S.next(0, cur)) return;
    f32x4v acc[2][2][4][2];
#pragma unroll
    for (int a = 0; a < 2; ++a)
#pragma unroll
        for (int b = 0; b < 2; ++b)
#pragma unroll
            for (int m = 0; m < 4; ++m)
#pragma unroll
                for (int n = 0; n < 2; ++n) acc[a][b][m][n] = (f32x4v){0.f, 0.f, 0.f, 0.f};
    bf16x8 At[4][2], B0[2][2], B1[2][2];
    unsigned vA[2][2], nvA[2][2];
    set_voffA(cur, vA);
    const char* cA = cur.A; const char* cB = cur.B;
    G8_STAGE(G8_SB(0, 0), cB, voffB); G8_STAGE(G8_SA(0, 0), cA, vA[0]); G8_STAGE(G8_SB(0, 1), cB + hstepB, voffB); G8_STAGE(G8_SA(0, 1), cA, vA[1]);
    if (wr == 1) G8_BAR;
    G8_WAIT_V(4); G8_BAR;
    G8_STAGE(G8_SB(1, 0), cB + kstep, voffB); G8_STAGE(G8_SA(1, 0), cA + kstep, vA[0]); G8_STAGE(G8_SB(1, 1), cB + hstepB + kstep, voffB);
    G8_WAIT_V(6); G8_BAR;
    for (;;) {
        const bool has_next = S.next(ui + 1, nxt);
        const char* nA = has_next ? nxt.A : cA; const char* nB = has_next ? nxt.B : cB;
        if (GATHER) {
            if (has_next) set_voffA(nxt, nvA);
            else {
#pragma unroll
                for (int h2 = 0; h2 < 2; ++h2)
#pragma unroll
                    for (int i = 0; i < 2; ++i) nvA[h2][i] = vA[h2][i];
            }
        }
        for (int t = 0; t < nt; t += 2) {
            const bool last = (t == nt - 2);
            const char* a1 = cA + (size_t)(t + 1) * kstep;
            const char* a2 = last ? nA : cA + (size_t)(t + 2) * kstep; const char* b2 = last ? nB : cB + (size_t)(t + 2) * kstep;
            const char* a3 = a2 + kstep; const char* b3 = b2 + kstep;
            G8_LDB(B0, 0, 0); G8_SCHED; G8_LDA(At, 0, 0); G8_STAGE(G8_SA(1, 1), a1, vA[1]);
            if (GATHER && last) {
#pragma unroll
                for (int h2 = 0; h2 < 2; ++h2)
#pragma unroll
                    for (int i = 0; i < 2; ++i) vA[h2][i] = nvA[h2][i];
            }
            G8_WAIT_L(8); G8_BAR; G8_WAIT_L(0); G8_MMA(0, 0, At, B0); G8_BAR; G8_SCHED;
            G8_LDB(B1, 0, 1); G8_STAGE(G8_SB(0, 0), b2, voffB);
            G8_BAR; G8_WAIT_L(0); G8_MMA(0, 1, At, B1); G8_BAR;
            G8_LDA(At, 0, 1); G8_STAGE(G8_SA(0, 0), a2, vA[0]);
            G8_BAR; G8_WAIT_L(0); G8_MMA(1, 0, At, B0); G8_BAR; G8_SCHED;
            G8_STAGE(G8_SB(0, 1), b2 + hstepB, voffB);
            G8_WAIT_V(6); G8_BAR; G8_MMA(1, 1, At, B1); G8_BAR;
            G8_LDB(B0, 1, 0); G8_SCHED; G8_LDA(At, 1, 0); G8_STAGE(G8_SA(0, 1), a2, vA[1]);
            G8_WAIT_L(8); G8_BAR; G8_WAIT_L(0); G8_MMA(0, 0, At, B0); G8_BAR; G8_SCHED;
            G8_LDB(B1, 1, 1); G8_STAGE(G8_SB(1, 0), b3, voffB);
            G8_BAR; G8_WAIT_L(0); G8_MMA(0, 1, At, B1); G8_BAR;
            G8_LDA(At, 1, 1); G8_STAGE(G8_SA(1, 0), a3, vA[0]);
            G8_BAR; G8_WAIT_L(0); G8_MMA(1, 0, At, B0); G8_BAR; G8_SCHED;
            G8_STAGE(G8_SB(1, 1), b3 + hstepB, voffB);
            G8_WAIT_V(6); G8_BAR; G8_MMA(1, 1, At, B1); G8_BAR;
        }
        E(acc, cur, wr, wc, fr, fq);
        if (!has_next) break;
#pragma unroll
        for (int a = 0; a < 2; ++a)
#pragma unroll
            for (int b = 0; b < 2; ++b)
#pragma unroll
                for (int m = 0; m < 4; ++m)
#pragma unroll
                    for (int n = 0; n < 2; ++n) acc[a][b][m][n] = (f32x4v){0.f, 0.f, 0.f, 0.f};
        cur = nxt; cA = nA; cB = nB; ++ui;
    }
    G8_WAIT_V(0);
    if (wr == 0) G8_BAR;
    G8_BAR;
#undef G8_SA
#undef G8_SB
#undef G8_STAGE
#undef G8_LDA
#undef G8_LDB
#undef G8_MMA
#undef G8_WAIT_V
#undef G8_WAIT_L
#undef G8_BAR
#undef G8_SCHED
}
struct GridOrder {
    const char* A; const char* Bt; int K, nM, nN, nwg, G, c, skipctx;
    __device__ __forceinline__ bool next(int i, Unit& u) const {
        const long L = (long)i * G + c; if (L >= nwg) return false;
        int wgid = (int)L; { const int q = nwg / 8, r = nwg % 8, xcd = wgid % 8, off = wgid / 8; wgid = (xcd < r ? xcd * (q + 1) : r * (q + 1) + (xcd - r) * q) + off; }
        const int nig = 8 * nN, gid = wgid / nig, fm = gid * 8, gsz = (nM - fm) < 8 ? (nM - fm) : 8;
        u.pm = fm + ((wgid % nig) % gsz); u.pn = (wgid % nig) / gsz;
        if (skipctx) u.pm = (u.pm >> 5) * 33 + 1 + (u.pm & 31);
        u.A = A + (size_t)u.pm * 256 * K * 2; u.B = Bt + (size_t)u.pn * 256 * K * 2; u.rows = nullptr; return true;
    }
};
}

#define EPI_FOR(MI)                                                                                   \
    _Pragma("unroll") for (int i_ = 0; i_ < MI; ++i_)                                                 \
    _Pragma("unroll") for (int j_ = 0; j_ < 2; ++j_)                                                  \
    _Pragma("unroll") for (int g_ = 0; g_ < 4; ++g_)
#define EPI_M (mb + i_ * 32 + (lane & 31))
#define EPI_N (nb + j_ * 32 + 8 * g_ + 4 * (lane >> 5))
#define EPI_V(q) (acc[i_][j_][4 * g_ + (q)])

__device__ __forceinline__ void st_bf4(bf16* p, float a, float b, float c, float d) { u32x2 v; v[0] = pk2(a, b); v[1] = pk2(c, d); *(u32x2*)p = v; }
template <int MI>
__device__ __forceinline__ void stage_store_bf16(f32x16 (&acc)[MI][2], char* stg, bf16* C, int ldc, int mb, int nb, int lane) {
#pragma unroll
    for (int i = 0; i < MI; ++i)
#pragma unroll
        for (int j = 0; j < 2; ++j)
#pragma unroll
            for (int g = 0; g < 4; ++g) {
                u32x2 v; v[0] = pk2(acc[i][j][4 * g], acc[i][j][4 * g + 1]); v[1] = pk2(acc[i][j][4 * g + 2], acc[i][j][4 * g + 3]);
                *(u32x2*)(stg + (i * 32 + (lane & 31)) * STG_ROWB + (j * 32 + 8 * g + 4 * (lane >> 5)) * 2) = v;
            }
    __builtin_amdgcn_wave_barrier();
#pragma unroll
    for (int it = 0; it < MI * 4; ++it) {
        const int row = it * 8 + (lane >> 3), ch = lane & 7;
        const u32x4 v = *(const u32x4*)(stg + row * STG_ROWB + ch * 16);
        *(u32x4*)(C + (size_t)(mb + row) * ldc + nb + ch * 8) = v;
    }
    __builtin_amdgcn_wave_barrier();
}
struct EpiBf16Stg {
    bf16* C; int ldc; char* stg;
    template <int MI> __device__ __forceinline__ void run(f32x16 (&acc)[MI][2], int mb, int nb, int lane) const {
        const int wave = otid() >> 6;
        stage_store_bf16<MI>(acc, stg + wave * (MI * 32 * STG_ROWB), C, ldc, mb, nb, lane);
    }
};

struct EpiInproj {
    bf16* ug; bf16* z; float* gates; char* stg;
    template <int MI> __device__ __forceinline__ void run(f32x16 (&acc)[MI][2], int mb, int nb, int lane) const {
        if (nb >= 256 && nb + 64 <= 1696) { stage_store_bf16<MI>(acc, stg + (otid() >> 6) * (MI * 32 * STG_ROWB), z, ZW, mb, nb - 256, lane); return; }
        EPI_FOR(MI) {
            const int m = EPI_M, n = EPI_N;
            const float v0 = EPI_V(0), v1 = EPI_V(1), v2 = EPI_V(2), v3 = EPI_V(3);
            if (n < 256) {
                const int g = n >> 4, cc = n & 15, b = m / SQ, s = m - b * SQ;
                const int row = b * NCH + (s >> 6), j = s & 63;
                st_bf4(ug + ((size_t)g * NROWP + row) * 1024 + j * 16 + cc, v0, v1, v2, v3);
            } else if (n < 1696) {
                st_bf4(z + (size_t)m * ZW + (n - 256), v0, v1, v2, v3);
            } else if (n < 1712) {
                f32x4 v = {v0, v1, v2, v3};
                *(f32x4*)(gates + (size_t)m * 16 + (n - 1696)) = v;
            }
        }
    }
};
struct EpiRouterSum {
    float* C; char* stg;
    template <int MI> __device__ __forceinline__ void run(f32x16 (&acc)[MI][2], int mb, int nb, int lane) const {
        float* st = (float*)stg + (otid() >> 7) * (MI * 2 * 16 * 64);
        if (nb >= 64) {
#pragma unroll
            for (int i = 0; i < MI; ++i)
#pragma unroll
                for (int j = 0; j < 2; ++j)
#pragma unroll
                    for (int q = 0; q < 16; ++q) st[((i * 2 + j) * 16 + q) * 64 + lane] = acc[i][j][q];
        }
        __syncthreads();
        if (nb < 64) {
#pragma unroll
            for (int i = 0; i < MI; ++i)
#pragma unroll
                for (int j = 0; j < 2; ++j)
#pragma unroll
                    for (int q = 0; q < 16; ++q) acc[i][j][q] += st[((i * 2 + j) * 16 + q) * 64 + lane];
            EPI_FOR(MI) {
                const int m = EPI_M, n = EPI_N;
                if (m < NTOK) { f32x4 v = {EPI_V(0), EPI_V(1), EPI_V(2), EPI_V(3)}; *(f32x4*)(C + (size_t)m * 64 + n) = v; }
            }
        }
    }
};
struct EpiF32 {
    float* C; int ldc, mvalid, nvalid;
    template <int MI> __device__ __forceinline__ void run(f32x16 (&acc)[MI][2], int mb, int nb, int lane) const {
        EPI_FOR(MI) {
            const int m = EPI_M, n = EPI_N;
            if (m < mvalid && n < nvalid) { f32x4 v = {EPI_V(0), EPI_V(1), EPI_V(2), EPI_V(3)}; *(f32x4*)(C + (size_t)m * ldc + n) = v; }
        }
    }
};
struct EpiBf16 {
    bf16* C; int ldc;
    template <int MI> __device__ __forceinline__ void run(f32x16 (&acc)[MI][2], int mb, int nb, int lane) const {
        EPI_FOR(MI) { st_bf4(C + (size_t)EPI_M * ldc + EPI_N, EPI_V(0), EPI_V(1), EPI_V(2), EPI_V(3)); }
    }
};
struct EpiS5Y {
    bf16* gs; int g;
    template <int MI> __device__ __forceinline__ void run(f32x16 (&acc)[MI][2], int mb, int nb, int lane) const {
        EPI_FOR(MI) {
            const int m = EPI_M, n = EPI_N;
            if (m < NROW) {
                const int b = m / NCH, c = m - b * NCH, i = n >> 4, cc = n & 15;
                const size_t tok = (size_t)b * SQ + c * 64 + i;
                st_bf4(gs + tok * 256 + g * 16 + cc, gelu_tanh(EPI_V(0)), gelu_tanh(EPI_V(1)), gelu_tanh(EPI_V(2)), gelu_tanh(EPI_V(3)));
            }
        }
    }
};
struct EpiGlu {
    const bf16* gs; const float* bias; bf16* cat; char* stg;
    template <int MI> __device__ __forceinline__ void run(f32x16 (&acc)[MI][2], int mb, int nb, int lane) const {
        EPI_FOR(MI) {
            const int m = EPI_M, n = EPI_N;
            const u32x2 gv = *(const u32x2*)(gs + (size_t)m * 256 + n);
            const f32x4 bv = *(const f32x4*)(bias + n);
            acc[i_][j_][4 * g_] = bflo(gv[0]) * sigmoidf_(EPI_V(0) + bv[0]); acc[i_][j_][4 * g_ + 1] = bfhi(gv[0]) * sigmoidf_(EPI_V(1) + bv[1]);
            acc[i_][j_][4 * g_ + 2] = bflo(gv[1]) * sigmoidf_(EPI_V(2) + bv[2]); acc[i_][j_][4 * g_ + 3] = bfhi(gv[1]) * sigmoidf_(EPI_V(3) + bv[3]);
        }
        stage_store_bf16<MI>(acc, stg + (otid() >> 6) * (MI * 32 * STG_ROWB), cat, 1024, mb, nb, lane);
    }
};
struct EpiQ {
    const float* rq; const float* tab; bf16* q; char* stg;
    template <int MI> __device__ __forceinline__ void run(f32x16 (&acc)[MI][2], int mb, int nb, int lane) const {
        EPI_FOR(MI) {
            const int m = EPI_M, n = EPI_N;
            const int b = m / SQ, s = m - b * SQ, hd = n / 96, d = n - hd * 96;
            const float sc = rq[m] * QSCALE;
            float v0 = EPI_V(0) * sc, v1 = EPI_V(1) * sc, v2 = EPI_V(2) * sc, v3 = EPI_V(3) * sc;
            if (d >= 64 && s >= CTXL) {
                const int r = d - 64, ax = r >> 4, i0 = (r & 15) >> 1, sl = s - CTXL;
                const int pos = ax ? (sl & 63) : (sl >> 6);
                const f32x4 cs = *(const f32x4*)(tab + (pos * 8 + i0) * 2);
                const float a0 = v0 * cs[0] - v1 * cs[1], a1 = v0 * cs[1] + v1 * cs[0];
                const float a2 = v2 * cs[2] - v3 * cs[3], a3 = v2 * cs[3] + v3 * cs[2];
                v0 = a0; v1 = a1; v2 = a2; v3 = a3;
            }
            acc[i_][j_][4 * g_] = v0; acc[i_][j_][4 * g_ + 1] = v1; acc[i_][j_][4 * g_ + 2] = v2; acc[i_][j_][4 * g_ + 3] = v3;
        }
        stage_store_bf16<MI>(acc, stg + (otid() >> 6) * (MI * 32 * STG_ROWB), q, 768, mb, nb, lane);
    }
};
struct EpiKV {
    const float* rkv; bf16* kf; bf16* vt; char* stg;
    template <int MI> __device__ __forceinline__ void run(f32x16 (&acc)[MI][2], int mb, int nb, int lane) const {
        const int hd = nb >> 7;
        if ((nb & 64) == 0) {
            const int b = mb / SQ, s0 = mb - b * SQ;
            EPI_FOR(MI) { const float sc = rkv[EPI_M]; acc[i_][j_][4 * g_] *= sc; acc[i_][j_][4 * g_ + 1] *= sc; acc[i_][j_][4 * g_ + 2] *= sc; acc[i_][j_][4 * g_ + 3] *= sc; }
            stage_store_bf16<MI>(acc, stg + (otid() >> 6) * (MI * 32 * STG_ROWB), kf + (size_t)(b * 8 + hd) * SQ * 96, 96, s0, 0, lane);
            return;
        }
        EPI_FOR(MI) {
            const int m = EPI_M, n = EPI_N;
            const int b = m / SQ, s = m - b * SQ, d2 = n & 127;
            const float sc = rkv[m];
            const float v0 = EPI_V(0) * sc, v1 = EPI_V(1) * sc, v2 = EPI_V(2) * sc, v3 = EPI_V(3) * sc;
            bf16* p = vt + ((size_t)(b * 8 + hd) * 64 + (d2 - 64)) * SQ + s;
            p[0] = f2bf(v0); p[SQ] = f2bf(v1); p[2 * SQ] = f2bf(v2); p[3 * SQ] = f2bf(v3);
        }
    }
};
struct EpiMoeUp {
    const float* slotgate; bf16* hc; char* stg;
    template <int MI> __device__ __forceinline__ void run(f32x16 (&acc)[MI][2], int mb, int nb, int lane) const {
        char* st = stg + (otid() >> 6) * (MI * 32 * 80);
#pragma unroll
        for (int i_ = 0; i_ < MI; ++i_)
#pragma unroll
            for (int g_ = 0; g_ < 4; ++g_) {
                const int rl = i_ * 32 + (lane & 31);
                const float gw = slotgate[mb + rl];
                float o[4];
#pragma unroll
                for (int q = 0; q < 4; ++q) o[q] = gw * siluf_(acc[i_][0][4 * g_ + q]) * acc[i_][1][4 * g_ + q];
                u32x2 v; v[0] = pk2(o[0], o[1]); v[1] = pk2(o[2], o[3]);
                *(u32x2*)(st + rl * 80 + (8 * g_ + 4 * (lane >> 5)) * 2) = v;
            }
        __builtin_amdgcn_wave_barrier();
#pragma unroll
        for (int it = 0; it < MI * 2; ++it) {
            const int row = it * 16 + (lane >> 2), ch = lane & 3;
            const u32x4 v = *(const u32x4*)(st + row * 80 + ch * 16);
            *(u32x4*)(hc + (size_t)(mb + row) * 256 + (nb >> 1) + ch * 8) = v;
        }
        __builtin_amdgcn_wave_barrier();
    }
};

struct EpiInproj8 {
    bf16* ug; bf16* z; float* gates;
    __device__ __forceinline__ void operator()(const g8::f32x4v (&acc)[2][2][4][2], const g8::Unit& u, int wr, int wc, int fr, int fq) const {
#pragma unroll
        for (int ai = 0; ai < 2; ++ai)
#pragma unroll
            for (int mm = 0; mm < 4; ++mm) {
                const int m = u.pm * 256 + 128 * ai + 64 * wr + 16 * mm + fr;
                const int b = m / SQ, s = m - b * SQ;
#pragma unroll
                for (int bj = 0; bj < 2; ++bj) {
                    const int n = u.pn * 256 + 128 * bj + 32 * wc + 8 * fq;
                    const g8::f32x4v a = acc[ai][bj][mm][0], c = acc[ai][bj][mm][1];
                    if (n < 1696) {
                        u32x4 o = {pk2(a[0], a[1]), pk2(a[2], a[3]), pk2(c[0], c[1]), pk2(c[2], c[3])};
                        if (n < 256) {
                            const int g = n >> 4, cc = n & 15, row = b * NCH + (s >> 6), j = s & 63;
                            *(u32x4*)(ug + ((size_t)g * NROWP + row) * 1024 + j * 16 + cc) = o;
                        } else *(u32x4*)(z + (size_t)m * ZW + (n - 256)) = o;
                    } else if (n < 1712) {
                        f32x4 w0 = {a[0], a[1], a[2], a[3]}, w1 = {c[0], c[1], c[2], c[3]};
                        *(f32x4*)(gates + (size_t)m * 16 + (n - 1696)) = w0; *(f32x4*)(gates + (size_t)m * 16 + (n - 1696) + 4) = w1;
                    }
                }
            }
    }
};
struct EpiBf16_8 {
    bf16* C; int ldc;
    __device__ __forceinline__ void operator()(const g8::f32x4v (&acc)[2][2][4][2], const g8::Unit& u, int wr, int wc, int fr, int fq) const {
#pragma unroll
        for (int ai = 0; ai < 2; ++ai)
#pragma unroll
            for (int mm = 0; mm < 4; ++mm) {
                bf16* rowp = C + (size_t)(u.pm * 256 + 128 * ai + 64 * wr + 16 * mm + fr) * ldc + u.pn * 256 + 32 * wc + 8 * fq;
#pragma unroll
                for (int bj = 0; bj < 2; ++bj) {
                    const g8::f32x4v a = acc[ai][bj][mm][0], b = acc[ai][bj][mm][1];
                    u32x4 o = {pk2(a[0], a[1]), pk2(a[2], a[3]), pk2(b[0], b[1]), pk2(b[2], b[3])};
                    *(u32x4*)(rowp + 128 * bj) = o;
                }
            }
    }
};
struct EpiUp8 {
    const float* slotgate; bf16* hc;
    __device__ __forceinline__ void operator()(const g8::f32x4v (&acc)[2][2][4][2], const g8::Unit& u, int wr, int wc, int fr, int fq) const {
#pragma unroll
        for (int ai = 0; ai < 2; ++ai)
#pragma unroll
            for (int mm = 0; mm < 4; ++mm) {
                const int slot = u.pm + 128 * ai + 64 * wr + 16 * mm + fr;
                const float gw = slotgate[slot];
#pragma unroll
                for (int bj = 0; bj < 2; ++bj) {
                    const g8::f32x4v gv = acc[ai][bj][mm][0], uv = acc[ai][bj][mm][1];
                    const int j = u.pn * 128 + 64 * bj + 16 * wc + 4 * fq;
                    st_bf4(hc + (size_t)slot * 256 + j, gw * siluf_(gv[0]) * uv[0], gw * siluf_(gv[1]) * uv[1], gw * siluf_(gv[2]) * uv[2], gw * siluf_(gv[3]) * uv[3]);
                }
            }
    }
};
struct UpOrder {
    const char* A; const char* Bt; const int* slottok; const int* ue; const int* ur; int nu2, G, c;
    __device__ __forceinline__ bool next(int i, g8::Unit& u) const {
        const int L = i * G + c; if (L >= nu2) return false;
        const int k = L >> 1, pn = L & 1, e = ue[k], row0 = ur[k];
        u.A = A; u.rows = slottok + row0; u.B = Bt + ((size_t)e * 512 + pn * 256) * 1024 * 2; u.pm = row0; u.pn = pn; return true;
    }
};

__device__ __forceinline__ const float* res_row_in(const Params& p, int layer, int tok) {
    const int b = tok / SQ, s = tok - b * SQ;
    if (layer == 0) return s < CTXL ? p.ctx + ((size_t)b * CTXL + s) * DM : p.x + ((size_t)b * SEQL + (s - CTXL)) * DM;
    return s < CTXL ? p.ctxres + ((size_t)b * CTXL + s) * DM : p.out + ((size_t)b * SEQL + (s - CTXL)) * DM;
}
__device__ __forceinline__ float* res_row_out(const Params& p, int tok) {
    const int b = tok / SQ, s = tok - b * SQ;
    return s < CTXL ? p.ctxres + ((size_t)b * CTXL + s) * DM : p.out + ((size_t)b * SEQL + (s - CTXL)) * DM;
}
__device__ __forceinline__ void row_ln(float (&v)[16]) {
    float s = 0.f;
#pragma unroll
    for (int i = 0; i < 16; ++i) s += v[i];
    const float mu = wave_sum(s) * (1.f / 1024.f);
    float q = 0.f;
#pragma unroll
    for (int i = 0; i < 16; ++i) { v[i] -= mu; q += v[i] * v[i]; }
    const float rs = rsqrtf(wave_sum(q) * (1.f / 1024.f) + LN_EPS);
#pragma unroll
    for (int i = 0; i < 16; ++i) v[i] *= rs;
}
__device__ __forceinline__ void row_ld(const float* r, int lane, float (&v)[16]) {
#pragma unroll
    for (int j = 0; j < 4; ++j) { const f32x4 t = *(const f32x4*)(r + 4 * lane + 256 * j); v[4 * j] = t[0]; v[4 * j + 1] = t[1]; v[4 * j + 2] = t[2]; v[4 * j + 3] = t[3]; }
}
__device__ __forceinline__ void row_ld_nt(const float* r, int lane, float (&v)[16]) {
#pragma unroll
    for (int j = 0; j < 4; ++j) { const f32x4 t = __builtin_nontemporal_load((const f32x4*)(r + 4 * lane + 256 * j)); v[4 * j] = t[0]; v[4 * j + 1] = t[1]; v[4 * j + 2] = t[2]; v[4 * j + 3] = t[3]; }
}
__device__ __forceinline__ void row_ld_bf_nt(const bf16* r, int lane, float (&v)[16]) {
#pragma unroll
    for (int j = 0; j < 4; ++j) { const u32x2 t = __builtin_nontemporal_load((const u32x2*)(r + 4 * lane + 256 * j)); v[4 * j] = bflo(t[0]); v[4 * j + 1] = bfhi(t[0]); v[4 * j + 2] = bflo(t[1]); v[4 * j + 3] = bfhi(t[1]); }
}
__device__ __forceinline__ void row_st(float* r, int lane, const float (&v)[16]) {
#pragma unroll
    for (int j = 0; j < 4; ++j) { f32x4 t = {v[4 * j], v[4 * j + 1], v[4 * j + 2], v[4 * j + 3]}; *(f32x4*)(r + 4 * lane + 256 * j) = t; }
}
__device__ __forceinline__ void row_st_bf(bf16* r, int lane, const float (&v)[16]) {
#pragma unroll
    for (int j = 0; j < 4; ++j) st_bf4(r + 4 * lane + 256 * j, v[4 * j], v[4 * j + 1], v[4 * j + 2], v[4 * j + 3]);
}
__device__ __forceinline__ void row_ld_f8(const unsigned char* r, int lane, float (&v)[16]) {
    typedef float f2v __attribute__((ext_vector_type(2)));
#pragma unroll
    for (int j = 0; j < 4; ++j) {
        const int w = __builtin_nontemporal_load((const int*)(r + 4 * lane + 256 * j));
        const f2v lo = __builtin_amdgcn_cvt_pk_f32_fp8(w, false), hi = __builtin_amdgcn_cvt_pk_f32_fp8(w, true);
        v[4 * j] = lo[0] * 0.0625f; v[4 * j + 1] = lo[1] * 0.0625f; v[4 * j + 2] = hi[0] * 0.0625f; v[4 * j + 3] = hi[1] * 0.0625f;
    }
}
__device__ __forceinline__ void row_ld_bf(const bf16* r, int lane, float (&v)[16]) {
#pragma unroll
    for (int j = 0; j < 4; ++j) { const u32x2 t = *(const u32x2*)(r + 4 * lane + 256 * j); v[4 * j] = bflo(t[0]); v[4 * j + 1] = bfhi(t[0]); v[4 * j + 2] = bflo(t[1]); v[4 * j + 3] = bfhi(t[1]); }
}

__device__ __forceinline__ void wave_token_range(int wave, int& t0, int& t1) {
    const int G = gridDim.x, b = blockIdx.x;
    const int b0 = (int)(((long)NTOK * b) / G), b1 = (int)(((long)NTOK * (b + 1)) / G), n = b1 - b0;
    t0 = b0 + (n * wave) / 8; t1 = b0 + (n * (wave + 1)) / 8;
}
__device__ __forceinline__ void phase_ln_mod(const Params& p, int layer, int item) {
    const int lane = otid() & 63, wave = otid() >> 6;
    int t0, t1; wave_token_range(wave, t0, t1); (void)item;
    for (int tok = t0; tok < t1; ++tok) {
        const int b = tok / SQ, s = tok - b * SQ;
        const float* mv = p.modv + (size_t)(layer * 9 + (s < CTXL ? 8 : b)) * 6144;
        float v[16], sh[16], sc[16];
        row_ld_nt(res_row_in(p, layer, tok), lane, v);
        row_ld(mv, lane, sh); row_ld(mv + 1024, lane, sc);
        row_ln(v);
#pragma unroll
        for (int k = 0; k < 16; ++k) v[k] = v[k] * (1.f + sc[k]) + sh[k];
        row_st_bf(p.h + (size_t)tok * DM, lane, v);
    }
}
template <int DUMMY>
__device__ __forceinline__ void phase_post_mixer(const Params& p, int layer, int item) {
    const int lane = otid() & 63, wave = otid() >> 6;
    const bf16* y = p.z;
    bf16* fhi = p.h; bf16* flo = p.cat;
    int t0, t1; if (DUMMY) { t0 = item * 64 + wave * 8; t1 = t0 + 8; } else wave_token_range(wave, t0, t1);
    for (int tok = t0; tok < t1; ++tok) {
        const int b = tok / SQ, s = tok - b * SQ;
        if (!DUMMY && layer == 1 && s < CTXL) continue;
        const float* mv = p.modv + (size_t)(layer * 9 + (s < CTXL ? 8 : b)) * 6144;
        float v[16], t[16], u[16];
        row_ld_nt(res_row_in(p, layer, tok), lane, v);
        row_ld_bf_nt(y + (size_t)tok * DM, lane, t);
        row_ld(mv + 2048, lane, u);
#pragma unroll
        for (int k = 0; k < 16; ++k) v[k] = ALPHA_DN * v[k] + u[k] * t[k];
        row_ln(v);
        row_ld(p.ln1_g + layer * DM, lane, t); row_ld(p.ln1_b + layer * DM, lane, u);
#pragma unroll
        for (int k = 0; k < 16; ++k) v[k] = v[k] * t[k] + u[k];
        row_st(DUMMY ? (float*)p.yc + (size_t)(blockIdx.x * 8 + wave) * 1024 : res_row_out(p, tok), lane, v);
        row_ln(v);
        row_ld(mv + 3072, lane, t); row_ld(mv + 4096, lane, u);
        float lo[16];
#pragma unroll
        for (int k = 0; k < 16; ++k) { v[k] = v[k] * (1.f + u[k]) + t[k]; const float hi = bf2f(f2bf(v[k])); lo[k] = v[k] - hi; }
        row_st_bf(DUMMY ? p.yc + (size_t)(4096 + blockIdx.x * 8 + wave) * 2048 : fhi + (size_t)tok * DM, lane, v);
        row_st_bf(DUMMY ? p.yc + (size_t)(8192 + blockIdx.x * 8 + wave) * 2048 : flo + (size_t)tok * DM, lane, lo);
    }
}
struct CombRows { u32x4 y[9]; f32x4 x[4]; };
__device__ __forceinline__ void comb_issue(const Params& p, int b, int s, int off_sh, const bf16* yc, int lane, CombRows& R) {
    const int tok = b * SQ + s;
    const unsigned char* yb = (const unsigned char*)yc;
    R.y[0] = __builtin_nontemporal_load((const u32x4*)(yb + (size_t)(off_sh + s) * DM + 16 * lane));
#pragma unroll
    for (int k = 0; k < 8; ++k) {
        const int slot = p.tokslot[tok * 8 + k];
        R.y[1 + k] = __builtin_nontemporal_load((const u32x4*)(yb + (size_t)slot * DM + 16 * lane));
    }
    const float* xr = res_row_out(p, tok);
#pragma unroll
    for (int j = 0; j < 4; ++j) R.x[j] = __builtin_nontemporal_load((const f32x4*)(xr + 4 * lane + 256 * j));
}
__device__ __forceinline__ void phase_combine(const Params& p, int layer, int b, int item, const bf16* yc) {
    typedef float f2v __attribute__((ext_vector_type(2)));
    const int lane = otid() & 63, wave = otid() >> 6;
    const int off_sh = p.ntb[b * 2 + 1];
    (void)item;
    const int G = gridDim.x, nb0 = (int)(((long)SQ * blockIdx.x) / G), nb1 = (int)(((long)SQ * (blockIdx.x + 1)) / G), nn = nb1 - nb0;
    int sa = nb0 + (nn * wave) / 8; const int sb = nb0 + (nn * (wave + 1)) / 8;
    if (layer == 1 && sa < CTXL) sa = CTXL;
    if (sa >= sb) return;
    CombRows cur, nxt;
    comb_issue(p, b, sa, off_sh, yc, lane, cur);
    for (int s = sa; s < sb; ++s) {
        const int tok = b * SQ + s;
        if (s + 1 < sb) comb_issue(p, b, s + 1, off_sh, yc, lane, nxt);
        const float* mv = p.modv + (size_t)(layer * 9 + (s < CTXL ? 8 : b)) * 6144;
        float f[16], t[16], v[16];
#pragma unroll
        for (int q = 0; q < 16; ++q) f[q] = 0.f;
#pragma unroll
        for (int k = 0; k < 9; ++k)
#pragma unroll
            for (int j = 0; j < 4; ++j) {
                const f2v lo = __builtin_amdgcn_cvt_pk_f32_fp8((int)cur.y[k][j], false), hi = __builtin_amdgcn_cvt_pk_f32_fp8((int)cur.y[k][j], true);
                f[4 * j] += lo[0]; f[4 * j + 1] += lo[1]; f[4 * j + 2] += hi[0]; f[4 * j + 3] += hi[1];
            }
#pragma unroll
        for (int j = 0; j < 4; ++j) { v[4 * j] = cur.x[j][0]; v[4 * j + 1] = cur.x[j][1]; v[4 * j + 2] = cur.x[j][2]; v[4 * j + 3] = cur.x[j][3]; }
        float* xr = res_row_out(p, tok);
        row_ld(mv + 5120, lane, t);
#pragma unroll
        for (int q = 0; q < 16; ++q) v[q] = ALPHA_DN * v[q] + t[q] * (f[q] * 0.0625f);
        row_ln(v);
        row_ld(p.ln2_g + layer * DM, lane, t); row_ld(p.ln2_b + layer * DM, lane, f);
#pragma unroll
        for (int q = 0; q < 16; ++q) v[q] = v[q] * t[q] + f[q];
        row_st(xr, lane, v);
        if (layer == 0) {
            const float* mv1 = p.modv + (size_t)(9 + (s < CTXL ? 8 : b)) * 6144;
            row_ln(v);
            row_ld(mv1, lane, t); row_ld(mv1 + 1024, lane, f);
#pragma unroll
            for (int q = 0; q < 16; ++q) v[q] = v[q] * (1.f + f[q]) + t[q];
            row_st_bf(p.h + (size_t)tok * DM, lane, v);
        }
        if (s + 1 < sb) cur = nxt;
    }
}

__device__ __forceinline__ void job_modv(const Params& p, int item, char* smem) {
    float* sc = (float*)smem;
    float* red = sc + 9 * 1024;
    const int tid = otid();
    for (int i = tid; i < 9 * 1024; i += 512) { const int r = i >> 10, k = i & 1023; const float cv = r < 8 ? p.c[r * 1024 + k] : p.c_ctx[k]; sc[i] = siluf_(cv); }
    __syncthreads();
    const int layer = item / 96, col = (item % 96) * 64 + (tid & 63), sl = tid >> 6;
    const float* w = p.ada_w + (size_t)layer * 1024 * 6144 + col + (size_t)sl * 128 * 6144;
    const float* scs = sc + sl * 128;
    float acc[9];
#pragma unroll
    for (int r = 0; r < 9; ++r) acc[r] = 0.f;
    for (int k = 0; k < 128; k += 8) {
        float wv[8];
#pragma unroll
        for (int u = 0; u < 8; ++u) wv[u] = w[(size_t)(k + u) * 6144];
#pragma unroll
        for (int u = 0; u < 8; ++u)
#pragma unroll
            for (int r = 0; r < 9; ++r) acc[r] += scs[r * 1024 + k + u] * wv[u];
    }
#pragma unroll
    for (int r = 0; r < 9; ++r) red[(sl * 9 + r) * 64 + (tid & 63)] = acc[r];
    __syncthreads();
    for (int e = tid; e < 9 * 64; e += 512) {
        const int r = e >> 6, c = e & 63;
        float v = 0.f;
#pragma unroll
        for (int q = 0; q < 8; ++q) v += red[(q * 9 + r) * 64 + c];
        const int cc = (item % 96) * 64 + c;
        p.modv[(size_t)(layer * 9 + r) * 6144 + cc] = v + p.ada_b[layer * 6144 + cc];
    }
}
__device__ __forceinline__ void job_rope_tab(const Params& p) {
    for (int e = otid(); e < 1024; e += 512) {
        const int pos = e >> 3, i = e & 7;
        const float invf = powf(10000.f, -(float)i / 8.f);
        const float ang = (float)pos * invf;
        p.rope_tab[e * 2] = cosf(ang); p.rope_tab[e * 2 + 1] = sinf(ang);
    }
}
__device__ __forceinline__ void job_s5_tables(const Params& p, int item, char* smem) {
    float2* s_pw = (float2*)smem;
    float2* s_bb = s_pw + 64 * 65;
    float2* s_cc = s_bb + 64 * 16;
    const int tid = otid();
    const int dir = item & 1, g = (item >> 1) & 15, l = item >> 5;
    const int lg = (l * 2 + dir) * 16 + g;
    const int og = (l * 16 + g) * 2 + dir;
    const float step = expf(p.log_step[lg]);
    for (int e = tid; e < 64 * 65; e += 512) {
        const int pp = e / 65, d = e - pp * 65;
        const float lr = p.lam_re[lg * 64 + pp] * step, li = p.lam_im[lg * 64 + pp] * step;
        const float mag = expf(lr * (float)d), ang = li * (float)d;
        const float2 v = make_float2(mag * cosf(ang), mag * sinf(ang));
        s_pw[e] = v; ((float2*)p.pw)[(size_t)og * 64 * 65 + e] = v;
    }
    for (int e = tid; e < 1024; e += 512) {
        const int pp = e >> 4;
        const float lre = p.lam_re[lg * 64 + pp], lim = p.lam_im[lg * 64 + pp];
        const float lr = lre * step, li = lim * step;
        const float mag = expf(lr);
        const float ar = mag * cosf(li) - 1.f, ai = mag * sinf(li);
        const float den = 1.f / (lre * lre + lim * lim);
        const float qr = (ar * lre + ai * lim) * den, qi = (ai * lre - ar * lim) * den;
        const float br = p.b_re[(size_t)lg * 1024 + e], bi = p.b_im[(size_t)lg * 1024 + e];
        const float2 v = make_float2(qr * br - qi * bi, qr * bi + qi * br);
        s_bb[e] = v; ((float2*)p.bbar)[(size_t)og * 1024 + e] = v;
        s_cc[e] = make_float2(p.c_re[(size_t)lg * 1024 + e], p.c_im[(size_t)lg * 1024 + e]);
    }
    __syncthreads();
    for (int q = 0; q < 32; ++q) {
        const int idx = tid + 512 * q, d = idx >> 8, c = (idx >> 4) & 15, c2 = idx & 15;
        float acc = 0.f;
        for (int pp = 0; pp < 64; ++pp) {
            const float2 C = s_cc[c * 64 + pp], P = s_pw[pp * 65 + d], B = s_bb[pp * 16 + c2];
            const float xr = C.x * P.x - C.y * P.y, xi = C.x * P.y + C.y * P.x;
            acc += xr * B.x - xi * B.y;
        }
        p.klag[(size_t)og * 16384 + idx] = acc;
    }
}
__device__ __forceinline__ void job_s5_expand(const Params& p, int l, int item) {
    const int tid = otid(), g = item >> 6, i = item & 63;
    const float* kf = p.klag + (size_t)((l * 16 + g) * 2 + 0) * 16384;
    const float* kb = p.klag + (size_t)((l * 16 + g) * 2 + 1) * 16384;
    {
        const int c = tid >> 5, kk = tid & 31;
        const float dsk = p.s5_d[l * 256 + g * 16 + c];
#pragma unroll
        for (int q = 0; q < 4; ++q) {
            const int col0 = kk * 8 + 256 * q, j = col0 >> 4, c0 = col0 & 15;
            float v[8];
#pragma unroll
            for (int e = 0; e < 8; ++e) {
                const int c2 = c0 + e;
                float a = 0.f;
                if (j <= i) a += kf[(i - j) * 256 + c * 16 + c2];
                if (j >= i) a += kb[(j - i) * 256 + c * 16 + c2];
                if (j == i && c2 == c) a += dsk;
                v[e] = a;
            }
            u32x4 o = {pk2(v[0], v[1]), pk2(v[2], v[3]), pk2(v[4], v[5]), pk2(v[6], v[7])};
            *(u32x4*)(p.wg + ((size_t)g * 1024 + i * 16 + c) * 1024 + col0) = o;
        }
    }
    {
        const int c = tid >> 5, col0 = (tid & 31) * 8;
        const int dir = col0 >> 7, ri = (col0 >> 6) & 1, p0 = col0 & 63;
        const int lg = (l * 2 + dir) * 16 + g, og = (l * 16 + g) * 2 + dir;
        const int e = dir ? 64 - i : i + 1;
        float v[8];
#pragma unroll
        for (int u = 0; u < 8; ++u) {
            const int pp = p0 + u;
            const float cr = p.c_re[(size_t)lg * 1024 + c * 64 + pp], ci = p.c_im[(size_t)lg * 1024 + c * 64 + pp];
            const float2 P = ((const float2*)p.pw)[(size_t)og * 64 * 65 + pp * 65 + e];
            v[u] = ri ? -(cr * P.y + ci * P.x) : (cr * P.x - ci * P.y);
        }
        u32x4 o = {pk2(v[0], v[1]), pk2(v[2], v[3]), pk2(v[4], v[5]), pk2(v[6], v[7])};
        *(u32x4*)(p.eg + ((size_t)g * 1024 + i * 16 + c) * 256 + col0) = o;
    }
    {
        const int n2 = 4 * i + (tid >> 7), col0 = (tid & 127) * 8;
        const int dir = n2 >> 7, ri = (n2 >> 6) & 1, pp = n2 & 63;
        const int og = (l * 16 + g) * 2 + dir;
        const int j = col0 >> 4, c0 = col0 & 15;
        const int pe = dir ? j : 63 - j;
        const float2 P = ((const float2*)p.pw)[(size_t)og * 64 * 65 + pp * 65 + pe];
        float v[8];
#pragma unroll
        for (int u = 0; u < 8; ++u) {
            const float2 B = ((const float2*)p.bbar)[(size_t)og * 1024 + pp * 16 + c0 + u];
            v[u] = ri ? (P.x * B.y + P.y * B.x) : (P.x * B.x - P.y * B.y);
        }
        u32x4 o = {pk2(v[0], v[1]), pk2(v[2], v[3]), pk2(v[4], v[5]), pk2(v[6], v[7])};
        *(u32x4*)(p.gg + ((size_t)g * 256 + n2) * 1024 + col0) = o;
    }
}

template <class SrcCol, class DstRow>
__device__ __forceinline__ void cvt_tile(const float* src, int ld_src, bf16* dst, int ld_dst, int k0, int n0, int nvalid, SrcCol sc, DstRow dr, const float* kscale, char* smem, bf16* dst_lo = nullptr) {
    float* sm = (float*)smem;
    const int tid = otid();
    {
        const int n = tid & 63, kk = tid >> 6;
        const bool ok = (n0 + n) < nvalid;
        const int col = ok ? sc(n0 + n) : 0;
#pragma unroll
        for (int i = 0; i < 8; ++i) {
            const int k = kk + 8 * i;
            float v = ok ? src[(size_t)(k0 + k) * ld_src + col] : 0.f;
            if (kscale) v *= kscale[k0 + k];
            sm[k * 65 + n] = v;
        }
    }
    __syncthreads();
    {
        const int k = tid & 63, nn = tid >> 6;
#pragma unroll
        for (int i = 0; i < 8; ++i) {
            const int n = nn + 8 * i;
            const float v = sm[k * 65 + n];
            const bf16 hi = f2bf(v);
            dst[(size_t)dr(n0 + n) * ld_dst + k0 + k] = hi;
            if (dst_lo) dst_lo[(size_t)dr(n0 + n) * ld_dst + k0 + k] = f2bf(v - bf2f(hi));
        }
    }
    __syncthreads();
}
struct IdMap { __device__ __forceinline__ int operator()(int n) const { return n; } };
struct InColMap {
    __device__ __forceinline__ int operator()(int n) const {
        if (n < 640 || n >= 672) return n;
        const int r = n - 640, ax = r >> 4, q = r & 15, i = q >> 1, t = q & 1;
        return 640 + ax * 16 + t * 8 + i;
    }
};
struct QColMap {
    __device__ __forceinline__ int operator()(int n) const {
        const int hd = n / 96, d = n - hd * 96;
        if (d < 64) return n;
        const int r = d - 64, ax = r >> 4, q = r & 15, i = q >> 1, t = q & 1;
        return hd * 96 + 64 + ax * 16 + t * 8 + i;
    }
};
struct UpRowMap {
    int t; __device__ __forceinline__ int operator()(int j) const { return (j >> 4) * 32 + t * 16 + (j & 15); }
};
struct DnRowMap {
    __device__ __forceinline__ int operator()(int n) const { return ((n & 255) >> 2) * 16 + (n >> 8) * 4 + (n & 3); }
};
template <class SrcCol, class DstRow>
__device__ __forceinline__ void cvt_tile256(const float* src, int ld_src, bf16* dst, int ld_dst, int k0, int n0, int nvalid, SrcCol sc, DstRow dr, const float* kscale, char* smem) {
    float* sm = (float*)smem;
    const int tid = otid();
    {
        const int n4 = (tid & 63) * 4, kk = tid >> 6;
        const int n = n0 + n4;
        const bool ok = n < nvalid;
        const bool vec = ok && sc(n) == n && sc(n + 3) == n + 3;
#pragma unroll
        for (int i = 0; i < 8; ++i) {
            const int k = kk + 8 * i;
            f32x4 v = {0.f, 0.f, 0.f, 0.f};
            const float* row = src + (size_t)(k0 + k) * ld_src;
            if (vec) v = __builtin_nontemporal_load((const f32x4*)(row + n));
            else if (ok) { v[0] = row[sc(n)]; v[1] = row[sc(n + 1)]; v[2] = row[sc(n + 2)]; v[3] = row[sc(n + 3)]; }
            if (kscale) { const float ks = kscale[k0 + k]; v[0] *= ks; v[1] *= ks; v[2] *= ks; v[3] *= ks; }
            float* d = sm + k * 257 + n4;
            d[0] = v[0]; d[1] = v[1]; d[2] = v[2]; d[3] = v[3];
        }
    }
    __syncthreads();
    {
        const int kch = tid & 7, nn = tid >> 3;
#pragma unroll
        for (int i = 0; i < 4; ++i) {
            const int n = nn + 64 * i;
            const float* c = sm + (kch * 8) * 257 + n;
            u32x4 o = {pk2(c[0], c[257]), pk2(c[2 * 257], c[3 * 257]), pk2(c[4 * 257], c[5 * 257]), pk2(c[6 * 257], c[7 * 257])};
            *(u32x4*)(dst + (size_t)dr(n0 + n) * ld_dst + k0 + kch * 8) = o;
        }
    }
    __syncthreads();
}
#define CVT_N_IN   (16 * 7)
#define CVT_N_Q    (4 * 3)
#define CVT_N_KV   (2 * 4)
#define CVT_N_GLU  (4 * 1)
#define CVT_N_OUT  (16 * 4)
#define CVT_N_R    (16 * 2)
#define CVT_N_UP   (130 * 16)
#define CVT_N_DN   (65 * 4 * 4)
#define CVT_TOTAL  (CVT_N_IN + CVT_N_Q + CVT_N_KV + CVT_N_GLU + CVT_N_OUT + CVT_N_R + CVT_N_UP + CVT_N_DN)
#define CVT_EXPERT (CVT_N_UP + CVT_N_DN)
#define CVT_SMALL (CVT_TOTAL - CVT_EXPERT)
__device__ __forceinline__ void job_cvt_expert(const Params& p, int l, int item, char* smem) {
    int it = item;
    if (it < CVT_N_UP) {
        const int et = it / 16, kt = it % 16, e = et >> 1, t = et & 1;
        const float* src = e < 64 ? (t ? p.ew_up : p.ew_gate) + ((size_t)l * 64 + e) * 1024 * 256 : (t ? p.sw_up : p.sw_gate) + (size_t)l * 1024 * 256;
        UpRowMap rm; rm.t = t;
        cvt_tile256(src, 256, p.bt_up + (size_t)e * 512 * 1024, 1024, kt * 64, 0, 256, IdMap(), rm, nullptr, smem); return;
    }
    it -= CVT_N_UP;
    {
        const int e = it / 16, r = it % 16, kt = r / 4, nt = r % 4;
        const float* src = e < 64 ? p.ew_down + ((size_t)l * 64 + e) * 256 * 1024 : p.sw_down + (size_t)l * 256 * 1024;
        cvt_tile256(src, 1024, p.bt_dn + (size_t)e * 1024 * 256, 256, kt * 64, nt * 256, 1024, IdMap(), DnRowMap(), nullptr, smem);
    }
}
__device__ __forceinline__ void job_cvt_small(const Params& p, int l, int item, char* smem) {
    int it = item;
    if (it < CVT_N_IN) { const int kt = it / 7, nt = it % 7; cvt_tile256(p.w_in + (size_t)l * 1024 * NIN, NIN, p.bt_in, 1024, kt * 64, nt * 256, NIN, InColMap(), IdMap(), nullptr, smem); return; }
    it -= CVT_N_IN;
    if (it < CVT_N_Q) { const int kt = it / 3, nt = it % 3; cvt_tile256(p.w_q_up + (size_t)l * 256 * 768, 768, p.bt_q, 256, kt * 64, nt * 256, 768, QColMap(), IdMap(), p.q_norm + l * 256, smem); return; }
    it -= CVT_N_Q;
    if (it < CVT_N_KV) { const int kt = it / 4, nt = it % 4; cvt_tile256(p.w_kv_up + (size_t)l * 128 * 1024, 1024, p.bt_kv, 128, kt * 64, nt * 256, 1024, IdMap(), IdMap(), p.kv_norm + l * 128, smem); return; }
    it -= CVT_N_KV;
    if (it < CVT_N_GLU) { const int kt = it; cvt_tile256(p.glu_w + (size_t)l * 256 * 256, 256, p.bt_glu, 256, kt * 64, 0, 256, IdMap(), IdMap(), nullptr, smem); return; }
    it -= CVT_N_GLU;
    if (it < CVT_N_OUT) { const int kt = it / 4, nt = it % 4; cvt_tile256(p.w_out + (size_t)l * 1024 * 1024, 1024, p.bt_out, 1024, kt * 64, nt * 256, 1024, IdMap(), IdMap(), nullptr, smem); return; }
    it -= CVT_N_OUT;
    { const int kt = it / 2, nt = it % 2; if (nt == 0) cvt_tile(p.router_w + (size_t)l * 1024 * 64, 64, p.bt_rhi, 1024, kt * 64, 0, 64, IdMap(), IdMap(), nullptr, smem, p.bt_rlo); }
}

__device__ __forceinline__ void phase_post_inproj(const Params& p, int l, int item) {
    const int tid = otid(), lane = tid & 63, wave = tid >> 6;
    int t0, t1; wave_token_range(wave, t0, t1); (void)item;
    for (int tb = t0; tb < t1; tb += 4) {
        u32x2 qv4[4]; unsigned kv4[4], kr4[4];
#pragma unroll
        for (int i = 0; i < 4; ++i) {
            const int tok = (tb + i < t1) ? tb + i : t1 - 1;
            const bf16* zr = p.z + (size_t)tok * ZW;
            qv4[i] = __builtin_nontemporal_load((const u32x2*)(zr + Z_QC + 4 * lane));
            kv4[i] = __builtin_nontemporal_load((const unsigned*)(zr + Z_KVC + 2 * lane));
            kr4[i] = *(const unsigned*)(zr + Z_KR + 2 * (lane & 15));
        }
#pragma unroll
        for (int i = 0; i < 4; ++i) {
            const int tok = tb + i;
            if (tok < t1) {
                const int b = tok / SQ, s = tok - b * SQ;
                const u32x2 qv = qv4[i];
                float ss = bflo(qv[0]) * bflo(qv[0]) + bfhi(qv[0]) * bfhi(qv[0]) + bflo(qv[1]) * bflo(qv[1]) + bfhi(qv[1]) * bfhi(qv[1]);
                ss = wave_sum(ss);
                const unsigned kv = kv4[i];
                float s2 = bflo(kv) * bflo(kv) + bfhi(kv) * bfhi(kv);
                s2 = wave_sum(s2);
                if (lane == 0) { p.rq[tok] = rsqrtf(ss * (1.f / 256.f) + 1e-6f); p.rkv[tok] = rsqrtf(s2 * (1.f / 128.f) + 1e-6f); }
                if (lane < 16) {
                    const unsigned kr = kr4[i];
                    float v0 = bflo(kr), v1 = bfhi(kr);
                    if (s >= CTXL) {
                        const int ax = lane >> 3, ii = lane & 7, sl = s - CTXL, pos = ax ? (sl & 63) : (sl >> 6);
                        const float cs = p.rope_tab[(pos * 8 + ii) * 2], sn = p.rope_tab[(pos * 8 + ii) * 2 + 1];
                        const float a0 = v0 * cs - v1 * sn, a1 = v0 * sn + v1 * cs; v0 = a0; v1 = a1;
                    }
                    const unsigned o = pk2(v0, v1);
#pragma unroll
                    for (int hd = 0; hd < 8; ++hd) *(unsigned*)(p.kf + ((size_t)(b * 8 + hd) * SQ + s) * 96 + 64 + 2 * lane) = o;
                }
            }
        }
    }
    const float* cw = p.conv_w + (size_t)l * 3 * 512; const float* cb = p.conv_b + l * 512;
    const int bt0 = (int)(((long)NTOK * blockIdx.x) / gridDim.x), bt1 = (int)(((long)NTOK * (blockIdx.x + 1)) / gridDim.x);
    const int nq = (bt1 - bt0) * 64;
    for (int q0 = tid; q0 < nq; q0 += 1024) {
        u32x4 cur2[2], prv2[2], nxt2[2];
#pragma unroll
        for (int i = 0; i < 2; ++i) {
            const int q = (q0 + 512 * i < nq) ? q0 + 512 * i : q0;
            const int tok = bt0 + (q >> 6), ch0 = (q & 63) * 8;
            const int b = tok / SQ, s = tok - b * SQ;
            const bool hasp = (s != 0) && (s != CTXL), hasn = (s != CTXL - 1) && (s != SQ - 1);
            const bf16* zr = p.z + (size_t)tok * ZW + Z_MLQ + ch0;
            const u32x4 zz = {0u, 0u, 0u, 0u};
            cur2[i] = *(const u32x4*)zr; prv2[i] = zz; nxt2[i] = zz;
            if (hasp) prv2[i] = *(const u32x4*)(zr - ZW);
            if (hasn) nxt2[i] = *(const u32x4*)(zr + ZW);
        }
#pragma unroll
        for (int i = 0; i < 2; ++i) {
            const int q = q0 + 512 * i;
            if (q < nq) {
                const int tok = bt0 + (q >> 6), ch0 = (q & 63) * 8;
                const u32x4 cur = cur2[i], prv = prv2[i], nxt = nxt2[i];
                const float ksc = ch0 >= 256 ? 0.125f : 1.f;
                float o[8];
#pragma unroll
                for (int e = 0; e < 8; ++e) {
                    const unsigned pc = prv[e >> 1], cc = cur[e >> 1], nc = nxt[e >> 1];
                    const float xp = (e & 1) ? bfhi(pc) : bflo(pc), xc = (e & 1) ? bfhi(cc) : bflo(cc), xn = (e & 1) ? bfhi(nc) : bflo(nc);
                    const int ch = ch0 + e;
                    const float a = cb[ch] + cw[ch] * xp + cw[512 + ch] * xc + cw[1024 + ch] * xn;
                    o[e] = siluf_(a) * ksc;
                }
                u32x4 ov = {pk2(o[0], o[1]), pk2(o[2], o[3]), pk2(o[4], o[5]), pk2(o[6], o[7])};
                *(u32x4*)(p.qkc + (size_t)tok * 512 + ch0) = ov;
            }
        }
    }
}

__device__ __forceinline__ int chain_chunk(int dir, int step) { return dir == 0 ? step : (step < 4 ? 3 - step : NCH + 3 - step); }

__device__ __forceinline__ void job_s5_carry(const Params& p, int l, int item) {
    const int id = item * 512 + otid();
    const int pp = id & 63, dir = (id >> 6) & 1, g = (id >> 7) & 15, b = id >> 11;
    const float2 a64 = ((const float2*)p.pw)[(size_t)((l * 16 + g) * 2 + dir) * 64 * 65 + pp * 65 + 64];
    float sr = 0.f, si = 0.f;
    const size_t base = (size_t)g * NROWP * 256 + dir * 128 + pp;
    for (int s0 = 0; s0 < NCH; s0 += 12) {
        float fr[12], fi[12];
#pragma unroll
        for (int u = 0; u < 12; ++u) { const size_t o = base + (size_t)(b * NCH + chain_chunk(dir, s0 + u)) * 256; fr[u] = p.ff[o]; fi[u] = p.ff[o + 64]; }
#pragma unroll
        for (int u = 0; u < 12; ++u) {
            const size_t o = base + (size_t)(b * NCH + chain_chunk(dir, s0 + u)) * 256;
            p.sin_[o] = f2bf(sr); p.sin_[o + 64] = f2bf(si);
            const float nr = a64.x * sr - a64.y * si + fr[u], ni = a64.x * si + a64.y * sr + fi[u];
            sr = nr; si = ni;
        }
    }
}
__device__ __forceinline__ void job_ml_carry(const Params& p, int item) {
    const int chain = item >> 2, part = item & 3, tid = otid();
    const int dir = chain & 1;
    if (tid >= 260) return;
    const size_t eoff = (size_t)part * 1040 + tid * 4;
    float c0 = 0.f, c1 = 0.f, c2 = 0.f, c3 = 0.f, m = 0.f;
    for (int s0 = 0; s0 < NCH; s0 += 12) {
        u32x2 lv[12]; float ml[12], bl[12];
#pragma unroll
        for (int u = 0; u < 12; ++u) {
            const size_t un = (size_t)chain * NCH + chain_chunk(dir, s0 + u);
            lv[u] = *(const u32x2*)(p.cloc + un * CLOC_STRIDE + eoff); ml[u] = p.mlstat[un * 4]; bl[u] = p.mlstat[un * 4 + 1];
        }
#pragma unroll
        for (int u = 0; u < 12; ++u) {
            const size_t un = (size_t)chain * NCH + chain_chunk(dir, s0 + u);
            u32x2 o = {pk2(c0, c1), pk2(c2, c3)};
            *(u32x2*)(p.cloc + un * CLOC_STRIDE + eoff) = o;
            if (part == 0 && tid == 0) p.mlstat[un * 4 + 2] = m;
            const float mn = fmaxf(bl[u] + m, ml[u]);
            const float a = fexp(bl[u] + m - mn), sc = fexp(ml[u] - mn);
            c0 = a * c0 + sc * bflo(lv[u][0]); c1 = a * c1 + sc * bfhi(lv[u][0]); c2 = a * c2 + sc * bflo(lv[u][1]); c3 = a * c3 + sc * bfhi(lv[u][1]); m = mn;
        }
    }
}

__device__ __forceinline__ int scan_sum_i(int v, int lane) {
    (void)lane;
    v += dppi<0x111, 0xf>(0, v); v += dppi<0x112, 0xf>(0, v); v += dppi<0x114, 0xf>(0, v); v += dppi<0x118, 0xf>(0, v);
    v += dppi<0x142, 0xa>(0, v); v += dppi<0x143, 0xc>(0, v);
    return v;
}
__device__ __forceinline__ void phase_route(const Params& p, int l, int item, char* smem) {
    const int lane = otid() & 63, wave = otid() >> 6;
    const float bias = p.router_bias[l * 64 + lane];
    const float NEG = -__builtin_inff();
    int t0, t1; wave_token_range(wave, t0, t1); (void)item;
    int* wl = (int*)(smem + wave * 2048);
    int cnt = 0, seg0 = t0, curb = (t0 < t1) ? t0 / SQ : 0;
    auto flush = [&](int ta, int tb_, int bb) {
        const int base = cnt ? atomicAdd(&p.moe_cnt[(l * 8 + bb) * 64 + lane], cnt) : 0;
        for (int tok = ta; tok < tb_; ++tok) {
            if (l == 1 && tok - bb * SQ < CTXL) continue;
            const int v = (lane < 8) ? wl[(tok - t0) * 8 + lane] : 0;
            const int bs = __shfl(base, v & 63, 64);
            if (lane < 8) p.pos[tok * 8 + lane] = (v >> 6) + bs;
        }
        cnt = 0;
    };
    float lg4[4];
#pragma unroll
    for (int i = 0; i < 4; ++i) lg4[i] = (t0 + i < t1) ? __builtin_nontemporal_load(p.logits + (size_t)(t0 + i) * 64 + lane) : 0.f;
    for (int tb = t0; tb < t1; tb += 4)
#pragma unroll
    for (int ti = 0; ti < 4; ++ti) {
        const int tok = tb + ti;
        if (tok >= t1) break;
        const float lg = lg4[ti];
        if (tok + 4 < t1) lg4[ti] = __builtin_nontemporal_load(p.logits + (size_t)(tok + 4) * 64 + lane);
        const int b = tok / SQ;
        if (b != curb) { flush(seg0, tok, curb); seg0 = tok; curb = b; }
        if (l == 1 && tok - b * SQ < CTXL) continue;
        const float sc = 1.f / (1.f + expf(-lg));
        const float bs = sc + bias;
        float m1 = bs;
        m1 = fmaxf(m1, dppf<0xB1, 0xf>(m1, m1)); m1 = fmaxf(m1, dppf<0x4E, 0xf>(m1, m1)); m1 = fmaxf(m1, dppf<0x141, 0xf>(m1, m1));
        const unsigned long long gm = 0xFFull << (lane & ~7);
        const unsigned long long bal = __ballot(bs == m1) & gm;
        const int first = __ffsll((long long)bal) - 1;
        float m2 = (lane == first) ? NEG : bs;
        m2 = fmaxf(m2, dppf<0xB1, 0xf>(m2, m2)); m2 = fmaxf(m2, dppf<0x4E, 0xf>(m2, m2)); m2 = fmaxf(m2, dppf<0x141, 0xf>(m2, m2));
        const float gsc = m1 + m2;
        const int G = lane >> 3;
        int rank = 0;
#pragma unroll
        for (int g2 = 0; g2 < 8; ++g2) { const float o = readlane_f(gsc, g2 * 8); rank += (o > gsc || (o == gsc && g2 < G)) ? 1 : 0; }
        const float masked = (rank < 4) ? bs : NEG;
        int rk = 0;
#pragma unroll
        for (int j = 0; j < 64; ++j) { const float o = readlane_f(masked, j); rk += (o > masked || (o == masked && j < lane)) ? 1 : 0; }
        const bool sel = rk < 8;
        const float tot = wave_sum(sel ? sc : 0.f);
        if (sel) {
            wl[(tok - t0) * 8 + rk] = lane | (cnt << 6);
            p.tope[tok * 8 + rk] = lane; p.gatew[tok * 8 + rk] = sc / tot * 2.5f;
            ++cnt;
        }
    }
    if (seg0 < t1) flush(seg0, t1, curb);
}
__device__ __forceinline__ void job_tiles(const Params& p, int l, int b, int* s_int) {
    const int tid = otid();
    const int* cnt = p.moe_cnt + (l * 8 + b) * 64;
    if (tid < 64) {
        int* ue = p.up_e + b * UPU_STRIDE; int* ur = p.up_row + b * UPU_STRIDE;
        const int n256 = (cnt[tid] + 255) >> 8;
        const int incl = scan_sum_i(n256, tid), k0 = incl - n256, t = 2 * k0;
        s_int[tid] = t;
        for (int u = 0; u < n256; ++u) { ue[k0 + u] = tid; ur[k0 + u] = (t + 2 * u) * MOE_BM; }
        const int ktot = __builtin_amdgcn_readlane(incl, 63), ttot = 2 * ktot;
        if (tid == 63) { s_int[64] = ttot; p.up_n[b] = ktot + SQ / 256; p.ntb[b * 2] = ttot + SQ / MOE_BM; p.ntb[b * 2 + 1] = ttot * MOE_BM; }
        if (tid < SQ / 256) { ue[ktot + tid] = 64; ur[ktot + tid] = (ttot + 2 * tid) * MOE_BM; }
    }
    __syncthreads();
    if (tid < 64) { for (int t = s_int[tid]; t < s_int[tid + 1]; ++t) p.tile_e[b * MOE_TILES + t] = ((t - s_int[tid]) * MOE_BM < cnt[tid]) ? tid : -1; }
    const int t0 = s_int[64];
    if (tid < SQ / MOE_BM) p.tile_e[b * MOE_TILES + t0 + tid] = 64;
    if (tid < 8) {
        int* lst = p.xl_tile + (size_t)(b * 8 + tid) * XL_STRIDE; int k = 0;
        for (int e = tid; e < 64; e += 8) for (int t = s_int[e]; t < s_int[e + 1]; ++t) if ((t - s_int[e]) * MOE_BM < cnt[e]) lst[k++] = t;
        for (int j = tid; j < SQ / MOE_BM; j += 8) lst[k++] = t0 + j;
        p.xl_cnt[b * 8 + tid] = k;
    }
    __syncthreads();
}
__device__ __forceinline__ void job_slots(const Params& p, int l, int item, int* s_int) {
    (void)item;
    const int tid = otid();
    const int G = gridDim.x, t0 = (int)(((long)NTOK * blockIdx.x) / G), t1 = (int)(((long)NTOK * (blockIdx.x + 1)) / G);
    int cb = -1, base = t0;
    while (base < t1) {
        const int b = base / SQ;
        const int lim = t1 < (b + 1) * SQ ? t1 : (b + 1) * SQ;
        const int cnt = (lim - base) < 64 ? (lim - base) : 64;
        if (b != cb) {
            __syncthreads();
            if (tid < 64) {
                const int n = 2 * ((p.moe_cnt[(l * 8 + b) * 64 + tid] + 255) >> 8);
                const int incl = scan_sum_i(n, tid);
                s_int[tid] = (incl - n) * MOE_BM;
                if (tid == 63) s_int[64] = incl * MOE_BM;
            }
            __syncthreads();
            cb = b;
        }
        const int tok = base + (tid >> 3), k = tid & 7;
        if ((tid >> 3) < cnt && !(l == 1 && tok - b * SQ < CTXL)) {
            const int e = p.tope[tok * 8 + k];
            const int slot = s_int[e] + p.pos[tok * 8 + k];
            p.slottok[(size_t)b * MOE_SLOTS + slot] = tok;
            p.slotgate[(size_t)b * MOE_SLOTS + slot] = p.gatew[tok * 8 + k];
            p.tokslot[tok * 8 + k] = slot;
            if (k == 0) {
                const int s = tok - b * SQ, sl2 = s_int[64] + s;
                p.slottok[(size_t)b * MOE_SLOTS + sl2] = tok;
                p.slotgate[(size_t)b * MOE_SLOTS + sl2] = 1.f;
            }
        }
        base += cnt;
    }
    __syncthreads();
}

#define AT_KROW 208
#define AT_VROW 136
#define AT_BUF (64 * AT_KROW + 64 * AT_VROW)
template <int VAR>
__device__ __forceinline__ void attn_item(const Params& p, int bh, int qt, char* smem) {
    const int tid = otid(), lane = tid & 63, wave = tid >> 6, r = lane & 31, h = lane >> 5;
    const int nkt = (qt == 0) ? (CTXL / 64) : (SQ / 64);
    const int s = qt * 256 + wave * 32 + r;
    const bf16* qrow = p.q + ((size_t)(bh >> 3) * SQ + s) * 768 + (bh & 7) * 96;
    bf16x8 qf[6];
#pragma unroll
    for (int ks = 0; ks < 6; ++ks) qf[ks] = *(const bf16x8*)(qrow + ks * 16 + h * 8);
    const bf16* kbase = p.kf + (size_t)bh * SQ * 96;
    const bf16* vbase = p.vt + (size_t)bh * 64 * SQ;
    const int kkey0 = tid / 12, kpart0 = tid % 12, kkey1 = (tid + 512) / 12, kpart1 = (tid + 512) % 12;
    const int vd = tid >> 3, vpart = tid & 7;
    u32x4 rk0, rk1 = {0u, 0u, 0u, 0u}, rv;
    auto gload = [&](int t) {
        const bf16* kb = kbase + (size_t)t * 64 * 96;
        rk0 = *(const u32x4*)(kb + tid * 8);
        if (tid < 256) rk1 = *(const u32x4*)(kb + (tid + 512) * 8);
        rv = *(const u32x4*)(vbase + (size_t)vd * SQ + t * 64 + vpart * 8);
    };
    auto lstore = [&](int buf) {
        char* base = smem + buf * AT_BUF;
        *(u32x4*)(base + kkey0 * AT_KROW + kpart0 * 16) = rk0;
        if (tid < 256) *(u32x4*)(base + kkey1 * AT_KROW + kpart1 * 16) = rk1;
        char* vb = base + 64 * AT_KROW + vd * AT_VROW + vpart * 16;
        u32x2 a = {rv[0], rv[1]}, b2 = {rv[2], rv[3]};
        *(u32x2*)vb = a; *(u32x2*)(vb + 8) = b2;
    };
    f32x16 o[2];
#pragma unroll
    for (int d = 0; d < 2; ++d)
#pragma unroll
        for (int q = 0; q < 16; ++q) o[d][q] = 0.f;
    float m = -1e30f;
    f32x16 lacc;
#pragma unroll
    for (int q = 0; q < 16; ++q) lacc[q] = 0.f;
    const u32x4 ones4 = {0x3F803F80u, 0x3F803F80u, 0x3F803F80u, 0x3F803F80u};
    const bf16x8 onesf = (bf16x8)ones4;
    gload(0);
    __syncthreads();
    lstore(0);
    __syncthreads();
    for (int t = 0; t < nkt; ++t) {
        if (t + 1 < nkt) gload(t + 1);
        const char* base = smem + (t & 1) * AT_BUF;
        f32x16 sacc[2];
        bf16x8 kfr[2][6];
#pragma unroll
        for (int kb = 0; kb < 2; ++kb)
#pragma unroll
            for (int ks = 0; ks < 6; ++ks) kfr[kb][ks] = *(const bf16x8*)(base + (kb * 32 + r) * AT_KROW + ks * 32 + h * 16);
        asm volatile("" ::: "memory");
#pragma unroll
        for (int kb = 0; kb < 2; ++kb)
#pragma unroll
            for (int q = 0; q < 16; ++q) sacc[kb][q] = 0.f;
#pragma unroll
        for (int ks = 0; ks < 6; ++ks) {
            sacc[0] = MFMA32(kfr[0][ks], qf[ks], sacc[0]);
            sacc[1] = MFMA32(kfr[1][ks], qf[ks], sacc[1]);
        }
        const char* vb = base + 64 * AT_KROW;
        bf16x8 vfr[2][2][2];
#pragma unroll
        for (int kb = 0; kb < 2; ++kb)
#pragma unroll
            for (int s2 = 0; s2 < 2; ++s2)
#pragma unroll
                for (int d = 0; d < 2; ++d) {
                    const char* a = vb + (d * 32 + r) * AT_VROW + (kb * 32 + 16 * s2 + 4 * h) * 2;
                    const u32x2 lo = *(const u32x2*)a, hi = *(const u32x2*)(a + 16);
                    u32x4 t4 = {lo[0], lo[1], hi[0], hi[1]};
                    vfr[d][kb][s2] = (bf16x8)t4;
                }
        asm volatile("" ::: "memory");
        float mx = fmaxf(sacc[0][0], sacc[1][0]);
        if (VAR != 1) {
#pragma unroll
        for (int q = 1; q < 16; ++q) mx = fmaxf(fmaxf(mx, sacc[0][q]), sacc[1][q]);
        {
            typedef unsigned u2_t __attribute__((ext_vector_type(2)));
            const u2_t sw = __builtin_amdgcn_permlane32_swap(__float_as_uint(mx), __float_as_uint(mx), false, false);
            mx = fmaxf(__uint_as_float(sw[0]), __uint_as_float(sw[1]));
        }
        }
        if (VAR != 1 && __any(mx > m + 8.f)) {
            const float mn = fmaxf(m, mx), alpha = fexp2(m - mn);
            m = mn; lacc[0] *= alpha;
#pragma unroll
            for (int d = 0; d < 2; ++d)
#pragma unroll
                for (int q = 0; q < 16; ++q) o[d][q] *= alpha;
        }
        bf16x8 pf[2][2];
#pragma unroll
        for (int kb = 0; kb < 2; ++kb) {
#pragma unroll
            for (int q = 0; q < 16; ++q) if (VAR != 1) sacc[kb][q] = fexp2(sacc[kb][q] - m);
#pragma unroll
            for (int s2 = 0; s2 < 2; ++s2) {
                u32x4 t4 = {pk2(sacc[kb][8 * s2], sacc[kb][8 * s2 + 1]), pk2(sacc[kb][8 * s2 + 2], sacc[kb][8 * s2 + 3]),
                            pk2(sacc[kb][8 * s2 + 4], sacc[kb][8 * s2 + 5]), pk2(sacc[kb][8 * s2 + 6], sacc[kb][8 * s2 + 7])};
                pf[kb][s2] = (bf16x8)t4;
            }
        }
#pragma unroll
        for (int kb = 0; kb < 2; ++kb)
#pragma unroll
            for (int s2 = 0; s2 < 2; ++s2) {
                lacc = MFMA32(onesf, pf[kb][s2], lacc);
                o[0] = MFMA32(vfr[0][kb][s2], pf[kb][s2], o[0]);
                o[1] = MFMA32(vfr[1][kb][s2], pf[kb][s2], o[1]);
            }
        if (t + 1 < nkt) lstore((t + 1) & 1);
        __syncthreads();
    }
    const float inv = 1.f / lacc[0];
    const int b = bh >> 3, hd = bh & 7;
    bf16* orow = (VAR == 0 ? p.cat : p.yc) + ((size_t)b * SQ + s) * 1024 + 256 + hd * 64;
#pragma unroll
    for (int d = 0; d < 2; ++d)
#pragma unroll
        for (int g = 0; g < 4; ++g) st_bf4(orow + d * 32 + 8 * g + 4 * h, o[d][4 * g] * inv, o[d][4 * g + 1] * inv, o[d][4 * g + 2] * inv, o[d][4 * g + 3] * inv);
}

__device__ __forceinline__ void attn_item64(const Params& p, int bh, int qt, char* smem) {
    const int tid = otid(), lane = tid & 63, wave = tid >> 6, r = lane & 31, h = lane >> 5;
    const int nkt = SQ / 64;
    const int s0 = CTXL + qt * 512 + wave * 64 + r;
    bf16x8 qf[2][6];
#pragma unroll
    for (int qb = 0; qb < 2; ++qb) {
        const bf16* qrow = p.q + ((size_t)(bh >> 3) * SQ + s0 + qb * 32) * 768 + (bh & 7) * 96;
#pragma unroll
        for (int ks = 0; ks < 6; ++ks) qf[qb][ks] = *(const bf16x8*)(qrow + ks * 16 + h * 8);
    }
    const bf16* kbase = p.kf + (size_t)bh * SQ * 96;
    const bf16* vbase = p.vt + (size_t)bh * 64 * SQ;
    const int ko1 = 8192 + tid * 8;
    u32x4 rk0, rv; u32x2 rk1;
    auto gload = [&](int t) {
        const char* kb = (const char*)(kbase + (size_t)t * 64 * 96);
        rk0 = *(const u32x4*)(kb + tid * 16);
        rk1 = *(const u32x2*)(kb + ko1);
        rv = *(const u32x4*)(vbase + (size_t)(tid >> 3) * SQ + t * 64 + (tid & 7) * 8);
    };
    auto lstore = [&](int buf) {
        char* base = smem + buf * AT_BUF;
        *(u32x4*)(base + (tid / 12) * AT_KROW + (tid % 12) * 16) = rk0;
        *(u32x2*)(base + (ko1 / 192) * AT_KROW + (ko1 % 192)) = rk1;
        char* vb = base + 64 * AT_KROW + (tid >> 3) * AT_VROW + (tid & 7) * 16;
        u32x2 a = {rv[0], rv[1]}, b2 = {rv[2], rv[3]};
        *(u32x2*)vb = a; *(u32x2*)(vb + 8) = b2;
    };
    f32x16 o[2][2];
#pragma unroll
    for (int qb = 0; qb < 2; ++qb)
#pragma unroll
        for (int d = 0; d < 2; ++d)
#pragma unroll
            for (int q = 0; q < 16; ++q) o[qb][d][q] = 0.f;
    float m[2] = {-1e30f, -1e30f}, lsum[2] = {0.f, 0.f};
    gload(0);
    __syncthreads();
    lstore(0);
    __syncthreads();
    for (int t = 0; t < nkt; ++t) {
        if (t + 1 < nkt) gload(t + 1);
        const char* base = smem + (t & 1) * AT_BUF;
        f32x16 sacc[2][2];
#pragma unroll
        for (int kb = 0; kb < 2; ++kb) {
            bf16x8 kfr[6];
#pragma unroll
            for (int ks = 0; ks < 6; ++ks) kfr[ks] = *(const bf16x8*)(base + (kb * 32 + r) * AT_KROW + ks * 32 + h * 16);
#pragma unroll
            for (int qb = 0; qb < 2; ++qb)
#pragma unroll
                for (int q = 0; q < 16; ++q) sacc[qb][kb][q] = 0.f;
#pragma unroll
            for (int ks = 0; ks < 6; ++ks) {
                sacc[0][kb] = MFMA32(kfr[ks], qf[0][ks], sacc[0][kb]);
                sacc[1][kb] = MFMA32(kfr[ks], qf[1][ks], sacc[1][kb]);
            }
        }
        bf16x8 pf[2][2][2];
#pragma unroll
        for (int qb = 0; qb < 2; ++qb) {
            float mx = fmaxf(sacc[qb][0][0], sacc[qb][1][0]);
#pragma unroll
            for (int q = 1; q < 16; ++q) mx = fmaxf(fmaxf(mx, sacc[qb][0][q]), sacc[qb][1][q]);
            {
                typedef unsigned u2_t __attribute__((ext_vector_type(2)));
                const u2_t sw = __builtin_amdgcn_permlane32_swap(__float_as_uint(mx), __float_as_uint(mx), false, false);
                mx = fmaxf(__uint_as_float(sw[0]), __uint_as_float(sw[1]));
            }
            if (__any(mx > m[qb] + 8.f)) {
                const float mn = fmaxf(m[qb], mx), alpha = fexp2(m[qb] - mn);
                m[qb] = mn; lsum[qb] *= alpha;
#pragma unroll
                for (int d = 0; d < 2; ++d)
#pragma unroll
                    for (int q = 0; q < 16; ++q) o[qb][d][q] *= alpha;
            }
#pragma unroll
            for (int kb = 0; kb < 2; ++kb) {
#pragma unroll
                for (int q = 0; q < 16; ++q) { const float e = fexp2(sacc[qb][kb][q] - m[qb]); sacc[qb][kb][q] = e; lsum[qb] += e; }
#pragma unroll
                for (int s2 = 0; s2 < 2; ++s2) {
                    u32x4 t4 = {pk2(sacc[qb][kb][8 * s2], sacc[qb][kb][8 * s2 + 1]), pk2(sacc[qb][kb][8 * s2 + 2], sacc[qb][kb][8 * s2 + 3]),
                                pk2(sacc[qb][kb][8 * s2 + 4], sacc[qb][kb][8 * s2 + 5]), pk2(sacc[qb][kb][8 * s2 + 6], sacc[qb][kb][8 * s2 + 7])};
                    pf[qb][kb][s2] = (bf16x8)t4;
                }
            }
        }
        const char* vb = base + 64 * AT_KROW;
#pragma unroll
        for (int kb = 0; kb < 2; ++kb)
#pragma unroll
            for (int s2 = 0; s2 < 2; ++s2)
#pragma unroll
                for (int d = 0; d < 2; ++d) {
                    const char* a = vb + (d * 32 + r) * AT_VROW + (kb * 32 + 16 * s2 + 4 * h) * 2;
                    const u32x2 lo = *(const u32x2*)a, hi = *(const u32x2*)(a + 16);
                    u32x4 t4 = {lo[0], lo[1], hi[0], hi[1]};
                    const bf16x8 vf = (bf16x8)t4;
                    o[0][d] = MFMA32(vf, pf[0][kb][s2], o[0][d]);
                    o[1][d] = MFMA32(vf, pf[1][kb][s2], o[1][d]);
                }
        if (t + 1 < nkt) lstore((t + 1) & 1);
        __syncthreads();
    }
    const int b = bh >> 3, hd = bh & 7;
    char* st = smem + 2 * AT_BUF + wave * (64 * 144);
#pragma unroll
    for (int qb = 0; qb < 2; ++qb) {
        float l = lsum[qb]; l += __shfl_xor(l, 32, 64);
        const float inv = 1.f / l;
#pragma unroll
        for (int d = 0; d < 2; ++d)
#pragma unroll
            for (int g = 0; g < 4; ++g) {
                u32x2 v; v[0] = pk2(o[qb][d][4 * g] * inv, o[qb][d][4 * g + 1] * inv); v[1] = pk2(o[qb][d][4 * g + 2] * inv, o[qb][d][4 * g + 3] * inv);
                *(u32x2*)(st + (qb * 32 + r) * 144 + (d * 32 + 8 * g + 4 * h) * 2) = v;
            }
    }
    __builtin_amdgcn_wave_barrier();
    bf16* obase = p.cat + ((size_t)b * SQ + CTXL + qt * 512 + wave * 64) * 1024 + 256 + hd * 64;
#pragma unroll
    for (int it = 0; it < 8; ++it) {
        const int row = it * 8 + (lane >> 3), c8 = lane & 7;
        const u32x4 v = *(const u32x4*)(st + row * 144 + c8 * 16);
        *(u32x4*)(obase + (size_t)row * 1024 + c8 * 8) = v;
    }
    __builtin_amdgcn_wave_barrier();
}

#define ML_ROWB 144
__device__ __forceinline__ float logsigmoid_(float x) { return fminf(x, 0.f) - log1pf(expf(-fabsf(x))); }
__device__ __forceinline__ float scan_sum(float v, int lane) { (void)lane; return dpp_scan_sum(v); }
__device__ __forceinline__ float scan_max(float v, int lane) { (void)lane; return dpp_scan_max(v); }
#define MLA_SLOT (64 * ML_ROWB + 96 * ML_ROWB + 256)
__device__ __forceinline__ void phase_ml_a(const Params& p, int l, int item, char* smem) {
    const int tid = otid(), lane = tid & 63, us = tid >> 7, tl = tid & 127, hw = (tid >> 6) & 1, r = lane & 31, h = lane >> 5;
    const int u = item * 4 + us;
    const int c = u % NCH, dir = (u / NCH) & 1, hd = (u / (NCH * 2)) & 3, b = u / (NCH * 8);
    const int tok0 = b * SQ + c * 64;
    char* sl = smem + us * MLA_SLOT;
    bf16* s_kt = (bf16*)sl; bf16* s_vt = (bf16*)(sl + 64 * ML_ROWB); float* s_e = (float*)(sl + 160 * ML_ROWB);
    const int pq = tl >> 3, part = tl & 7;
    u32x4 kv[4], vv[4];
#pragma unroll
    for (int i = 0; i < 4; ++i) {
        const int pos = pq * 4 + i;
        kv[i] = *(const u32x4*)(p.qkc + (size_t)(tok0 + pos) * 512 + 256 + hd * 64 + part * 8);
        vv[i] = *(const u32x4*)(p.z + (size_t)(tok0 + pos) * ZW + Z_MLV + hd * 64 + part * 8);
    }
    if (hw == 0) {
        const int pos = dir ? 63 - lane : lane, tok = tok0 + pos;
        const float gi = p.gates[(size_t)tok * 16 + dir * 4 + hd] + p.gate_b[l * 16 + dir * 4 + hd];
        const float gf = p.gates[(size_t)tok * 16 + 8 + dir * 4 + hd] + p.gate_b[l * 16 + 8 + dir * 4 + hd];
        const float bc = scan_sum(logsigmoid_(gf), lane);
        const float bl = readlane_f(bc, 63);
        const float we = bl - bc + gi;
        const float ml = wave_max(we);
        s_e[pos] = expf(we - ml);
        if (lane == 0) { p.mlstat[(size_t)u * 4] = ml; p.mlstat[(size_t)u * 4 + 1] = bl; }
    }
    __syncthreads();
    {
        float e[4];
#pragma unroll
        for (int i = 0; i < 4; ++i) e[i] = s_e[pq * 4 + i];
#pragma unroll
        for (int j = 0; j < 8; ++j) {
            float kx[4]; unsigned vx[4];
#pragma unroll
            for (int i = 0; i < 4; ++i) {
                const unsigned kw = kv[i][j >> 1], vw = vv[i][j >> 1];
                kx[i] = ((j & 1) ? bfhi(kw) : bflo(kw)) * e[i];
                vx[i] = (j & 1) ? (vw >> 16) : (vw & 0xffffu);
            }
            u32x2 ko = {pk2(kx[0], kx[1]), pk2(kx[2], kx[3])};
            u32x2 vo = {vx[0] | (vx[1] << 16), vx[2] | (vx[3] << 16)};
            *(u32x2*)((char*)s_kt + (part * 8 + j) * ML_ROWB + pq * 8) = ko;
            *(u32x2*)((char*)s_vt + (part * 8 + j) * ML_ROWB + pq * 8) = vo;
        }
    }
    if (tl < 64) s_vt[64 * 72 + tl] = 0x3F80;
    __syncthreads();
    f32x16 acc[3];
#pragma unroll
    for (int rt = 0; rt < 3; ++rt)
#pragma unroll
        for (int q = 0; q < 16; ++q) acc[rt][q] = 0.f;
#pragma unroll
    for (int ks = 0; ks < 4; ++ks) {
        const bf16x8 ktf = *(const bf16x8*)((const char*)s_kt + (hw * 32 + r) * ML_ROWB + ks * 32 + h * 16);
#pragma unroll
        for (int rt = 0; rt < 3; ++rt) {
            const bf16x8 vtf = *(const bf16x8*)((const char*)s_vt + (rt * 32 + r) * ML_ROWB + ks * 32 + h * 16);
            acc[rt] = MFMA32(vtf, ktf, acc[rt]);
        }
    }
    bf16* cl = p.cloc + (size_t)u * CLOC_STRIDE;
#pragma unroll
    for (int rt = 0; rt < 2; ++rt)
#pragma unroll
        for (int q = 0; q < 16; ++q) { const int d = rt * 32 + (q & 3) + 8 * (q >> 2) + 4 * h; cl[d * 64 + hw * 32 + r] = f2bf(acc[rt][q]); }
    if (h == 0) cl[64 * 64 + hw * 32 + r] = f2bf(acc[2][0]);
}
#define MLC_SLOT (64 * ML_ROWB + 64 * ML_ROWB + 96 * ML_ROWB + 1024)
__device__ __forceinline__ void phase_ml_c(const Params& p, int l, int item, char* smem) {
    const int tid = otid(), lane = tid & 63, us = tid >> 7, tl = tid & 127, hw = (tid >> 6) & 1, r = lane & 31, h = lane >> 5;
    const int pair = us >> 1, dir = us & 1, pr = item * 2 + pair;
    const int c = pr % NCH, hd = (pr / NCH) & 3, b = pr / (NCH * 4);
    const int u = ((b * 4 + hd) * 2 + dir) * NCH + c;
    const int tok0 = b * SQ + c * 64;
    char* sl = smem + us * MLC_SLOT;
    char* s_k = sl; char* s_vt = sl + 64 * ML_ROWB; char* s_ci = sl + 128 * ML_ROWB;
    float* s_bm = (float*)(sl + 224 * ML_ROWB); float* s_a1 = s_bm + 64; float* s_wi = s_bm + 128; float* s_em = s_bm + 192;
    {
        const int pq = tl >> 3, part = tl & 7;
        u32x4 vv[4];
#pragma unroll
        for (int i = 0; i < 4; ++i) {
            const int pos = pq * 4 + i;
            const u32x4 kv = *(const u32x4*)(p.qkc + (size_t)(tok0 + pos) * 512 + 256 + hd * 64 + part * 8);
            *(u32x4*)(s_k + pos * ML_ROWB + part * 16) = kv;
            vv[i] = *(const u32x4*)(p.z + (size_t)(tok0 + pos) * ZW + Z_MLV + hd * 64 + part * 8);
        }
#pragma unroll
        for (int j = 0; j < 8; ++j) {
            unsigned vx[4];
#pragma unroll
            for (int i = 0; i < 4; ++i) { const unsigned vw = vv[i][j >> 1]; vx[i] = (j & 1) ? (vw >> 16) : (vw & 0xffffu); }
            u32x2 vo = {vx[0] | (vx[1] << 16), vx[2] | (vx[3] << 16)};
            *(u32x2*)(s_vt + (part * 8 + j) * ML_ROWB + pq * 8) = vo;
        }
    }
#pragma unroll
    for (int q = 0; q < 5; ++q) {
        const int idx = tl + 128 * q;
        if (idx < 520) { const int row = idx >> 3, part = idx & 7; *(u32x4*)(s_ci + row * ML_ROWB + part * 16) = *(const u32x4*)(p.cloc + (size_t)u * CLOC_STRIDE + row * 64 + part * 8); }
    }
    const int t = hw * 32 + r;
    bf16x8 qf[4];
#pragma unroll
    for (int ks = 0; ks < 4; ++ks) qf[ks] = *(const bf16x8*)(p.qkc + (size_t)(tok0 + t) * 512 + hd * 64 + ks * 16 + h * 8);
    if (hw == 0) {
        const int pos = dir ? 63 - lane : lane, tok = tok0 + pos;
        const float gi = p.gates[(size_t)tok * 16 + dir * 4 + hd] + p.gate_b[l * 16 + dir * 4 + hd];
        const float gf = p.gates[(size_t)tok * 16 + 8 + dir * 4 + hd] + p.gate_b[l * 16 + 8 + dir * 4 + hd];
        const float bc = scan_sum(logsigmoid_(gf), lane);
        const float a1 = gi - bc;
        const float pm = scan_max(a1, lane);
        const float li = bc + p.mlstat[(size_t)u * 4 + 2];
        const float mt = fmaxf(li, bc + pm);
        s_bm[pos] = (bc - mt) * LOG2E; s_a1[pos] = a1 * LOG2E; s_wi[pos] = expf(li - mt); s_em[pos] = expf(-mt);
    }
    __syncthreads();
    f32x16 sacc[2];
#pragma unroll
    for (int sb = 0; sb < 2; ++sb) {
#pragma unroll
        for (int q = 0; q < 16; ++q) sacc[sb][q] = 0.f;
#pragma unroll
        for (int ks = 0; ks < 4; ++ks) sacc[sb] = MFMA32(*(const bf16x8*)(s_k + (sb * 32 + r) * ML_ROWB + ks * 32 + h * 16), qf[ks], sacc[sb]);
    }
    const float bt = s_bm[t], wi = s_wi[t], em = s_em[t];
    float dsum = 0.f;
    bf16x8 pf[2][2];
#pragma unroll
    for (int sb = 0; sb < 2; ++sb) {
#pragma unroll
        for (int q = 0; q < 16; ++q) {
            const int sp = sb * 32 + (q & 3) + 8 * (q >> 2) + 4 * h;
            const bool valid = dir ? (sp >= t) : (sp <= t);
            const float v = valid ? sacc[sb][q] * fexp2(bt + s_a1[sp]) : 0.f;
            sacc[sb][q] = v; dsum += v;
        }
#pragma unroll
        for (int s2 = 0; s2 < 2; ++s2) {
            u32x4 t4 = {pk2(sacc[sb][8 * s2], sacc[sb][8 * s2 + 1]), pk2(sacc[sb][8 * s2 + 2], sacc[sb][8 * s2 + 3]),
                        pk2(sacc[sb][8 * s2 + 4], sacc[sb][8 * s2 + 5]), pk2(sacc[sb][8 * s2 + 6], sacc[sb][8 * s2 + 7])};
            pf[sb][s2] = (bf16x8)t4;
        }
    }
    f32x16 an[3];
#pragma unroll
    for (int rt = 0; rt < 3; ++rt) {
#pragma unroll
        for (int q = 0; q < 16; ++q) an[rt][q] = 0.f;
#pragma unroll
        for (int ks = 0; ks < 4; ++ks) an[rt] = MFMA32(*(const bf16x8*)(s_ci + (rt * 32 + r) * ML_ROWB + ks * 32 + h * 16), qf[ks], an[rt]);
    }
#pragma unroll
    for (int rt = 0; rt < 2; ++rt)
#pragma unroll
        for (int q = 0; q < 16; ++q) an[rt][q] *= wi;
    const float ninq = __shfl(an[2][0], r, 64);
#pragma unroll
    for (int d = 0; d < 2; ++d)
#pragma unroll
        for (int sb = 0; sb < 2; ++sb)
#pragma unroll
            for (int s2 = 0; s2 < 2; ++s2) {
                const char* a = s_vt + (d * 32 + r) * ML_ROWB + (sb * 32 + 16 * s2 + 4 * h) * 2;
                const u32x2 lo = *(const u32x2*)a, hi = *(const u32x2*)(a + 16);
                u32x4 t4 = {lo[0], lo[1], hi[0], hi[1]};
                an[d] = MFMA32((bf16x8)t4, pf[sb][s2], an[d]);
            }
    dsum += __shfl_xor(dsum, 32, 64);
    const float den = dsum + wi * ninq;
    const float inv = 1.f / fmaxf(fabsf(den), em);
    __syncthreads();
    float* hs = (float*)(smem + pair * 2 * MLC_SLOT) + dir * 64 * 65;
#pragma unroll
    for (int d = 0; d < 2; ++d)
#pragma unroll
        for (int q = 0; q < 16; ++q) { const int dd = d * 32 + (q & 3) + 8 * (q >> 2) + 4 * h; hs[t * 65 + dd] = an[d][q] * inv; }
    __syncthreads();
    {
        const int tp = tid & 255, tt = tp >> 2, qd = tp & 3;
        const float* h0 = (const float*)(smem + pair * 2 * MLC_SLOT) + tt * 65 + qd * 16;
        const bf16* orow = p.z + (size_t)(tok0 + tt) * ZW + Z_MLO + hd * 64 + qd * 16;
        const u32x4 o0 = *(const u32x4*)orow, o1 = *(const u32x4*)(orow + 8);
        float v[16]; float sm = 0.f;
#pragma unroll
        for (int j = 0; j < 16; ++j) {
            const unsigned w = j < 8 ? o0[j >> 1] : o1[(j - 8) >> 1];
            const float og = (j & 1) ? bfhi(w) : bflo(w);
            v[j] = sigmoidf_(og) * (h0[j] + h0[64 * 65 + j]); sm += v[j];
        }
        sm += __shfl_xor(sm, 1, 64); sm += __shfl_xor(sm, 2, 64);
        const float mu = sm * (1.f / 64.f);
        float vq = 0.f;
#pragma unroll
        for (int j = 0; j < 16; ++j) { v[j] -= mu; vq += v[j] * v[j]; }
        vq += __shfl_xor(vq, 1, 64); vq += __shfl_xor(vq, 2, 64);
        const float rs = rsqrtf(vq * (1.f / 64.f) + LN_EPS);
        const float* ng = p.ml_norm_g + l * 256 + hd * 64 + qd * 16;
        bf16* dst = p.cat + (size_t)(tok0 + tt) * 1024 + 768 + hd * 64 + qd * 16;
#pragma unroll
        for (int j = 0; j < 16; j += 4) st_bf4(dst + j, v[j] * rs * ng[j], v[j + 1] * rs * ng[j + 1], v[j + 2] * rs * ng[j + 2], v[j + 3] * rs * ng[j + 3]);
    }
}

#define PROBE_REPEAT 0
#ifndef DBG_STOP
#define DBG_STOP 0
#endif
#ifndef DBG_L
#define DBG_L 0
#endif
__device__ __forceinline__ void dbg_scan(const Params& p, const void* base, size_t rows, size_t stride, size_t c0, size_t c1, bool isbf, int bit = 0) {
    const size_t cpr = (c1 - c0) >> 4, total = rows * cpr;
    unsigned cs = 0, nf = 0;
    for (size_t i = (size_t)blockIdx.x * 512 + threadIdx.x; i < total; i += (size_t)gridDim.x * 512) {
        const size_t r = i / cpr, c = i - r * cpr;
        const u32x4 v = *(const u32x4*)((const char*)base + r * stride + c0 + c * 16);
#pragma unroll
        for (int k = 0; k < 4; ++k) {
            const unsigned w = v[k]; cs += w * 2654435761u + (w >> 7);
            if (isbf) { if ((w & 0x7F80u) >= 0x4480u || ((w >> 16) & 0x7F80u) >= 0x4480u) ++nf; }
            else { if ((w & 0x7F800000u) >= 0x44800000u) ++nf; }
        }
    }
    atomicAdd(&p.ctr[250], cs); if (nf) atomicOr(&p.ctr[251], 1u << bit);
}
#define SMEM_HDR 512
#define SMEM_BYTES (SMEM_HDR + 6 * ASTAT_SLAB + 8 * 32 * STG_ROWB)
#define NCTR 512

typedef const Params __attribute__((address_space(4)))* kparams_t;
__device__ __forceinline__ const Params& fresh_params() {
    kparams_t q = (kparams_t)__builtin_amdgcn_kernarg_segment_ptr();
    asm volatile("" : "+s"(q));
    return *(const Params*)q;
}
#define STAGE_BEGIN { const Params& p = fresh_params();
#define STAGE_END }
extern "C" __global__ void __launch_bounds__(512) mega_kernel(Params p_in) {
    (void)p_in;
    extern __shared__ __attribute__((aligned(16))) char smem_raw[];
    int* s_item = (int*)(smem_raw + 16);
    int* s_int = (int*)(smem_raw + 64);
    char* sm = smem_raw + SMEM_HDR;
    if (threadIdx.x == 0) *(uint4*)smem_raw = make_uint4(0u, 0u, 0u, 0u);
    __syncthreads();
    XcdBarrier bar = xcd_barrier_post(fresh_params().bar, (volatile LAS unsigned*)smem_raw);

    STAGE_BEGIN
    run_items(p.ctr + 0, 192, s_item, [&](int it) { job_modv(p, it, sm); });
    run_items(p.ctr + 1, 1, s_item, [&](int) { job_rope_tab(p); });
    run_items(p.ctr + 2, 64, s_item, [&](int it) { job_s5_tables(p, it, sm); });
    STAGE_END
    xcd_barrier(bar);

#if DBG_STOP
#define DBG_CHECK(N) if (DBG_STOP == (N) && l == DBG_L) break;
#else
#define DBG_CHECK(N)
#endif
    for (int l = 0; l < 2; ++l) {
        unsigned* C = fresh_params().ctr + 8 + l * 64;
        if (l == 0) {
            STAGE_BEGIN
            run_items(C + 0, CVT_SMALL, s_item, [&](int it) { job_cvt_small(p, 0, it, sm); });
            run_items(C + 1, 1024, s_item, [&](int it) { job_s5_expand(p, 0, it); });
            phase_ln_mod(p, 0, 0);
            STAGE_END
            xcd_barrier(bar);
        }
        DBG_CHECK(1)
        STAGE_BEGIN
        {
            g8::GridOrder S8; S8.A = (const char*)p.h; S8.Bt = (const char*)p.bt_in; S8.K = 1024; S8.nM = NTOK / 256; S8.nN = 7; S8.nwg = S8.nM * S8.nN; S8.G = (int)gridDim.x; S8.c = (int)blockIdx.x; S8.skipctx = 0;
            EpiInproj8 e8; e8.ug = p.ug; e8.z = p.z; e8.gates = p.gates;
            __syncthreads();
            g8::gemm_phase<false, true>((LAS unsigned char*)sm, 1024, S8, e8);
        }
        STAGE_END
        xcd_barrier(bar);
        DBG_CHECK(2)
        STAGE_BEGIN
        run_items(C + 4, 16 * 9 * 2, s_item, [&](int it) {
            const int g = it / 18, r = it % 18, mt = r >> 1, nt = r & 1;
            const Seg sg[1] = {{p.ug + (size_t)g * NROWP * 1024, p.gg + (size_t)g * 256 * 1024, 1024, 1024, 1024}};
            EpiF32 e; e.C = p.ff + (size_t)g * NROWP * 256; e.ldc = 256; e.mvalid = NROW; e.nvalid = 256;
            gemm_tile<128, 1>(sg, nullptr, mt * 128, nt * 128, e, sm);
        });
        phase_post_inproj(p, l, 0);
        STAGE_END
        xcd_barrier(bar);
        DBG_CHECK(3)
        STAGE_BEGIN
        run_items(C + 6, 32, s_item, [&](int it) { job_s5_carry(p, l, it); });
        run_items(C + 7, NUNIT / 4, s_item, [&](int it) { phase_ml_a(p, l, it, sm); });
        run_items(C + 8, NTOK / 128, s_item, [&](int mt) {
            EpiQ e; e.rq = p.rq; e.tab = p.rope_tab; e.q = p.q; e.stg = sm + 6 * ASTAT_SLAB;
            gemm_astat<4>(p.z + Z_QC, ZW, nullptr, mt * 128, p.bt_q, 256, 6, e, sm);
        });
        run_items(C + 9, NTOK / 128, s_item, [&](int mt) {
            EpiKV e; e.rkv = p.rkv; e.kf = p.kf; e.vt = p.vt; e.stg = sm + 6 * ASTAT_SLAB;
            gemm_astat<2>(p.z + Z_KVC, ZW, nullptr, mt * 128, p.bt_kv, 128, 8, e, sm);
        });
        STAGE_END
        xcd_barrier(bar);
        DBG_CHECK(4)
        STAGE_BEGIN
        run_items(C + 12, 64 * 16, s_item, [&](int it) { attn_item64(p, it >> 4, it & 15, sm); });
        if (l == 0) run_items(C + 59, 64, s_item, [&](int it) { attn_item<0>(p, it, 0, sm); });
        run_items(C + 10, 64 * 4, s_item, [&](int it) { job_ml_carry(p, it); });
        run_items(C + 11, 16 * 9 * 4, s_item, [&](int it) {
            const int g = it / 36, r = it % 36, mt = r >> 2, nt = r & 3;
            const Seg sg[2] = {{p.ug + (size_t)g * NROWP * 1024, p.wg + (size_t)g * 1024 * 1024, 1024, 1024, 1024},
                               {p.sin_ + (size_t)g * NROWP * 256, p.eg + (size_t)g * 1024 * 256, 256, 256, 256}};
            EpiS5Y e; e.gs = p.gs; e.g = g;
            gemm_tile<128, 2, 256>(sg, nullptr, mt * 128, nt * 256, e, sm);
        });
        STAGE_END
        xcd_barrier(bar);
        DBG_CHECK(5)
        STAGE_BEGIN
        run_items(C + 13, NTOK / 128, s_item, [&](int mt) {
            EpiGlu e; e.gs = p.gs; e.bias = p.glu_b + l * 256; e.cat = p.cat; e.stg = sm + 6 * ASTAT_SLAB;
            gemm_astat<4>(p.gs, 256, nullptr, mt * 128, p.bt_glu, 256, 2, e, sm);
        });
        run_items(C + 14, NB * 4 * NCH / 2, s_item, [&](int it) { phase_ml_c(p, l, it, sm); });
        STAGE_END
        xcd_barrier(bar);
        DBG_CHECK(6)
        STAGE_BEGIN
        {
            g8::GridOrder S8; S8.A = (const char*)p.cat; S8.Bt = (const char*)p.bt_out; S8.K = 1024; S8.skipctx = (l == 1); S8.nM = S8.skipctx ? NB * 32 : NTOK / 256; S8.nN = 4; S8.nwg = S8.nM * S8.nN; S8.G = (int)gridDim.x; S8.c = (int)blockIdx.x;
            EpiBf16_8 e8; e8.C = p.z; e8.ldc = 1024;
            __syncthreads();
            g8::gemm_phase<false, true>((LAS unsigned char*)sm, 1024, S8, e8);
        }
        run_items(C + 63, CVT_EXPERT, s_item, [&](int it) { job_cvt_expert(p, l, it, sm); });
        STAGE_END
        xcd_barrier(bar);
        DBG_CHECK(7)
        STAGE_BEGIN
        phase_post_mixer<0>(p, l, 0);
        STAGE_END
        xcd_barrier(bar);
        DBG_CHECK(8)
        STAGE_BEGIN
        run_items(C + 17, l == 1 ? NB * 32 : NTOK / 256, s_item, [&](int it0) {
            const int it = (l == 1) ? (it0 >> 5) * 33 + 1 + (it0 & 31) : it0;
            const Seg sg[2] = {{p.h, p.bt_rhi, 1024, 1024, 1024}, {p.cat, p.bt_rhi, 1024, 1024, 1024}};
            EpiRouterSum e; e.C = p.logits; e.stg = sm;
            gemm_tile<256, 2>(sg, nullptr, it * 256, 0, e, sm);
        });
        STAGE_END
        xcd_barrier(bar);
        DBG_CHECK(9)
        STAGE_BEGIN
        phase_route(p, l, 0, sm);
        run_items(C + 19, (NB * MOE_SLOTS / 4 + 2047) / 2048, s_item, [&](int it) {
            const u32x4 zz = {0u, 0u, 0u, 0u};
            for (int k = 0; k < 4; ++k) { const int idx = it * 2048 + k * 512 + otid(); if (idx < NB * MOE_SLOTS / 4) { ((u32x4*)p.slottok)[idx] = zz; ((u32x4*)p.slotgate)[idx] = zz; } }
        });
        STAGE_END
        xcd_barrier(bar);
        DBG_CHECK(10)
        STAGE_BEGIN
        run_items(C + 20, NB, s_item, [&](int it) { job_tiles(p, l, it, s_int); });
        job_slots(p, l, 0, s_int);
        STAGE_END
        xcd_barrier(bar);
        DBG_CHECK(11)
        for (int sgi = 0; sgi < NB + 2; ++sgi) {
            STAGE_BEGIN
            if (sgi < NB) {
                const int b = sgi;
                UpOrder S8; S8.A = (const char*)p.h; S8.Bt = (const char*)p.bt_up; S8.slottok = p.slottok + (size_t)b * MOE_SLOTS; S8.ue = p.up_e + b * UPU_STRIDE; S8.ur = p.up_row + b * UPU_STRIDE;
                S8.nu2 = 2 * p.up_n[b]; S8.G = (int)gridDim.x; S8.c = (int)blockIdx.x;
                EpiUp8 e8; e8.slotgate = p.slotgate + (size_t)b * MOE_SLOTS; e8.hc = (b & 1) ? p.hc1 : p.hc;
                __syncthreads();
                g8::gemm_phase<true>((LAS unsigned char*)sm, 1024, S8, e8);
            }
            if (sgi >= 2) { const int b = sgi - 2; const bf16* yb = (b & 1) ? p.yc1 : p.yc; phase_combine(p, l, b, 0, yb); }
            if (l == 0 && sgi == NB + 1) {
                run_items(C + 64 + 0, CVT_SMALL, s_item, [&](int it) { job_cvt_small(p, 1, it, sm); });
                run_items(C + 64 + 1, 1024, s_item, [&](int it) { job_s5_expand(p, 1, it); });
            }
            if (sgi >= 1 && sgi <= NB) {
                const int b = sgi - 1;
                const bf16* hb = (b & 1) ? p.hc1 : p.hc; bf16* yb = (b & 1) ? p.yc1 : p.yc;
                run_items_xcd(p.ctr + 256 + ((l * 8 + b) * 2 + 1) * 8, p.xl_cnt + b * 8, 1, (int)(bar.x & 7u), s_item, [&](int x, int it) {
                    const int t = p.xl_tile[(size_t)(b * 8 + x) * XL_STRIDE + it], ex = p.tile_e[b * MOE_TILES + t];
                    gemm_astat256<4, true>(hb, 256, t * 128, p.bt_dn + (size_t)ex * 1024 * 256, 256, 4, yb, 1024, sm);
                });
            }
            STAGE_END
            xcd_barrier(bar);
        }
        DBG_CHECK(12)
    }
#if DBG_STOP
    {
        const Params& p = fresh_params();
        const size_t T = NTOK;
        if (DBG_STOP == 1) { dbg_scan(p, p.h, T, 2048, 0, 2048, true); dbg_scan(p, p.bt_in, NINP, 2048, 0, 2048, true); dbg_scan(p, p.bt_up, 65 * 512, 2048, 0, 2048, true); dbg_scan(p, p.bt_dn, 65 * 1024, 512, 0, 512, true);
                             dbg_scan(p, p.wg, 16 * 1024, 2048, 0, 2048, true); dbg_scan(p, p.eg, 16 * 1024, 512, 0, 512, true); dbg_scan(p, p.gg, 16 * 256, 2048, 0, 2048, true); dbg_scan(p, p.modv, 18, 6144 * 4, 0, 6144 * 4, false); }
        if (DBG_STOP == 2) { dbg_scan(p, p.z, T, ZW * 2, 0, ZW * 2, true); dbg_scan(p, p.gates, T, 64, 0, 64, false); for (int g = 0; g < 16; ++g) dbg_scan(p, p.ug + (size_t)g * NROWP * 1024, NROW, 2048, 0, 2048, true); }
        if (DBG_STOP == 3) { for (int g = 0; g < 16; ++g) dbg_scan(p, p.ff + (size_t)g * NROWP * 256, NROW, 1024, 0, 1024, false); dbg_scan(p, p.qkc, T, 1024, 0, 1024, true); dbg_scan(p, p.rq, 1, T * 4, 0, T * 4, false); dbg_scan(p, p.rkv, 1, T * 4, 0, T * 4, false); dbg_scan(p, p.kf, T * 8, 192, 128, 192, true); }
        if (DBG_STOP == 4) { dbg_scan(p, p.cloc, (size_t)NUNIT * 65, 128, 0, 64, true, 0); dbg_scan(p, p.cloc, (size_t)NUNIT * 65, 128, 64, 128, true, 1);
                             dbg_scan(p, p.cloc, NUNIT, CLOC_STRIDE * 2, 0, 4096, true, 2); dbg_scan(p, p.cloc, NUNIT, CLOC_STRIDE * 2, 4096, 8192, true, 3); dbg_scan(p, p.cloc, NUNIT, CLOC_STRIDE * 2, 8192, 8320, true, 4); }
        if (DBG_STOP == 5) { dbg_scan(p, p.cloc, NUNIT, CLOC_STRIDE * 2, 0, CLOC_STRIDE * 2, true); dbg_scan(p, p.gs, T, 512, 0, 512, true); dbg_scan(p, p.cat, T, 2048, 512, 1536, true); }
        if (DBG_STOP == 6) {
            dbg_scan(p, p.z, T, ZW * 2, 0, ZW * 2, true, 0); dbg_scan(p, p.gates, T, 64, 0, 64, false, 0); for (int g = 0; g < 16; ++g) dbg_scan(p, p.ug + (size_t)g * NROWP * 1024, NROW, 2048, 0, 2048, true, 0);
            dbg_scan(p, p.qkc, T, 1024, 0, 1024, true, 0); dbg_scan(p, p.rq, 1, T * 4, 0, T * 4, false, 0); dbg_scan(p, p.rkv, 1, T * 4, 0, T * 4, false, 0);
            for (int g = 0; g < 16; ++g) { dbg_scan(p, p.ff + (size_t)g * NROWP * 256, NROW, 1024, 0, 1024, false, 1); dbg_scan(p, p.sin_ + (size_t)g * NROWP * 256, NROW, 512, 0, 512, true, 1); }
            dbg_scan(p, p.gs, T, 512, 0, 512, true, 1); dbg_scan(p, p.cat, T, 2048, 0, 512, true, 1);
            dbg_scan(p, p.q, T * 8, 192, 0, 192, true, 2); dbg_scan(p, p.kf, T * 8, 192, 0, 192, true, 2); dbg_scan(p, p.vt, (size_t)NB * 8 * 64, SQ * 2, 0, SQ * 2, true, 2);
            dbg_scan(p, p.cat, T, 2048, 512, 1536, true, 3);
            dbg_scan(p, p.cloc, NUNIT, CLOC_STRIDE * 2, 0, CLOC_STRIDE * 2, true, 4); dbg_scan(p, p.cat, T, 2048, 1536, 2048, true, 4);
        }
        if (DBG_STOP == 7) { dbg_scan(p, p.z, T, 2048, 0, 2048, true); }
        if (DBG_STOP == 8) { dbg_scan(p, p.out, (size_t)NB * SEQL, 4096, 0, 4096, false); dbg_scan(p, p.ctxres, NB * CTXL, 4096, 0, 4096, false); dbg_scan(p, p.h, T, 2048, 0, 2048, true); dbg_scan(p, p.cat, T, 2048, 0, 2048, true); }
        if (DBG_STOP == 9) { dbg_scan(p, p.logits, T, 256, 0, 256, false); }
        if (DBG_STOP == 10) { dbg_scan(p, p.tope, T, 32, 0, 32, false); dbg_scan(p, p.gatew, T, 32, 0, 32, false); }
        if (DBG_STOP == 12) { dbg_scan(p, p.out, (size_t)NB * SEQL, 4096, 0, 4096, false); dbg_scan(p, p.ctxres, NB * CTXL, 4096, 0, 4096, false); }
        xcd_barrier(bar);
        const unsigned cs = __hip_atomic_load(&p.ctr[250], __ATOMIC_RELAXED, __HIP_MEMORY_SCOPE_AGENT), nf = __hip_atomic_load(&p.ctr[251], __ATOMIC_RELAXED, __HIP_MEMORY_SCOPE_AGENT);
        const float code = (DBG_STOP == 6 || DBG_STOP == 4) ? 1.f + (float)nf : 1.f + (nf ? 4.f : 0.f) + (float)((cs >> 3) & 3u);
        const f32x4 cv = {code, code, code, code};
        for (size_t i = (size_t)blockIdx.x * 512 + threadIdx.x; i < (size_t)NB * SEQL * DM / 4; i += (size_t)gridDim.x * 512) ((f32x4*)p.out)[i] = cv;
    }
#endif
}

static inline size_t al256(size_t x) { return (x + 255) & ~(size_t)255; }

extern "C" void kernel_launch(void* const* d_in, const int* in_sizes, int n_in, void* d_out, int out_size, void* d_ws, size_t ws_size, hipStream_t stream) {
    (void)in_sizes; (void)n_in; (void)out_size;
    Params p; memset(&p, 0, sizeof(p));
    const float* const* in = (const float* const*)d_in;
    p.x = in[0]; p.c = in[1]; p.ctx = in[2]; p.c_ctx = in[3]; p.ada_w = in[4]; p.ada_b = in[5]; p.w_in = in[6];
    p.lam_re = in[7]; p.lam_im = in[8]; p.log_step = in[9]; p.b_re = in[10]; p.b_im = in[11]; p.c_re = in[12]; p.c_im = in[13];
    p.s5_d = in[14]; p.glu_w = in[15]; p.glu_b = in[16]; p.q_norm = in[17]; p.w_q_up = in[18]; p.kv_norm = in[19]; p.w_kv_up = in[20];
    p.conv_w = in[21]; p.conv_b = in[22]; p.gate_b = in[23]; p.ml_norm_g = in[24]; p.w_out = in[25]; p.ln1_g = in[26]; p.ln1_b = in[27];
    p.ln2_g = in[28]; p.ln2_b = in[29]; p.router_w = in[30]; p.router_bias = in[31]; p.ew_gate = in[32]; p.ew_up = in[33]; p.ew_down = in[34];
    p.sw_gate = in[35]; p.sw_up = in[36]; p.sw_down = in[37];
    p.out = (float*)d_out;

    char* ws = (char*)d_ws; size_t off = 0;
    auto take = [&](size_t bytes) { char* r = ws + off; off += al256(bytes); return r; };
    const size_t zero_bytes = al256(XCD_BAR_WORDS * 4) + al256(NCTR * 4) + al256(2 * 8 * 64 * 4);
    p.bar = (unsigned*)take(XCD_BAR_WORDS * 4); p.ctr = (unsigned*)take(NCTR * 4); p.moe_cnt = (int*)take(2 * 8 * 64 * 4);
    p.modv = (float*)take((size_t)2 * 9 * 6144 * 4); p.rope_tab = (float*)take(1024 * 2 * 4);
    p.klag = (float*)take((size_t)64 * 16384 * 4); p.pw = (float*)take((size_t)64 * 64 * 65 * 8); p.bbar = (float*)take((size_t)64 * 1024 * 8);
    p.ctxres = (float*)take((size_t)NB * CTXL * DM * 4); p.gates = (float*)take((size_t)NTOK * 16 * 4);
    p.rq = (float*)take((size_t)NTOK * 4); p.rkv = (float*)take((size_t)NTOK * 4); p.mlstat = (float*)take((size_t)NUNIT * 4 * 4);
    p.bt_in = (bf16*)take((size_t)NINP * 1024 * 2); p.bt_q = (bf16*)take((size_t)768 * 256 * 2); p.bt_kv = (bf16*)take((size_t)1024 * 128 * 2);
    p.bt_glu = (bf16*)take((size_t)256 * 256 * 2); p.bt_out = (bf16*)take((size_t)1024 * 1024 * 2);
    p.bt_rhi = (bf16*)take((size_t)128 * 1024 * 2); p.bt_rlo = p.bt_rhi + (size_t)64 * 1024;
    p.bt_up = (bf16*)take((size_t)65 * 512 * 1024 * 2); p.bt_dn = (bf16*)take((size_t)65 * 1024 * 256 * 2);
    p.wg = (bf16*)take((size_t)16 * 1024 * 1024 * 2); p.eg = (bf16*)take((size_t)16 * 1024 * 256 * 2); p.gg = (bf16*)take((size_t)16 * 256 * 1024 * 2);
    {
        const size_t qkc_b = al256((size_t)NTOK * 512 * 2), cloc_b = al256((size_t)NUNIT * CLOC_STRIDE * 2), h_b = al256((size_t)NTOK * DM * 2);
        const size_t reg = (qkc_b + cloc_b) > h_b ? (qkc_b + cloc_b) : h_b;
        char* r = take(reg); p.h = (bf16*)r; p.qkc = (bf16*)r; p.cloc = (bf16*)(r + qkc_b);
    }
    p.z = (bf16*)take((size_t)NTOK * ZW * 2);
    p.cat = (bf16*)take((size_t)NTOK * DM * 2);
    {
        const size_t ug_b = al256((size_t)16 * NROWP * 1024 * 2), sin_b = al256((size_t)16 * NROWP * 256 * 2), ff_b = al256((size_t)16 * NROWP * 256 * 4), gs_b = al256((size_t)NTOK * 256 * 2);
        const size_t s5_total = ug_b + sin_b + ff_b + gs_b;
        const size_t lg_b = al256((size_t)NTOK * 64 * 4), t8_b = al256((size_t)NTOK * 8 * 4), sl_b = al256((size_t)NB * MOE_SLOTS * 4), te_b = al256((size_t)NB * MOE_TILES * 4), nt_b = al256(64), xl_b = al256((size_t)NB * 8 * XL_STRIDE * 4), xc_b = al256(NB * 8 * 4), uu_b = al256((size_t)NB * UPU_STRIDE * 4);
        const size_t rt_total = lg_b + 4 * t8_b + 2 * sl_b + te_b + nt_b + xl_b + xc_b + 2 * uu_b + 256;
        char* r = take(s5_total > rt_total ? s5_total : rt_total);
        p.ug = (bf16*)r; p.sin_ = (bf16*)(r + ug_b); p.ff = (float*)(r + ug_b + sin_b); p.gs = (bf16*)(r + ug_b + sin_b + ff_b);
        char* q = r;
        p.logits = (float*)q; q += lg_b; p.tope = (int*)q; q += t8_b; p.pos = (int*)q; q += t8_b; p.tokslot = (int*)q; q += t8_b; p.gatew = (float*)q; q += t8_b;
        p.slottok = (int*)q; q += sl_b; p.slotgate = (float*)q; q += sl_b; p.tile_e = (int*)q; q += te_b; p.ntb = (int*)q; q += nt_b; p.xl_tile = (int*)q; q += xl_b; p.xl_cnt = (int*)q; q += xc_b; p.up_e = (int*)q; q += uu_b; p.up_row = (int*)q; q += uu_b; p.up_n = (int*)q; q += 256;
    }
    {
        const size_t q_b = al256((size_t)NTOK * 768 * 2), kf_b = q_b, vt_b = al256((size_t)NTOK * 512 * 2);
        const size_t hc_b = al256((size_t)MOE_SLOTS * 256 * 2), yc_b = al256((size_t)MOE_SLOTS * 1024 * 2);
        const size_t a_total = q_b + kf_b + vt_b, m_total = hc_b + yc_b;
        char* r = take(a_total > m_total ? a_total : m_total);
        p.q = (bf16*)r; p.kf = (bf16*)(r + q_b); p.vt = (bf16*)(r + q_b + kf_b);
        p.yc = (bf16*)r;
        p.yc1 = p.z; p.hc = p.cat; p.hc1 = (bf16*)((char*)p.cat + hc_b);
        if (yc_b > al256((size_t)NTOK * ZW * 2) || 2 * hc_b > al256((size_t)NTOK * DM * 2) || yc_b > a_total) { fprintf(stderr, "MoE buffers do not fit\n"); return; }
    }
    if (off > ws_size) { fprintf(stderr, "workspace too small: need %zu have %zu\n", off, ws_size); return; }

    static int configured = 0;
    if (!configured) { hipFuncSetAttribute((const void*)mega_kernel, hipFuncAttributeMaxDynamicSharedMemorySize, SMEM_BYTES); configured = 1; }
    int dev = 0, cus = 0; hipGetDevice(&dev); hipDeviceGetAttribute(&cus, hipDeviceAttributeMultiprocessorCount, dev);
    if (cus <= 0) cus = 256;
    hipMemsetAsync(d_ws, 0, zero_bytes, stream);
    hipLaunchKernelGGL(mega_kernel, dim3(cus), dim3(512), SMEM_BYTES, stream, p);
}
```

```cpp
#include <hip/hip_runtime.h>
#include <stdint.h>
#include <string.h>
#include <stdio.h>

#define DM 1024
#define NB 8
#define SEQL 8192
#define CTXL 256
#define SQ 8448
#define NTOK (NB * SQ)
#define NCH 132
#define NROW (NB * NCH)
#define NROWP 1152
#define NIN 1712
#define NINP 1792
#define ZW 1440
#define Z_QC 0
#define Z_KVC 256
#define Z_KR 384
#define Z_MLQ 416
#define Z_MLV 928
#define Z_MLO 1184
#define NUNIT (NB * 4 * 2 * NCH)
#define CLOC_STRIDE (65 * 64)
#define MOE_BM 128
#define MOE_TILES 722
#define MOE_SLOTS (MOE_TILES * MOE_BM)
#define UPU_STRIDE 384
#define ALPHA_DN 1.41421356237f
#define LN_EPS 1e-5f
#define QSCALE (0.10206207261596577f * 1.4426950408889634f)
#define LOG2E 1.4426950408889634f

typedef unsigned short bf16;
typedef short bf16x8 __attribute__((ext_vector_type(8)));
typedef float f32x16 __attribute__((ext_vector_type(16)));
typedef float f32x4 __attribute__((ext_vector_type(4)));
typedef unsigned u32x4 __attribute__((ext_vector_type(4)));
typedef unsigned u32x2 __attribute__((ext_vector_type(2)));

#define MFMA32(a, b, c) __builtin_amdgcn_mfma_f32_32x32x16_bf16((a), (b), (c), 0, 0, 0)
__device__ __forceinline__ int otid() { int t = (int)threadIdx.x; asm volatile("" : "+v"(t)); return t; }

typedef __bf16 bf2_t __attribute__((ext_vector_type(2)));
typedef float f2_t __attribute__((ext_vector_type(2)));
__device__ __forceinline__ unsigned pk2(float lo, float hi) { f2_t v = {lo, hi}; bf2_t b = __builtin_convertvector(v, bf2_t); return __builtin_bit_cast(unsigned, b); }
__device__ __forceinline__ bf16 f2bf(float x) { return (bf16)(pk2(x, 0.f) & 0xffffu); }
__device__ __forceinline__ float bf2f(bf16 x) { return __uint_as_float(((unsigned)x) << 16); }
__device__ __forceinline__ float bflo(unsigned u) { return __uint_as_float(u << 16); }
__device__ __forceinline__ float bfhi(unsigned u) { return __uint_as_float(u & 0xffff0000u); }
__device__ __forceinline__ float fexp2(float x) { return __builtin_amdgcn_exp2f(x); }
__device__ __forceinline__ float fexp(float x) { return __builtin_amdgcn_exp2f(x * LOG2E); }
__device__ __forceinline__ float frcp(float x) { return __builtin_amdgcn_rcpf(x); }
__device__ __forceinline__ float sigmoidf_(float x) { return frcp(1.f + fexp(-x)); }
__device__ __forceinline__ float siluf_(float x) { return x * sigmoidf_(x); }
__device__ __forceinline__ float gelu_tanh(float x) {
    const float u = 0.7978845608028654f * (x + 0.044715f * x * x * x);
    const float t = 1.f - 2.f * frcp(fexp(2.f * u) + 1.f);
    return 0.5f * x * (1.f + t);
}
template <int CTRL, int RM> __device__ __forceinline__ float dppf(float ident, float v) {
    return __int_as_float(__builtin_amdgcn_update_dpp(__float_as_int(ident), __float_as_int(v), CTRL, RM, 0xf, false));
}
template <int CTRL, int RM> __device__ __forceinline__ int dppi(int ident, int v) { return __builtin_amdgcn_update_dpp(ident, v, CTRL, RM, 0xf, false); }
__device__ __forceinline__ float dpp_scan_sum(float v) {
    v += dppf<0x111, 0xf>(0.f, v); v += dppf<0x112, 0xf>(0.f, v); v += dppf<0x114, 0xf>(0.f, v); v += dppf<0x118, 0xf>(0.f, v);
    v += dppf<0x142, 0xa>(0.f, v); v += dppf<0x143, 0xc>(0.f, v);
    return v;
}
__device__ __forceinline__ float dpp_scan_max(float v) {
    const float NI = -__builtin_inff();
    v = fmaxf(v, dppf<0x111, 0xf>(NI, v)); v = fmaxf(v, dppf<0x112, 0xf>(NI, v)); v = fmaxf(v, dppf<0x114, 0xf>(NI, v)); v = fmaxf(v, dppf<0x118, 0xf>(NI, v));
    v = fmaxf(v, dppf<0x142, 0xa>(NI, v)); v = fmaxf(v, dppf<0x143, 0xc>(NI, v));
    return v;
}
__device__ __forceinline__ float readlane_f(float v, int l) { return __int_as_float(__builtin_amdgcn_readlane(__float_as_int(v), l)); }
__device__ __forceinline__ float wave_sum(float v) { return readlane_f(dpp_scan_sum(v), 63); }
__device__ __forceinline__ float wave_max(float v) { return readlane_f(dpp_scan_max(v), 63); }

#define XB_TMO      128
#define XB_XCNT(j)  (256  + 64 * (j))
#define XB_XSUB(j)  (1280 + 64 * (j))
#define XB_XGEN(j)  (2304 + 64 * (j))
#define XB_TOP      3328
#define XB_TOPGEN   3392
#define XCD_BAR_WORDS 3456
#define XB_SPIN_CAP (1u << 21)
#define LAS __attribute__((address_space(3)))

__device__ __forceinline__ unsigned xb_ld(unsigned* p)              { return __hip_atomic_load(p, __ATOMIC_RELAXED, __HIP_MEMORY_SCOPE_AGENT); }
__device__ __forceinline__ unsigned xb_add(unsigned* p, unsigned v) { return __hip_atomic_fetch_add(p, v, __ATOMIC_RELAXED, __HIP_MEMORY_SCOPE_AGENT); }
__device__ __forceinline__ unsigned xb_xcc_id() { return (unsigned)__builtin_amdgcn_s_getreg((3 << 11) | 20) & 0xFu; }
#define XB_SPIN(cond, bar) do { unsigned _sp = 0; while (cond) { __builtin_amdgcn_s_sleep(1); \
    if ((++_sp & 255u) == 0u) { if (xb_ld(&(bar)[XB_TMO])) break; if (_sp > XB_SPIN_CAP) { atomicAdd(&(bar)[XB_TMO], 1u); break; } } } } while (0)

struct XcdBarrier { unsigned* bar; unsigned x; volatile LAS unsigned* st; };

__device__ __forceinline__ XcdBarrier xcd_barrier_post(unsigned* bar, volatile LAS unsigned* st) {
    XcdBarrier b; b.bar = bar; b.x = xb_xcc_id(); b.st = st;
    if (threadIdx.x == 0) (void)xb_add(&bar[XB_XCNT(b.x)], 1u);
    return b;
}
__device__ __forceinline__ void xcd_barrier_complete(unsigned* bar, unsigned x, unsigned& nloc, unsigned& nx) {
    const unsigned G = gridDim.x * gridDim.y * gridDim.z;
    unsigned sum, cnt, mine, sp = 0u;
    for (;;) {
        sum = 0u; cnt = 0u; mine = 0u;
#pragma unroll
        for (unsigned j = 0; j < 16; ++j) { const unsigned c = xb_ld(&bar[XB_XCNT(j)]); sum += c; cnt += (c > 0u) ? 1u : 0u; mine = (j == x) ? c : mine; }
        if (sum == G) break;
        __builtin_amdgcn_s_sleep(1);
        if ((++sp & 255u) == 0u) { if (xb_ld(&bar[XB_TMO])) break; if (sp > XB_SPIN_CAP) { atomicAdd(&bar[XB_TMO], 1u); break; } }
    }
    nloc = mine > 0u ? mine : 1u; nx = cnt > 0u ? cnt : 1u;
}
__device__ __forceinline__ void xcd_barrier(const XcdBarrier& b) {
    asm volatile("s_waitcnt vmcnt(0)" ::: "memory");
    __syncthreads();
    if (threadIdx.x == 0) {
        unsigned* bar = b.bar;
        __builtin_amdgcn_s_waitcnt(0);
        const unsigned bx = xb_xcc_id();
        unsigned nloc = b.st[0], nx = b.st[1];
        if (nloc == 0u) { xcd_barrier_complete(bar, bx, nloc, nx); b.st[0] = nloc; b.st[1] = nx; }
        const unsigned old = xb_add(&bar[XB_XSUB(bx)], 1u);
        const unsigned gen = old / nloc;
        if (old + 1u == (gen + 1u) * nloc) {
            __builtin_amdgcn_fence(__ATOMIC_RELEASE, "agent");
            asm volatile("s_waitcnt vmcnt(0)" ::: "memory");
            const unsigned og = xb_add(&bar[XB_TOP], 1u);
            const unsigned tg = og / nx;
            if (og + 1u == (tg + 1u) * nx) xb_add(&bar[XB_TOPGEN], 1u);
            else XB_SPIN(xb_ld(&bar[XB_TOPGEN]) == tg, bar);
            __builtin_amdgcn_fence(__ATOMIC_ACQUIRE, "agent");
            xb_add(&bar[XB_XGEN(bx)], 1u);
            asm volatile("s_waitcnt vmcnt(0)" ::: "memory");
        } else {
            XB_SPIN(xb_ld(&bar[XB_XGEN(bx)]) == gen, bar);
            __builtin_amdgcn_fence(__ATOMIC_ACQUIRE, "agent");
            asm volatile("s_waitcnt vmcnt(0)" ::: "memory");
        }
    }
    __syncthreads();
}

struct Params {
    const float *x, *c, *ctx, *c_ctx, *ada_w, *ada_b, *w_in, *lam_re, *lam_im, *log_step, *b_re, *b_im, *c_re, *c_im, *s5_d, *glu_w, *glu_b;
    const float *q_norm, *w_q_up, *kv_norm, *w_kv_up, *conv_w, *conv_b, *gate_b, *ml_norm_g, *w_out, *ln1_g, *ln1_b, *ln2_g, *ln2_b;
    const float *router_w, *router_bias, *ew_gate, *ew_up, *ew_down, *sw_gate, *sw_up, *sw_down;
    float* out;
    unsigned* bar; unsigned* ctr; int* moe_cnt;
    float *modv, *rope_tab, *klag, *pw, *bbar, *ctxres, *gates, *rq, *rkv, *mlstat;
    bf16 *bt_in, *bt_q, *bt_kv, *bt_glu, *bt_out, *bt_rhi, *bt_rlo, *bt_up, *bt_dn;
    bf16 *wg, *eg, *gg;
    bf16 *h;
    bf16 *qkc, *cloc;
    bf16 *z;
    bf16 *cat;
    bf16 *ug, *sin_; float* ff; bf16* gs;
    float* logits; int *tope, *pos, *tokslot, *slottok, *tile_e, *ntb, *xl_tile, *xl_cnt, *up_e, *up_row, *up_n; float *gatew, *slotgate;
    bf16 *q, *kf, *vt;
    bf16 *hc, *yc, *hc1, *yc1;
};

template <class F>
__device__ __forceinline__ void run_items(unsigned* ctr, int total, int* s_item, F&& f) {
    for (;;) {
        __syncthreads();
        if (threadIdx.x == 0) *s_item = (int)atomicAdd(ctr, 1u);
        __syncthreads();
        const int it = *s_item;
        if (it >= total) break;
        f(it);
    }
}

#define XL_STRIDE 672
template <class F>
__device__ __forceinline__ void run_items_xcd(unsigned* ctr8, const int* cnt8, int mult, int myx, int* s_item, F&& f) {
    for (int k = 0; k < 8; ++k) {
        const int x = (myx + k) & 7;
        const int total = cnt8[x] * mult;
        for (;;) {
            __syncthreads();
            if (threadIdx.x == 0) *s_item = (int)atomicAdd(ctr8 + x, 1u);
            __syncthreads();
            const int it = *s_item;
            if (it >= total) break;
            f(x, it);
        }
    }
}

struct Seg { const bf16* A; const bf16* B; int lda, ldb, K; };
#define GEMM_ROWB 144
#define STG_ROWB 144

template <int BM, int NSEG, int BN = 128, class Epi>
__device__ __forceinline__ void gemm_tile(const Seg (&seg)[NSEG], const int* __restrict__ rowidx, int m0, int n0, const Epi& epi, char* smem) {
    constexpr int AI = BM / 64, BI = BN / 64, WNW = BN / 64, WMW = 8 / WNW, WM = BM / WMW, MI = WM / 32;
    constexpr int BUFB = (BM + BN) * GEMM_ROWB;
    const int tid = otid(), lane = tid & 63, wave = tid >> 6;
    const int kc = tid & 7, r0 = tid >> 3;
    const int wm = wave / WNW, wn = wave % WNW;
    int arow[AI];
#pragma unroll
    for (int i = 0; i < AI; ++i) { const int r = m0 + r0 + 64 * i; arow[i] = rowidx ? rowidx[r] : r; }
    int total = 0;
#pragma unroll
    for (int s = 0; s < NSEG; ++s) total += seg[s].K >> 6;
    u32x4 ra0[AI], rb0[BI], ra1[AI], rb1[BI];
    const bf16* cA = seg[0].A; const bf16* cB = seg[0].B; int clda = seg[0].lda, cldb = seg[0].ldb, cnk = seg[0].K >> 6, ckt = 0, cs = 0;
    auto gload = [&](u32x4 (&ra)[AI], u32x4 (&rb)[BI]) {
        const int ko = ckt * 64 + kc * 8;
#pragma unroll
        for (int i = 0; i < AI; ++i) ra[i] = *(const u32x4*)(cA + (size_t)arow[i] * clda + ko);
#pragma unroll
        for (int i = 0; i < BI; ++i) rb[i] = *(const u32x4*)(cB + (size_t)(n0 + r0 + 64 * i) * cldb + ko);
        ++ckt;
        if (ckt == cnk) {
            ++cs; ckt = 0;
            if (NSEG > 1 && cs == 1) { cA = seg[NSEG > 1 ? 1 : 0].A; cB = seg[NSEG > 1 ? 1 : 0].B; clda = seg[NSEG > 1 ? 1 : 0].lda; cldb = seg[NSEG > 1 ? 1 : 0].ldb; cnk = seg[NSEG > 1 ? 1 : 0].K >> 6; }
            if (NSEG > 2 && cs == 2) { cA = seg[NSEG > 2 ? 2 : 0].A; cB = seg[NSEG > 2 ? 2 : 0].B; clda = seg[NSEG > 2 ? 2 : 0].lda; cldb = seg[NSEG > 2 ? 2 : 0].ldb; cnk = seg[NSEG > 2 ? 2 : 0].K >> 6; }
        }
    };
    auto lstore = [&](int buf, const u32x4 (&ra)[AI], const u32x4 (&rb)[BI]) {
        char* base = smem + buf * BUFB;
#pragma unroll
        for (int i = 0; i < AI; ++i) *(u32x4*)(base + (r0 + 64 * i) * GEMM_ROWB + kc * 16) = ra[i];
#pragma unroll
        for (int i = 0; i < BI; ++i) *(u32x4*)(base + (BM + r0 + 64 * i) * GEMM_ROWB + kc * 16) = rb[i];
    };
    f32x16 acc[MI][2];
#pragma unroll
    for (int i = 0; i < MI; ++i)
#pragma unroll
        for (int j = 0; j < 2; ++j)
#pragma unroll
            for (int q = 0; q < 16; ++q) acc[i][j][q] = 0.f;
    auto compute = [&](int buf) {
        const char* base = smem + buf * BUFB;
        const char* pa = base + (wm * WM + (lane & 31)) * GEMM_ROWB + (lane >> 5) * 16;
        const char* pb = base + (BM + wn * 64 + (lane & 31)) * GEMM_ROWB + (lane >> 5) * 16;
#pragma unroll
        for (int ks = 0; ks < 4; ++ks) {
            bf16x8 af[MI], bfr[2];
#pragma unroll
            for (int i = 0; i < MI; ++i) af[i] = *(const bf16x8*)(pa + i * 32 * GEMM_ROWB + ks * 32);
#pragma unroll
            for (int j = 0; j < 2; ++j) bfr[j] = *(const bf16x8*)(pb + j * 32 * GEMM_ROWB + ks * 32);
#pragma unroll
            for (int i = 0; i < MI; ++i)
#pragma unroll
                for (int j = 0; j < 2; ++j) acc[i][j] = MFMA32(bfr[j], af[i], acc[i][j]);
        }
    };
    gload(ra0, rb0);
    if (total > 1) gload(ra1, rb1);
    __syncthreads();
    lstore(0, ra0, rb0);
    if (total > 2) gload(ra0, rb0);
    __syncthreads();
    for (int t = 0; t < total; t += 2) {
        compute(0);
        if (t + 1 < total) lstore(1, ra1, rb1);
        if (t + 3 < total) gload(ra1, rb1);
        __syncthreads();
        if (t + 1 >= total) break;
        compute(1);
        if (t + 2 < total) lstore(0, ra0, rb0);
        if (t + 4 < total) gload(ra0, rb0);
        __syncthreads();
    }
    epi.template run<MI>(acc, m0 + wm * WM, n0 + wn * 64, lane);
}

#define ASTAT_SLAB (128 * GEMM_ROWB)
template <int KT, class Epi>
__device__ __forceinline__ void gemm_astat(const bf16* A, int lda, const int* __restrict__ rowidx, int m0, const bf16* B, int ldb, int NT, const Epi& epi, char* smem) {
    const int tid = otid(), lane = tid & 63, wave = tid >> 6;
    const int kc = tid & 7, r0 = tid >> 3;
    const int wm = wave >> 1, wn = wave & 1;
    char* sA = smem; char* sB = smem + KT * ASTAT_SLAB;
    {
        u32x4 ra[KT][2];
#pragma unroll
        for (int i = 0; i < 2; ++i) {
            const int r = m0 + r0 + 64 * i; const int gr = rowidx ? rowidx[r] : r;
#pragma unroll
            for (int kt = 0; kt < KT; ++kt) ra[kt][i] = *(const u32x4*)(A + (size_t)gr * lda + kt * 64 + kc * 8);
        }
        __syncthreads();
#pragma unroll
        for (int kt = 0; kt < KT; ++kt)
#pragma unroll
            for (int i = 0; i < 2; ++i) *(u32x4*)(sA + kt * ASTAT_SLAB + (r0 + 64 * i) * GEMM_ROWB + kc * 16) = ra[kt][i];
    }
    const int total = NT * KT;
    int gq = 0;
    constexpr int D = 4;
    u32x4 rb[D][2];
    auto gload = [&](u32x4 (&r)[2]) {
        const int nt = gq / KT, kt = gq - nt * KT;
#pragma unroll
        for (int i = 0; i < 2; ++i) r[i] = *(const u32x4*)(B + (size_t)(nt * 128 + r0 + 64 * i) * ldb + kt * 64 + kc * 8);
        ++gq;
    };
    auto lstore = [&](int buf, const u32x4 (&r)[2]) {
#pragma unroll
        for (int i = 0; i < 2; ++i) *(u32x4*)(sB + buf * ASTAT_SLAB + (r0 + 64 * i) * GEMM_ROWB + kc * 16) = r[i];
    };
    f32x16 acc[1][2];
#pragma unroll
    for (int j = 0; j < 2; ++j)
#pragma unroll
        for (int q = 0; q < 16; ++q) acc[0][j][q] = 0.f;
    auto compute = [&](int buf, int q) {
        const int nt = q / KT, kt = q - nt * KT;
        const char* pa = sA + kt * ASTAT_SLAB + (wm * 32 + (lane & 31)) * GEMM_ROWB + (lane >> 5) * 16;
        const char* pb = sB + buf * ASTAT_SLAB + (wn * 64 + (lane & 31)) * GEMM_ROWB + (lane >> 5) * 16;
#pragma unroll
        for (int ks = 0; ks < 4; ++ks) {
            const bf16x8 af = *(const bf16x8*)(pa + ks * 32);
#pragma unroll
            for (int j = 0; j < 2; ++j) { const bf16x8 bfr = *(const bf16x8*)(pb + j * 32 * GEMM_ROWB + ks * 32); acc[0][j] = MFMA32(bfr, af, acc[0][j]); }
        }
        if (kt == KT - 1) {
            epi.template run<1>(acc, m0 + wm * 32, nt * 128 + wn * 64, lane);
#pragma unroll
            for (int j = 0; j < 2; ++j)
#pragma unroll
                for (int qq = 0; qq < 16; ++qq) acc[0][j][qq] = 0.f;
        }
    };
#pragma unroll
    for (int i = 0; i < D; ++i) if (i < total) gload(rb[i]);
    lstore(0, rb[0]);
    if (D < total) gload(rb[0]);
    __syncthreads();
    for (int t = 0; t < total; t += D) {
#pragma unroll
        for (int u = 0; u < D; ++u) {
            const int q = t + u;
            if (q < total) {
                compute(u & 1, q);
                if (q + 1 < total) lstore((u + 1) & 1, rb[(u + 1) % D]);
                if (q + 1 + D < total) gload(rb[(u + 1) % D]);
                __syncthreads();
            }
        }
    }
}

template <int KT, bool FP8 = false>
__device__ __forceinline__ void gemm_astat256(const bf16* A, int lda, int m0, const bf16* B, int ldb, int NT, bf16* C, int ldc, char* smem) {
    const int tid = otid(), lane = tid & 63, wave = tid >> 6;
    const int kc = tid & 7, r0 = tid >> 3;
    const int wm = wave >> 2, wn = wave & 3;
    char* sA = smem; char* sB = smem + KT * ASTAT_SLAB;
    {
        u32x4 ra[KT][2];
#pragma unroll
        for (int i = 0; i < 2; ++i)
#pragma unroll
            for (int kt = 0; kt < KT; ++kt) ra[kt][i] = *(const u32x4*)(A + (size_t)(m0 + r0 + 64 * i) * lda + kt * 64 + kc * 8);
        __syncthreads();
#pragma unroll
        for (int kt = 0; kt < KT; ++kt)
#pragma unroll
            for (int i = 0; i < 2; ++i) *(u32x4*)(sA + kt * ASTAT_SLAB + (r0 + 64 * i) * GEMM_ROWB + kc * 16) = ra[kt][i];
    }
    const int total = NT * KT;
    int gq = 0;
    constexpr int D = 4;
    u32x4 rb[D][4];
    auto gload = [&](u32x4 (&r)[4]) {
        const int nt = gq / KT, kt = gq - nt * KT;
#pragma unroll
        for (int i = 0; i < 4; ++i) r[i] = *(const u32x4*)(B + (size_t)(nt * 256 + r0 + 64 * i) * ldb + kt * 64 + kc * 8);
        ++gq;
    };
    auto lstore = [&](int buf, const u32x4 (&r)[4]) {
#pragma unroll
        for (int i = 0; i < 4; ++i) *(u32x4*)(sB + buf * 2 * ASTAT_SLAB + (r0 + 64 * i) * GEMM_ROWB + kc * 16) = r[i];
    };
    f32x16 acc[2][2];
#pragma unroll
    for (int i = 0; i < 2; ++i)
#pragma unroll
        for (int j = 0; j < 2; ++j)
#pragma unroll
            for (int q = 0; q < 16; ++q) acc[i][j][q] = 0.f;
    auto compute = [&](int buf, int q) {
        const int nt = q / KT, kt = q - nt * KT;
        const char* pa = sA + kt * ASTAT_SLAB + (wm * 64 + (lane & 31)) * GEMM_ROWB + (lane >> 5) * 16;
        const char* pb = sB + buf * 2 * ASTAT_SLAB + (wn * 64 + (lane & 31)) * GEMM_ROWB + (lane >> 5) * 16;
#pragma unroll
        for (int ks = 0; ks < 4; ++ks) {
            bf16x8 af[2], bfr[2];
#pragma unroll
            for (int i = 0; i < 2; ++i) af[i] = *(const bf16x8*)(pa + i * 32 * GEMM_ROWB + ks * 32);
#pragma unroll
            for (int j = 0; j < 2; ++j) bfr[j] = *(const bf16x8*)(pb + j * 32 * GEMM_ROWB + ks * 32);
#pragma unroll
            for (int i = 0; i < 2; ++i)
#pragma unroll
                for (int j = 0; j < 2; ++j) acc[i][j] = MFMA32(bfr[j], af[i], acc[i][j]);
        }
        if (kt == KT - 1) {
            __syncthreads();
            char* st = sB + buf * 2 * ASTAT_SLAB + wave * (32 * STG_ROWB);
            if (FP8) {
#pragma unroll
                for (int i = 0; i < 2; ++i) {
#pragma unroll
                    for (int j = 0; j < 2; ++j)
#pragma unroll
                        for (int g = 0; g < 4; ++g) {
                            int w = 0;
                            w = __builtin_amdgcn_cvt_pk_fp8_f32(acc[i][j][4 * g] * 16.f, acc[i][j][4 * g + 1] * 16.f, w, false);
                            w = __builtin_amdgcn_cvt_pk_fp8_f32(acc[i][j][4 * g + 2] * 16.f, acc[i][j][4 * g + 3] * 16.f, w, true);
                            *(int*)(st + (lane & 31) * 80 + (j * 32 + 8 * g + 4 * (lane >> 5))) = w;
                        }
                    __builtin_amdgcn_wave_barrier();
#pragma unroll
                    for (int it = 0; it < 2; ++it) {
                        const int row = it * 16 + (lane >> 2), c4 = lane & 3;
                        const u32x4 v = *(const u32x4*)(st + row * 80 + c4 * 16);
                        *(u32x4*)((char*)C + (size_t)(m0 + wm * 64 + i * 32 + row) * ldc + nt * 256 + wn * 64 + c4 * 16) = v;
                    }
                    __builtin_amdgcn_wave_barrier();
                }
            } else
#pragma unroll
            for (int i = 0; i < 2; ++i) {
#pragma unroll
                for (int j = 0; j < 2; ++j)
#pragma unroll
                    for (int g = 0; g < 4; ++g) {
                        u32x2 v; v[0] = pk2(acc[i][j][4 * g], acc[i][j][4 * g + 1]); v[1] = pk2(acc[i][j][4 * g + 2], acc[i][j][4 * g + 3]);
                        *(u32x2*)(st + (lane & 31) * STG_ROWB + (j * 32 + 8 * g + 4 * (lane >> 5)) * 2) = v;
                    }
                __builtin_amdgcn_wave_barrier();
#pragma unroll
                for (int it = 0; it < 4; ++it) {
                    const int row = it * 8 + (lane >> 3), c8 = lane & 7;
                    const u32x4 v = *(const u32x4*)(st + row * STG_ROWB + c8 * 16);
                    *(u32x4*)(C + (size_t)(m0 + wm * 64 + i * 32 + row) * ldc + nt * 256 + wn * 64 + c8 * 8) = v;
                }
                __builtin_amdgcn_wave_barrier();
            }
#pragma unroll
            for (int i = 0; i < 2; ++i)
#pragma unroll
                for (int j = 0; j < 2; ++j)
#pragma unroll
                    for (int qq = 0; qq < 16; ++qq) acc[i][j][qq] = 0.f;
        }
    };
#pragma unroll
    for (int i = 0; i < D; ++i) if (i < total) gload(rb[i]);
    lstore(0, rb[0]);
    if (D < total) gload(rb[0]);
    __syncthreads();
    for (int t = 0; t < total; t += D) {
#pragma unroll
        for (int u = 0; u < D; ++u) {
            const int q = t + u;
            if (q < total) {
                compute(u & 1, q);
                if (q + 1 < total) lstore((u + 1) & 1, rb[(u + 1) % D]);
                if (q + 1 + D < total) gload(rb[(u + 1) % D]);
                __syncthreads();
            }
        }
    }
}

namespace g8 {
typedef float f32x4v __attribute__((ext_vector_type(4)));
constexpr int BK = 64, HALF = 128, HTB = HALF * BK * 2, STAGE_BYTES = 8 * HTB;
__device__ __forceinline__ int lds_byte(int r, int c) { const int st = (r >> 4) * 2 + (c >> 5), rr = r & 15, cc = c & 31, ob = rr * 64 + cc * 2; return st * 1024 + (ob ^ (((ob >> 9) & 1) << 5)); }
__device__ __forceinline__ void stage_rc(int b, int& R, int& C) { const int st = b / 1024, sb = b % 1024, swz = sb ^ (((sb >> 9) & 1) << 5); R = (st >> 1) * 16 + swz / 64; C = (st & 1) * 32 + (swz % 64) / 2; }
struct Unit { const char* A; const char* B; const int* rows; int pm, pn; };

template <bool GATHER, bool PERM = false, class Epi, class Sched>
__device__ __forceinline__ void gemm_phase(LAS unsigned char* lds, int K, const Sched& S, const Epi& E) {
    const int tid = otid(), wid = __builtin_amdgcn_readfirstlane(tid >> 6), lane = tid & 63, wr = wid >> 2, wc = wid & 3, fr = lane & 15, fq = lane >> 4;
    const int nt = K / BK;
    unsigned voffB[2];
#pragma unroll
    for (int i = 0; i < 2; ++i) { int R_, C_; stage_rc(tid * 16 + i * 8192, R_, C_);
        const int Rb = PERM ? ((R_ & ~31) + 8 * ((R_ & 15) >> 2) + 4 * ((R_ & 31) >> 4) + (R_ & 3)) : R_;
        voffB[i] = (unsigned)(Rb * K + C_) * 2u; }
    const size_t kstep = (size_t)(BK * 2);
    const size_t hstepB = (size_t)HALF * K * 2;
    const unsigned ldsw = (unsigned)wid * 1024u;
    const int aoff = lds_byte(wr * 64 + fr, fq * 8), boff = lds_byte(wc * 32 + fr, fq * 8);
#define G8_SA(b, h) (((b) * 2 + (h)) * HTB)
#define G8_SB(b, h) ((4 + (b) * 2 + (h)) * HTB)
#define G8_STAGE(bufoff, gbase, voff) do { _Pragma("unroll") for (int _i = 0; _i < 2; ++_i) \
        __builtin_amdgcn_global_load_lds((const unsigned*)((const char*)(gbase) + (voff)[_i]), (LAS unsigned*)(lds + (bufoff) + ldsw + _i * 8192), 16, 0, 0); } while (0)
#define G8_LDA(dst, b, h) do { _Pragma("unroll") for (int m = 0; m < 4; ++m) _Pragma("unroll") for (int k = 0; k < 2; ++k) dst[m][k] = *(const LAS bf16x8*)(lds + G8_SA(b, h) + aoff + m * 2048 + k * 1024); } while (0)
#define G8_LDB(dst, b, h) do { _Pragma("unroll") for (int n = 0; n < 2; ++n) _Pragma("unroll") for (int k = 0; k < 2; ++k) dst[n][k] = *(const LAS bf16x8*)(lds + G8_SB(b, h) + boff + n * 2048 + k * 1024); } while (0)
#define G8_MMA(ai, bj, At, Bt) do { __builtin_amdgcn_s_setprio(1); _Pragma("unroll") for (int m = 0; m < 4; ++m) _Pragma("unroll") for (int n = 0; n < 2; ++n) _Pragma("unroll") for (int k = 0; k < 2; ++k) \
        acc[ai][bj][m][n] = __builtin_amdgcn_mfma_f32_16x16x32_bf16(Bt[n][k], At[m][k], acc[ai][bj][m][n], 0, 0, 0); __builtin_amdgcn_s_setprio(0); } while (0)
#define G8_WAIT_V(n) asm volatile("s_waitcnt vmcnt(" #n ")" ::: "memory")
#define G8_WAIT_L(n) asm volatile("s_waitcnt lgkmcnt(" #n ")" ::: "memory")
#define G8_BAR __builtin_amdgcn_s_barrier()
#define G8_SCHED __builtin_amdgcn_sched_barrier(0)
    auto set_voffA = [&](const Unit& u, unsigned (&v)[2][2]) {
#pragma unroll
        for (int h2 = 0; h2 < 2; ++h2)
#pragma unroll
            for (int i = 0; i < 2; ++i) { int R_, C_; stage_rc(otid() * 16 + i * 8192, R_, C_); const int rr = h2 * HALF + R_; const int row = u.rows ? u.rows[rr] : rr; v[h2][i] = (unsigned)(row * K + C_) * 2u; }
    };
    Unit cur, nxt; int ui = 0;
    if (!S.next(0, cur)) return;
    f32x4v acc[2][2][4][2];
#pragma unroll
    for (int a = 0; a < 2; ++a)
#pragma unroll
        for (int b = 0; b < 2; ++b)
#pragma unroll
            for (int m = 0; m < 4; ++m)
#pragma unroll
                for (int n = 0; n < 2; ++n) acc[a][b][m][n] = (f32x4v){0.f, 0.f, 0.f, 0.f};
    bf16x8 At[4][2], B0[2][2], B1[2][2];
    unsigned vA[2][2], nvA[2][2];
    set_voffA(cur, vA);
    const char* cA = cur.A; const char* cB = cur.B;
    G8_STAGE(G8_SB(0, 0), cB, voffB); G8_STAGE(G8_SA(0, 0), cA, vA[0]); G8_STAGE(G8_SB(0, 1), cB + hstepB, voffB); G8_STAGE(G8_SA(0, 1), cA, vA[1]);
    if (wr == 1) G8_BAR;
    G8_WAIT_V(4); G8_BAR;
    G8_STAGE(G8_SB(1, 0), cB + kstep, voffB); G8_STAGE(G8_SA(1, 0), cA + kstep, vA[0]); G8_STAGE(G8_SB(1, 1), cB + hstepB + kstep, voffB);
    G8_WAIT_V(6); G8_BAR;
    for (;;) {
        const bool has_next = S.next(ui + 1, nxt);
        const char* nA = has_next ? nxt.A : cA; const char* nB = has_next ? nxt.B : cB;
        if (GATHER) {
            if (has_next) set_voffA(nxt, nvA);
            else {
#pragma unroll
                for (int h2 = 0; h2 < 2; ++h2)
#pragma unroll
                    for (int i = 0; i < 2; ++i) nvA[h2][i] = vA[h2][i];
            }
        }
        for (int t = 0; t < nt; t += 2) {
            const bool last = (t == nt - 2);
            const char* a1 = cA + (size_t)(t + 1) * kstep;
            const char* a2 = last ? nA : cA + (size_t)(t + 2) * kstep; const char* b2 = last ? nB : cB + (size_t)(t + 2) * kstep;
            const char* a3 = a2 + kstep; const char* b3 = b2 + kstep;
            G8_LDB(B0, 0, 0); G8_SCHED; G8_LDA(At, 0, 0); G8_STAGE(G8_SA(1, 1), a1, vA[1]);
            if (GATHER && last) {
#pragma unroll
                for (int h2 = 0; h2 < 2; ++h2)
#pragma unroll
                    for (int i = 0; i < 2; ++i) vA[h2][i] = nvA[h2][i];
            }
            G8_WAIT_L(8); G8_BAR; G8_WAIT_L(0); G8_MMA(0, 0, At, B0); G8_BAR; G8_SCHED;
            G8_LDB(B1, 0, 1); G8_STAGE(G8_SB(0, 0), b2, voffB);
            G8_BAR; G8_WAIT_L(0); G8_MMA(0, 1, At, B1); G8_BAR;
            G8_LDA(At, 0, 1); G8_STAGE(G8_SA(0, 0), a2, vA[0]);
            G8_BAR; G8_WAIT_L(0); G8_MMA(1, 0, At, B0); G8_BAR; G8_SCHED;
            G8_STAGE(G8_SB(0, 1), b2 + hstepB, voffB);
            G8_WAIT_V(6); G8_BAR; G8_MMA(1, 1, At, B1); G8_BAR;
            G8_LDB(B0, 1, 0); G8_SCHED; G8_LDA(At, 1, 0); G8_STAGE(G8_SA(0, 1), a2, vA[1]);
            G8_WAIT_L(8); G8_BAR; G8_WAIT_L(0); G8_MMA(0, 0, At, B0); G8_BAR; G8_SCHED;
            G8_LDB(B1, 1, 1); G8_STAGE(G8_SB(1, 0), b3, voffB);
            G8_BAR; G8_WAIT_L(0); G8_MMA(0, 1, At, B1); G8_BAR;
            G8_LDA(At, 1, 1); G8_STAGE(G8_SA(1, 0), a3, vA[0]);
            G8_BAR; G8_WAIT_L(0); G8_MMA(1, 0, At, B0); G8_BAR; G8_SCHED;
            G8_STAGE(G8_SB(1, 1), b3 + hstepB, voffB);
            G8_WAIT_V(6); G8_BAR; G8_MMA(1, 1, At, B1); G8_BAR;
        }
        E(acc, cur, wr, wc, fr, fq);
        if (!has_next) break;
#pragma unroll
        for (int a = 0; a < 2; ++a)
#pragma unroll
            for (int b = 0; b < 2; ++b)
#pragma unroll
                for (int m = 0; m < 4; ++m)
#pragma unroll
                    for (int n = 0; n < 2; ++n) acc[a][b][m][n] = (f32x4v){0.f, 0.f, 0.f, 0.f};
        cur = nxt; cA = nA; cB = nB; ++ui;
    }
    G8_WAIT_V(0);
    if (wr == 0) G8_BAR;
    G8_BAR;
#undef G8_SA
#undef G8_SB
#undef G8_STAGE
#undef G8_LDA
#undef G8_LDB
#undef G8_MMA
#undef G8_WAIT_V
#undef G8_WAIT_L
#undef G8_BAR
#undef G8_SCHED
}
struct GridOrder {
    const char* A; const char* Bt; int K, nM, nN, nwg, G, c, skipctx;
    __device__ __forceinline__ bool next(int i, Unit& u) const {
        const long L = (long)i * G + c; if (L >= nwg) return false;
        int wgid = (int)L; { const int q = nwg / 8, r = nwg % 8, xcd = wgid % 8, off = wgid / 8; wgid = (xcd < r ? xcd * (q + 1) : r * (q + 1) + (xcd - r) * q) + off; }
        const int nig = 8 * nN, gid = wgid / nig, fm = gid * 8, gsz = (nM - fm) < 8 ? (nM - fm) : 8;
        u.pm = fm + ((wgid % nig) % gsz); u.pn = (wgid % nig) / gsz;
        if (skipctx) u.pm = (u.pm >> 5) * 33 + 1 + (u.pm & 31);
        u.A = A + (size_t)u.pm * 256 * K * 2; u.B = Bt + (size_t)u.pn * 256 * K * 2; u.rows = nullptr; return true;
    }
};
}

#define EPI_FOR(MI)                                                                                   \
    _Pragma("unroll") for (int i_ = 0; i_ < MI; ++i_)                                                 \
    _Pragma("unroll") for (int j_ = 0; j_ < 2; ++j_)                                                  \
    _Pragma("unroll") for (int g_ = 0; g_ < 4; ++g_)
#define EPI_M (mb + i_ * 32 + (lane & 31))
#define EPI_N (nb + j_ * 32 + 8 * g_ + 4 * (lane >> 5))
#define EPI_V(q) (acc[i_][j_][4 * g_ + (q)])

__device__ __forceinline__ void st_bf4(bf16* p, float a, float b, float c, float d) { u32x2 v; v[0] = pk2(a, b); v[1] = pk2(c, d); *(u32x2*)p = v; }
template <int MI>
__device__ __forceinline__ void stage_store_bf16(f32x16 (&acc)[MI][2], char* stg, bf16* C, int ldc, int mb, int nb, int lane) {
#pragma unroll
    for (int i = 0; i < MI; ++i)
#pragma unroll
        for (int j = 0; j < 2; ++j)
#pragma unroll
            for (int g = 0; g < 4; ++g) {
                u32x2 v; v[0] = pk2(acc[i][j][4 * g], acc[i][j][4 * g + 1]); v[1] = pk2(acc[i][j][4 * g + 2], acc[i][j][4 * g + 3]);
                *(u32x2*)(stg + (i * 32 + (lane & 31)) * STG_ROWB + (j * 32 + 8 * g + 4 * (lane >> 5)) * 2) = v;
            }
    __builtin_amdgcn_wave_barrier();
#pragma unroll
    for (int it = 0; it < MI * 4; ++it) {
        const int row = it * 8 + (lane >> 3), ch = lane & 7;
        const u32x4 v = *(const u32x4*)(stg + row * STG_ROWB + ch * 16);
        *(u32x4*)(C + (size_t)(mb + row) * ldc + nb + ch * 8) = v;
    }
    __builtin_amdgcn_wave_barrier();
}
struct EpiBf16Stg {
    bf16* C; int ldc; char* stg;
    template <int MI> __device__ __forceinline__ void run(f32x16 (&acc)[MI][2], int mb, int nb, int lane) const {
        const int wave = otid() >> 6;
        stage_store_bf16<MI>(acc, stg + wave * (MI * 32 * STG_ROWB), C, ldc, mb, nb, lane);
    }
};

struct EpiInproj {
    bf16* ug; bf16* z; float* gates; char* stg;
    template <int MI> __device__ __forceinline__ void run(f32x16 (&acc)[MI][2], int mb, int nb, int lane) const {
        if (nb >= 256 && nb + 64 <= 1696) { stage_store_bf16<MI>(acc, stg + (otid() >> 6) * (MI * 32 * STG_ROWB), z, ZW, mb, nb - 256, lane); return; }
        EPI_FOR(MI) {
            const int m = EPI_M, n = EPI_N;
            const float v0 = EPI_V(0), v1 = EPI_V(1), v2 = EPI_V(2), v3 = EPI_V(3);
            if (n < 256) {
                const int g = n >> 4, cc = n & 15, b = m / SQ, s = m - b * SQ;
                const int row = b * NCH + (s >> 6), j = s & 63;
                st_bf4(ug + ((size_t)g * NROWP + row) * 1024 + j * 16 + cc, v0, v1, v2, v3);
            } else if (n < 1696) {
                st_bf4(z + (size_t)m * ZW + (n - 256), v0, v1, v2, v3);
            } else if (n < 1712) {
                f32x4 v = {v0, v1, v2, v3};
                *(f32x4*)(gates + (size_t)m * 16 + (n - 1696)) = v;
            }
        }
    }
};
struct EpiRouterSum {
    float* C; char* stg;
    template <int MI> __device__ __forceinline__ void run(f32x16 (&acc)[MI][2], int mb, int nb, int lane) const {
        float* st = (float*)stg + (otid() >> 7) * (MI * 2 * 16 * 64);
        if (nb >= 64) {
#pragma unroll
            for (int i = 0; i < MI; ++i)
#pragma unroll
                for (int j = 0; j < 2; ++j)
#pragma unroll
                    for (int q = 0; q < 16; ++q) st[((i * 2 + j) * 16 + q) * 64 + lane] = acc[i][j][q];
        }
        __syncthreads();
        if (nb < 64) {
#pragma unroll
            for (int i = 0; i < MI; ++i)
#pragma unroll
                for (int j = 0; j < 2; ++j)
#pragma unroll
                    for (int q = 0; q < 16; ++q) acc[i][j][q] += st[((i * 2 + j) * 16 + q) * 64 + lane];
            EPI_FOR(MI) {
                const int m = EPI_M, n = EPI_N;
                if (m < NTOK) { f32x4 v = {EPI_V(0), EPI_V(1), EPI_V(2), EPI_V(3)}; *(f32x4*)(C + (size_t)m * 64 + n) = v; }
            }
        }
    }
};
struct EpiF32 {
    float* C; int ldc, mvalid, nvalid;
    template <int MI> __device__ __forceinline__ void run(f32x16 (&acc)[MI][2], int mb, int nb, int lane) const {
        EPI_FOR(MI) {
            const int m = EPI_M, n = EPI_N;
            if (m < mvalid && n < nvalid) { f32x4 v = {EPI_V(0), EPI_V(1), EPI_V(2), EPI_V(3)}; *(f32x4*)(C + (size_t)m * ldc + n) = v; }
        }
    }
};
struct EpiBf16 {
    bf16* C; int ldc;
    template <int MI> __device__ __forceinline__ void run(f32x16 (&acc)[MI][2], int mb, int nb, int lane) const {
        EPI_FOR(MI) { st_bf4(C + (size_t)EPI_M * ldc + EPI_N, EPI_V(0), EPI_V(1), EPI_V(2), EPI_V(3)); }
    }
};
struct EpiS5Y {
    bf16* gs; int g;
    template <int MI> __device__ __forceinline__ void run(f32x16 (&acc)[MI][2], int mb, int nb, int lane) const {
        EPI_FOR(MI) {
            const int m = EPI_M, n = EPI_N;
            if (m < NROW) {
                const int b = m / NCH, c = m - b * NCH, i = n >> 4, cc = n & 15;
                const size_t tok = (size_t)b * SQ + c * 64 + i;
                st_bf4(gs + tok * 256 + g * 16 + cc, gelu_tanh(EPI_V(0)), gelu_tanh(EPI_V(1)), gelu_tanh(EPI_V(2)), gelu_tanh(EPI_V(3)));
            }
        }
    }
};
struct EpiGlu {
    const bf16* gs; const float* bias; bf16* cat; char* stg;
    template <int MI> __device__ __forceinline__ void run(f32x16 (&acc)[MI][2], int mb, int nb, int lane) const {
        EPI_FOR(MI) {
            const int m = EPI_M, n = EPI_N;
            const u32x2 gv = *(const u32x2*)(gs + (size_t)m * 256 + n);
            const f32x4 bv = *(const f32x4*)(bias + n);
            acc[i_][j_][4 * g_] = bflo(gv[0]) * sigmoidf_(EPI_V(0) + bv[0]); acc[i_][j_][4 * g_ + 1] = bfhi(gv[0]) * sigmoidf_(EPI_V(1) + bv[1]);
            acc[i_][j_][4 * g_ + 2] = bflo(gv[1]) * sigmoidf_(EPI_V(2) + bv[2]); acc[i_][j_][4 * g_ + 3] = bfhi(gv[1]) * sigmoidf_(EPI_V(3) + bv[3]);
        }
        stage_store_bf16<MI>(acc, stg + (otid() >> 6) * (MI * 32 * STG_ROWB), cat, 1024, mb, nb, lane);
    }
};
struct EpiQ {
    const float* rq; const float* tab; bf16* q; char* stg;
    template <int MI> __device__ __forceinline__ void run(f32x16 (&acc)[MI][2], int mb, int nb, int lane) const {
        EPI_FOR(MI) {
            const int m = EPI_M, n = EPI_N;
            const int b = m / SQ, s = m - b * SQ, hd = n / 96, d = n - hd * 96;
            const float sc = rq[m] * QSCALE;
            float v0 = EPI_V(0) * sc, v1 = EPI_V(1) * sc, v2 = EPI_V(2) * sc, v3 = EPI_V(3) * sc;
            if (d >= 64 && s >= CTXL) {
                const int r = d - 64, ax = r >> 4, i0 = (r & 15) >> 1, sl = s - CTXL;
                const int pos = ax ? (sl & 63) : (sl >> 6);
                const f32x4 cs = *(const f32x4*)(tab + (pos * 8 + i0) * 2);
                const float a0 = v0 * cs[0] - v1 * cs[1], a1 = v0 * cs[1] + v1 * cs[0];
                const float a2 = v2 * cs[2] - v3 * cs[3], a3 = v2 * cs[3] + v3 * cs[2];
                v0 = a0; v1 = a1; v2 = a2; v3 = a3;
            }
            acc[i_][j_][4 * g_] = v0; acc[i_][j_][4 * g_ + 1] = v1; acc[i_][j_][4 * g_ + 2] = v2; acc[i_][j_][4 * g_ + 3] = v3;
        }
        stage_store_bf16<MI>(acc, stg + (otid() >> 6) * (MI * 32 * STG_ROWB), q, 768, mb, nb, lane);
    }
};
struct EpiKV {
    const float* rkv; bf16* kf; bf16* vt; char* stg;
    template <int MI> __device__ __forceinline__ void run(f32x16 (&acc)[MI][2], int mb, int nb, int lane) const {
        const int hd = nb >> 7;
        if ((nb & 64) == 0) {
            const int b = mb / SQ, s0 = mb - b * SQ;
            EPI_FOR(MI) { const float sc = rkv[EPI_M]; acc[i_][j_][4 * g_] *= sc; acc[i_][j_][4 * g_ + 1] *= sc; acc[i_][j_][4 * g_ + 2] *= sc; acc[i_][j_][4 * g_ + 3] *= sc; }
            stage_store_bf16<MI>(acc, stg + (otid() >> 6) * (MI * 32 * STG_ROWB), kf + (size_t)(b * 8 + hd) * SQ * 96, 96, s0, 0, lane);
            return;
        }
        EPI_FOR(MI) {
            const int m = EPI_M, n = EPI_N;
            const int b = m / SQ, s = m - b * SQ, d2 = n & 127;
            const float sc = rkv[m];
            const float v0 = EPI_V(0) * sc, v1 = EPI_V(1) * sc, v2 = EPI_V(2) * sc, v3 = EPI_V(3) * sc;
            bf16* p = vt + ((size_t)(b * 8 + hd) * 64 + (d2 - 64)) * SQ + s;
            p[0] = f2bf(v0); p[SQ] = f2bf(v1); p[2 * SQ] = f2bf(v2); p[3 * SQ] = f2bf(v3);
        }
    }
};
struct EpiMoeUp {
    const float* slotgate; bf16* hc; char* stg;
    template <int MI> __device__ __forceinline__ void run(f32x16 (&acc)[MI][2], int mb, int nb, int lane) const {
        char* st = stg + (otid() >> 6) * (MI * 32 * 80);
#pragma unroll
        for (int i_ = 0; i_ < MI; ++i_)
#pragma unroll
            for (int g_ = 0; g_ < 4; ++g_) {
                const int rl = i_ * 32 + (lane & 31);
                const float gw = slotgate[mb + rl];
                float o[4];
#pragma unroll
                for (int q = 0; q < 4; ++q) o[q] = gw * siluf_(acc[i_][0][4 * g_ + q]) * acc[i_][1][4 * g_ + q];
                u32x2 v; v[0] = pk2(o[0], o[1]); v[1] = pk2(o[2], o[3]);
                *(u32x2*)(st + rl * 80 + (8 * g_ + 4 * (lane >> 5)) * 2) = v;
            }
        __builtin_amdgcn_wave_barrier();
#pragma unroll
        for (int it = 0; it < MI * 2; ++it) {
            const int row = it * 16 + (lane >> 2), ch = lane & 3;
            const u32x4 v = *(const u32x4*)(st + row * 80 + ch * 16);
            *(u32x4*)(hc + (size_t)(mb + row) * 256 + (nb >> 1) + ch * 8) = v;
        }
        __builtin_amdgcn_wave_barrier();
    }
};

struct EpiInproj8 {
    bf16* ug; bf16* z; float* gates;
    __device__ __forceinline__ void operator()(const g8::f32x4v (&acc)[2][2][4][2], const g8::Unit& u, int wr, int wc, int fr, int fq) const {
#pragma unroll
        for (int ai = 0; ai < 2; ++ai)
#pragma unroll
            for (int mm = 0; mm < 4; ++mm) {
                const int m = u.pm * 256 + 128 * ai + 64 * wr + 16 * mm + fr;
                const int b = m / SQ, s = m - b * SQ;
#pragma unroll
                for (int bj = 0; bj < 2; ++bj) {
                    const int n = u.pn * 256 + 128 * bj + 32 * wc + 8 * fq;
                    const g8::f32x4v a = acc[ai][bj][mm][0], c = acc[ai][bj][mm][1];
                    if (n < 1696) {
                        u32x4 o = {pk2(a[0], a[1]), pk2(a[2], a[3]), pk2(c[0], c[1]), pk2(c[2], c[3])};
                        if (n < 256) {
                            const int g = n >> 4, cc = n & 15, row = b * NCH + (s >> 6), j = s & 63;
                            *(u32x4*)(ug + ((size_t)g * NROWP + row) * 1024 + j * 16 + cc) = o;
                        } else *(u32x4*)(z + (size_t)m * ZW + (n - 256)) = o;
                    } else if (n < 1712) {
                        f32x4 w0 = {a[0], a[1], a[2], a[3]}, w1 = {c[0], c[1], c[2], c[3]};
                        *(f32x4*)(gates + (size_t)m * 16 + (n - 1696)) = w0; *(f32x4*)(gates + (size_t)m * 16 + (n - 1696) + 4) = w1;
                    }
                }
            }
    }
};
struct EpiBf16_8 {
    bf16* C; int ldc;
    __device__ __forceinline__ void operator()(const g8::f32x4v (&acc)[2][2][4][2], const g8::Unit& u, int wr, int wc, int fr, int fq) const {
#pragma unroll
        for (int ai = 0; ai < 2; ++ai)
#pragma unroll
            for (int mm = 0; mm < 4; ++mm) {
                bf16* rowp = C + (size_t)(u.pm * 256 + 128 * ai + 64 * wr + 16 * mm + fr) * ldc + u.pn * 256 + 32 * wc + 8 * fq;
#pragma unroll
                for (int bj = 0; bj < 2; ++bj) {
                    const g8::f32x4v a = acc[ai][bj][mm][0], b = acc[ai][bj][mm][1];
                    u32x4 o = {pk2(a[0], a[1]), pk2(a[2], a[3]), pk2(b[0], b[1]), pk2(b[2], b[3])};
                    *(u32x4*)(rowp + 128 * bj) = o;
                }
            }
    }
};
struct EpiUp8 {
    const float* slotgate; bf16* hc;
    __device__ __forceinline__ void operator()(const g8::f32x4v (&acc)[2][2][4][2], const g8::Unit& u, int wr, int wc, int fr, int fq) const {
#pragma unroll
        for (int ai = 0; ai < 2; ++ai)
#pragma unroll
            for (int mm = 0; mm < 4; ++mm) {
                const int slot = u.pm + 128 * ai + 64 * wr + 16 * mm + fr;
                const float gw = slotgate[slot];
#pragma unroll
                for (int bj = 0; bj < 2; ++bj) {
                    const g8::f32x4v gv = acc[ai][bj][mm][0], uv = acc[ai][bj][mm][1];
                    const int j = u.pn * 128 + 64 * bj + 16 * wc + 4 * fq;
                    st_bf4(hc + (size_t)slot * 256 + j, gw * siluf_(gv[0]) * uv[0], gw * siluf_(gv[1]) * uv[1], gw * siluf_(gv[2]) * uv[2], gw * siluf_(gv[3]) * uv[3]);
                }
            }
    }
};
struct UpOrder {
    const char* A; const char* Bt; const int* slottok; const int* ue; const int* ur; int nu2, G, c;
    __device__ __forceinline__ bool next(int i, g8::Unit& u) const {
        const int L = i * G + c; if (L >= nu2) return false;
        const int k = L >> 1, pn = L & 1, e = ue[k], row0 = ur[k];
        u.A = A; u.rows = slottok + row0; u.B = Bt + ((size_t)e * 512 + pn * 256) * 1024 * 2; u.pm = row0; u.pn = pn; return true;
    }
};

__device__ __forceinline__ const float* res_row_in(const Params& p, int layer, int tok) {
    const int b = tok / SQ, s = tok - b * SQ;
    if (layer == 0) return s < CTXL ? p.ctx + ((size_t)b * CTXL + s) * DM : p.x + ((size_t)b * SEQL + (s - CTXL)) * DM;
    return s < CTXL ? p.ctxres + ((size_t)b * CTXL + s) * DM : p.out + ((size_t)b * SEQL + (s - CTXL)) * DM;
}
__device__ __forceinline__ float* res_row_out(const Params& p, int tok) {
    const int b = tok / SQ, s = tok - b * SQ;
    return s < CTXL ? p.ctxres + ((size_t)b * CTXL + s) * DM : p.out + ((size_t)b * SEQL + (s - CTXL)) * DM;
}
__device__ __forceinline__ void row_ln(float (&v)[16]) {
    float s = 0.f;
#pragma unroll
    for (int i = 0; i < 16; ++i) s += v[i];
    const float mu = wave_sum(s) * (1.f / 1024.f);
    float q = 0.f;
#pragma unroll
    for (int i = 0; i < 16; ++i) { v[i] -= mu; q += v[i] * v[i]; }
    const float rs = rsqrtf(wave_sum(q) * (1.f / 1024.f) + LN_EPS);
#pragma unroll
    for (int i = 0; i < 16; ++i) v[i] *= rs;
}
__device__ __forceinline__ void row_ld(const float* r, int lane, float (&v)[16]) {
#pragma unroll
    for (int j = 0; j < 4; ++j) { const f32x4 t = *(const f32x4*)(r + 4 * lane + 256 * j); v[4 * j] = t[0]; v[4 * j + 1] = t[1]; v[4 * j + 2] = t[2]; v[4 * j + 3] = t[3]; }
}
__device__ __forceinline__ void row_ld_nt(const float* r, int lane, float (&v)[16]) {
#pragma unroll
    for (int j = 0; j < 4; ++j) { const f32x4 t = __builtin_nontemporal_load((const f32x4*)(r + 4 * lane + 256 * j)); v[4 * j] = t[0]; v[4 * j + 1] = t[1]; v[4 * j + 2] = t[2]; v[4 * j + 3] = t[3]; }
}
__device__ __forceinline__ void row_ld_bf_nt(const bf16* r, int lane, float (&v)[16]) {
#pragma unroll
    for (int j = 0; j < 4; ++j) { const u32x2 t = __builtin_nontemporal_load((const u32x2*)(r + 4 * lane + 256 * j)); v[4 * j] = bflo(t[0]); v[4 * j + 1] = bfhi(t[0]); v[4 * j + 2] = bflo(t[1]); v[4 * j + 3] = bfhi(t[1]); }
}
__device__ __forceinline__ void row_st(float* r, int lane, const float (&v)[16]) {
#pragma unroll
    for (int j = 0; j < 4; ++j) { f32x4 t = {v[4 * j], v[4 * j + 1], v[4 * j + 2], v[4 * j + 3]}; *(f32x4*)(r + 4 * lane + 256 * j) = t; }
}
__device__ __forceinline__ void row_st_bf(bf16* r, int lane, const float (&v)[16]) {
#pragma unroll
    for (int j = 0; j < 4; ++j) st_bf4(r + 4 * lane + 256 * j, v[4 * j], v[4 * j + 1], v[4 * j + 2], v[4 * j + 3]);
}
__device__ __forceinline__ void row_ld_f8(const unsigned char* r, int lane, float (&v)[16]) {
    typedef float f2v __attribute__((ext_vector_type(2)));
#pragma unroll
    for (int j = 0; j < 4; ++j) {
        const int w = __builtin_nontemporal_load((const int*)(r + 4 * lane + 256 * j));
        const f2v lo = __builtin_amdgcn_cvt_pk_f32_fp8(w, false), hi = __builtin_amdgcn_cvt_pk_f32_fp8(w, true);
        v[4 * j] = lo[0] * 0.0625f; v[4 * j + 1] = lo[1] * 0.0625f; v[4 * j + 2] = hi[0] * 0.0625f; v[4 * j + 3] = hi[1] * 0.0625f;
    }
}
__device__ __forceinline__ void row_ld_bf(const bf16* r, int lane, float (&v)[16]) {
#pragma unroll
    for (int j = 0; j < 4; ++j) { const u32x2 t = *(const u32x2*)(r + 4 * lane + 256 * j); v[4 * j] = bflo(t[0]); v[4 * j + 1] = bfhi(t[0]); v[4 * j + 2] = bflo(t[1]); v[4 * j + 3] = bfhi(t[1]); }
}

__device__ __forceinline__ void wave_token_range(int wave, int& t0, int& t1) {
    const int G = gridDim.x, b = blockIdx.x;
    const int b0 = (int)(((long)NTOK * b) / G), b1 = (int)(((long)NTOK * (b + 1)) / G), n = b1 - b0;
    t0 = b0 + (n * wave) / 8; t1 = b0 + (n * (wave + 1)) / 8;
}
__device__ __forceinline__ void phase_ln_mod(const Params& p, int layer, int item) {
    const int lane = otid() & 63, wave = otid() >> 6;
    int t0, t1; wave_token_range(wave, t0, t1); (void)item;
    for (int tok = t0; tok < t1; ++tok) {
        const int b = tok / SQ, s = tok - b * SQ;
        const float* mv = p.modv + (size_t)(layer * 9 + (s < CTXL ? 8 : b)) * 6144;
        float v[16], sh[16], sc[16];
        row_ld_nt(res_row_in(p, layer, tok), lane, v);
        row_ld(mv, lane, sh); row_ld(mv + 1024, lane, sc);
        row_ln(v);
#pragma unroll
        for (int k = 0; k < 16; ++k) v[k] = v[k] * (1.f + sc[k]) + sh[k];
        row_st_bf(p.h + (size_t)tok * DM, lane, v);
    }
}
template <int DUMMY>
__device__ __forceinline__ void phase_post_mixer(const Params& p, int layer, int item) {
    const int lane = otid() & 63, wave = otid() >> 6;
    const bf16* y = p.z;
    bf16* fhi = p.h; bf16* flo = p.cat;
    int t0, t1; if (DUMMY) { t0 = item * 64 + wave * 8; t1 = t0 + 8; } else wave_token_range(wave, t0, t1);
    for (int tok = t0; tok < t1; ++tok) {
        const int b = tok / SQ, s = tok - b * SQ;
        if (!DUMMY && layer == 1 && s < CTXL) continue;
        const float* mv = p.modv + (size_t)(layer * 9 + (s < CTXL ? 8 : b)) * 6144;
        float v[16], t[16], u[16];
        if (layer == 0) row_ld_nt(res_row_in(p, 0, tok), lane, v); else row_ld_bf_nt((const bf16*)res_row_out(p, tok), lane, v);
        row_ld_bf_nt(y + (size_t)tok * DM, lane, t);
        row_ld(mv + 2048, lane, u);
#pragma unroll
        for (int k = 0; k < 16; ++k) v[k] = ALPHA_DN * v[k] + u[k] * t[k];
        row_ln(v);
        row_ld(p.ln1_g + layer * DM, lane, t); row_ld(p.ln1_b + layer * DM, lane, u);
#pragma unroll
        for (int k = 0; k < 16; ++k) v[k] = v[k] * t[k] + u[k];
        if (DUMMY) row_st((float*)p.yc + (size_t)(blockIdx.x * 8 + wave) * 1024, lane, v); else row_st_bf((bf16*)res_row_out(p, tok), lane, v);
        row_ln(v);
        row_ld(mv + 3072, lane, t); row_ld(mv + 4096, lane, u);
        float lo[16];
#pragma unroll
        for (int k = 0; k < 16; ++k) { v[k] = v[k] * (1.f + u[k]) + t[k]; const float hi = bf2f(f2bf(v[k])); lo[k] = v[k] - hi; }
        row_st_bf(DUMMY ? p.yc + (size_t)(4096 + blockIdx.x * 8 + wave) * 2048 : fhi + (size_t)tok * DM, lane, v);
        row_st_bf(DUMMY ? p.yc + (size_t)(8192 + blockIdx.x * 8 + wave) * 2048 : flo + (size_t)tok * DM, lane, lo);
    }
}
struct CombRows { u32x4 y[9]; u32x2 x[4]; };
__device__ __forceinline__ void comb_issue(const Params& p, int b, int s, int off_sh, const bf16* yc, int lane, CombRows& R) {
    const int tok = b * SQ + s;
    const unsigned char* yb = (const unsigned char*)yc;
    R.y[0] = __builtin_nontemporal_load((const u32x4*)(yb + (size_t)(off_sh + s) * DM + 16 * lane));
#pragma unroll
    for (int k = 0; k < 8; ++k) {
        const int slot = p.tokslot[tok * 8 + k];
        R.y[1 + k] = __builtin_nontemporal_load((const u32x4*)(yb + (size_t)slot * DM + 16 * lane));
    }
    const bf16* xr = (const bf16*)res_row_out(p, tok);
#pragma unroll
    for (int j = 0; j < 4; ++j) R.x[j] = __builtin_nontemporal_load((const u32x2*)(xr + 4 * lane + 256 * j));
}
__device__ __forceinline__ void phase_combine(const Params& p, int layer, int b, int item, const bf16* yc) {
    typedef float f2v __attribute__((ext_vector_type(2)));
    const int lane = otid() & 63, wave = otid() >> 6;
    const int off_sh = p.ntb[b * 2 + 1];
    (void)item;
    const int G = gridDim.x, nb0 = (int)(((long)SQ * blockIdx.x) / G), nb1 = (int)(((long)SQ * (blockIdx.x + 1)) / G), nn = nb1 - nb0;
    int sa = nb0 + (nn * wave) / 8; const int sb = nb0 + (nn * (wave + 1)) / 8;
    if (layer == 1 && sa < CTXL) sa = CTXL;
    if (sa >= sb) return;
    CombRows cur, nxt;
    comb_issue(p, b, sa, off_sh, yc, lane, cur);
    for (int s = sa; s < sb; ++s) {
        const int tok = b * SQ + s;
        if (s + 1 < sb) comb_issue(p, b, s + 1, off_sh, yc, lane, nxt);
        const float* mv = p.modv + (size_t)(layer * 9 + (s < CTXL ? 8 : b)) * 6144;
        float f[16], t[16], v[16];
#pragma unroll
        for (int q = 0; q < 16; ++q) f[q] = 0.f;
#pragma unroll
        for (int k = 0; k < 9; ++k)
#pragma unroll
            for (int j = 0; j < 4; ++j) {
                const f2v lo = __builtin_amdgcn_cvt_pk_f32_fp8((int)cur.y[k][j], false), hi = __builtin_amdgcn_cvt_pk_f32_fp8((int)cur.y[k][j], true);
                f[4 * j] += lo[0]; f[4 * j + 1] += lo[1]; f[4 * j + 2] += hi[0]; f[4 * j + 3] += hi[1];
            }
#pragma unroll
        for (int j = 0; j < 4; ++j) { v[4 * j] = bflo(cur.x[j][0]); v[4 * j + 1] = bfhi(cur.x[j][0]); v[4 * j + 2] = bflo(cur.x[j][1]); v[4 * j + 3] = bfhi(cur.x[j][1]); }
        float* xr = res_row_out(p, tok);
        row_ld(mv + 5120, lane, t);
#pragma unroll
        for (int q = 0; q < 16; ++q) v[q] = ALPHA_DN * v[q] + t[q] * (f[q] * 0.0625f);
        row_ln(v);
        row_ld(p.ln2_g + layer * DM, lane, t); row_ld(p.ln2_b + layer * DM, lane, f);
#pragma unroll
        for (int q = 0; q < 16; ++q) v[q] = v[q] * t[q] + f[q];
        if (layer != 0) row_st(xr, lane, v); else row_st_bf((bf16*)xr, lane, v);
        if (layer == 0) {
            const float* mv1 = p.modv + (size_t)(9 + (s < CTXL ? 8 : b)) * 6144;
            row_ln(v);
            row_ld(mv1, lane, t); row_ld(mv1 + 1024, lane, f);
#pragma unroll
            for (int q = 0; q < 16; ++q) v[q] = v[q] * (1.f + f[q]) + t[q];
            row_st_bf(p.h + (size_t)tok * DM, lane, v);
        }
        if (s + 1 < sb) cur = nxt;
    }
}

__device__ __forceinline__ void job_modv(const Params& p, int item, char* smem) {
    float* sc = (float*)smem;
    float* red = sc + 9 * 1024;
    const int tid = otid();
    for (int i = tid; i < 9 * 1024; i += 512) { const int r = i >> 10, k = i & 1023; const float cv = r < 8 ? p.c[r * 1024 + k] : p.c_ctx[k]; sc[i] = siluf_(cv); }
    __syncthreads();
    const int layer = item / 96, col = (item % 96) * 64 + (tid & 63), sl = tid >> 6;
    const float* w = p.ada_w + (size_t)layer * 1024 * 6144 + col + (size_t)sl * 128 * 6144;
    const float* scs = sc + sl * 128;
    float acc[9];
#pragma unroll
    for (int r = 0; r < 9; ++r) acc[r] = 0.f;
    for (int k = 0; k < 128; k += 8) {
        float wv[8];
#pragma unroll
        for (int u = 0; u < 8; ++u) wv[u] = w[(size_t)(k + u) * 6144];
#pragma unroll
        for (int u = 0; u < 8; ++u)
#pragma unroll
            for (int r = 0; r < 9; ++r) acc[r] += scs[r * 1024 + k + u] * wv[u];
    }
#pragma unroll
    for (int r = 0; r < 9; ++r) red[(sl * 9 + r) * 64 + (tid & 63)] = acc[r];
    __syncthreads();
    for (int e = tid; e < 9 * 64; e += 512) {
        const int r = e >> 6, c = e & 63;
        float v = 0.f;
#pragma unroll
        for (int q = 0; q < 8; ++q) v += red[(q * 9 + r) * 64 + c];
        const int cc = (item % 96) * 64 + c;
        p.modv[(size_t)(layer * 9 + r) * 6144 + cc] = v + p.ada_b[layer * 6144 + cc];
    }
}
__device__ __forceinline__ void job_rope_tab(const Params& p) {
    for (int e = otid(); e < 1024; e += 512) {
        const int pos = e >> 3, i = e & 7;
        const float invf = powf(10000.f, -(float)i / 8.f);
        const float ang = (float)pos * invf;
        p.rope_tab[e * 2] = cosf(ang); p.rope_tab[e * 2 + 1] = sinf(ang);
    }
}
__device__ __forceinline__ void job_s5_tables(const Params& p, int item, char* smem) {
    float2* s_pw = (float2*)smem;
    float2* s_bb = s_pw + 64 * 65;
    float2* s_cc = s_bb + 64 * 16;
    const int tid = otid();
    const int dir = item & 1, g = (item >> 1) & 15, l = item >> 5;
    const int lg = (l * 2 + dir) * 16 + g;
    const int og = (l * 16 + g) * 2 + dir;
    const float step = expf(p.log_step[lg]);
    for (int e = tid; e < 64 * 65; e += 512) {
        const int pp = e / 65, d = e - pp * 65;
        const float lr = p.lam_re[lg * 64 + pp] * step, li = p.lam_im[lg * 64 + pp] * step;
        const float mag = expf(lr * (float)d), ang = li * (float)d;
        const float2 v = make_float2(mag * cosf(ang), mag * sinf(ang));
        s_pw[e] = v; ((float2*)p.pw)[(size_t)og * 64 * 65 + e] = v;
    }
    for (int e = tid; e < 1024; e += 512) {
        const int pp = e >> 4;
        const float lre = p.lam_re[lg * 64 + pp], lim = p.lam_im[lg * 64 + pp];
        const float lr = lre * step, li = lim * step;
        const float mag = expf(lr);
        const float ar = mag * cosf(li) - 1.f, ai = mag * sinf(li);
        const float den = 1.f / (lre * lre + lim * lim);
        const float qr = (ar * lre + ai * lim) * den, qi = (ai * lre - ar * lim) * den;
        const float br = p.b_re[(size_t)lg * 1024 + e], bi = p.b_im[(size_t)lg * 1024 + e];
        const float2 v = make_float2(qr * br - qi * bi, qr * bi + qi * br);
        s_bb[e] = v; ((float2*)p.bbar)[(size_t)og * 1024 + e] = v;
        s_cc[e] = make_float2(p.c_re[(size_t)lg * 1024 + e], p.c_im[(size_t)lg * 1024 + e]);
    }
    __syncthreads();
    for (int q = 0; q < 32; ++q) {
        const int idx = tid + 512 * q, d = idx >> 8, c = (idx >> 4) & 15, c2 = idx & 15;
        float acc = 0.f;
        for (int pp = 0; pp < 64; ++pp) {
            const float2 C = s_cc[c * 64 + pp], P = s_pw[pp * 65 + d], B = s_bb[pp * 16 + c2];
            const float xr = C.x * P.x - C.y * P.y, xi = C.x * P.y + C.y * P.x;
            acc += xr * B.x - xi * B.y;
        }
        p.klag[(size_t)og * 16384 + idx] = acc;
    }
}
__device__ __forceinline__ void job_s5_expand(const Params& p, int l, int item) {
    const int tid = otid(), g = item >> 6, i = item & 63;
    const float* kf = p.klag + (size_t)((l * 16 + g) * 2 + 0) * 16384;
    const float* kb = p.klag + (size_t)((l * 16 + g) * 2 + 1) * 16384;
    {
        const int c = tid >> 5, kk = tid & 31;
        const float dsk = p.s5_d[l * 256 + g * 16 + c];
#pragma unroll
        for (int q = 0; q < 4; ++q) {
            const int col0 = kk * 8 + 256 * q, j = col0 >> 4, c0 = col0 & 15;
            float v[8];
#pragma unroll
            for (int e = 0; e < 8; ++e) {
                const int c2 = c0 + e;
                float a = 0.f;
                if (j <= i) a += kf[(i - j) * 256 + c * 16 + c2];
                if (j >= i) a += kb[(j - i) * 256 + c * 16 + c2];
                if (j == i && c2 == c) a += dsk;
                v[e] = a;
            }
            u32x4 o = {pk2(v[0], v[1]), pk2(v[2], v[3]), pk2(v[4], v[5]), pk2(v[6], v[7])};
            *(u32x4*)(p.wg + ((size_t)g * 1024 + i * 16 + c) * 1024 + col0) = o;
        }
    }
    {
        const int c = tid >> 5, col0 = (tid & 31) * 8;
        const int dir = col0 >> 7, ri = (col0 >> 6) & 1, p0 = col0 & 63;
        const int lg = (l * 2 + dir) * 16 + g, og = (l * 16 + g) * 2 + dir;
        const int e = dir ? 64 - i : i + 1;
        float v[8];
#pragma unroll
        for (int u = 0; u < 8; ++u) {
            const int pp = p0 + u;
            const float cr = p.c_re[(size_t)lg * 1024 + c * 64 + pp], ci = p.c_im[(size_t)lg * 1024 + c * 64 + pp];
            const float2 P = ((const float2*)p.pw)[(size_t)og * 64 * 65 + pp * 65 + e];
            v[u] = ri ? -(cr * P.y + ci * P.x) : (cr * P.x - ci * P.y);
        }
        u32x4 o = {pk2(v[0], v[1]), pk2(v[2], v[3]), pk2(v[4], v[5]), pk2(v[6], v[7])};
        *(u32x4*)(p.eg + ((size_t)g * 1024 + i * 16 + c) * 256 + col0) = o;
    }
    {
        const int n2 = 4 * i + (tid >> 7), col0 = (tid & 127) * 8;
        const int dir = n2 >> 7, ri = (n2 >> 6) & 1, pp = n2 & 63;
        const int og = (l * 16 + g) * 2 + dir;
        const int j = col0 >> 4, c0 = col0 & 15;
        const int pe = dir ? j : 63 - j;
        const float2 P = ((const float2*)p.pw)[(size_t)og * 64 * 65 + pp * 65 + pe];
        float v[8];
#pragma unroll
        for (int u = 0; u < 8; ++u) {
            const float2 B = ((const float2*)p.bbar)[(size_t)og * 1024 + pp * 16 + c0 + u];
            v[u] = ri ? (P.x * B.y + P.y * B.x) : (P.x * B.x - P.y * B.y);
        }
        u32x4 o = {pk2(v[0], v[1]), pk2(v[2], v[3]), pk2(v[4], v[5]), pk2(v[6], v[7])};
        *(u32x4*)(p.gg + ((size_t)g * 256 + n2) * 1024 + col0) = o;
    }
}

template <class SrcCol, class DstRow>
__device__ __forceinline__ void cvt_tile(const float* src, int ld_src, bf16* dst, int ld_dst, int k0, int n0, int nvalid, SrcCol sc, DstRow dr, const float* kscale, char* smem, bf16* dst_lo = nullptr) {
    float* sm = (float*)smem;
    const int tid = otid();
    {
        const int n = tid & 63, kk = tid >> 6;
        const bool ok = (n0 + n) < nvalid;
        const int col = ok ? sc(n0 + n) : 0;
#pragma unroll
        for (int i = 0; i < 8; ++i) {
            const int k = kk + 8 * i;
            float v = ok ? src[(size_t)(k0 + k) * ld_src + col] : 0.f;
            if (kscale) v *= kscale[k0 + k];
            sm[k * 65 + n] = v;
        }
    }
    __syncthreads();
    {
        const int k = tid & 63, nn = tid >> 6;
#pragma unroll
        for (int i = 0; i < 8; ++i) {
            const int n = nn + 8 * i;
            const float v = sm[k * 65 + n];
            const bf16 hi = f2bf(v);
            dst[(size_t)dr(n0 + n) * ld_dst + k0 + k] = hi;
            if (dst_lo) dst_lo[(size_t)dr(n0 + n) * ld_dst + k0 + k] = f2bf(v - bf2f(hi));
        }
    }
    __syncthreads();
}
struct IdMap { __device__ __forceinline__ int operator()(int n) const { return n; } };
struct InColMap {
    __device__ __forceinline__ int operator()(int n) const {
        if (n < 640 || n >= 672) return n;
        const int r = n - 640, ax = r >> 4, q = r & 15, i = q >> 1, t = q & 1;
        return 640 + ax * 16 + t * 8 + i;
    }
};
struct QColMap {
    __device__ __forceinline__ int operator()(int n) const {
        const int hd = n / 96, d = n - hd * 96;
        if (d < 64) return n;
        const int r = d - 64, ax = r >> 4, q = r & 15, i = q >> 1, t = q & 1;
        return hd * 96 + 64 + ax * 16 + t * 8 + i;
    }
};
struct UpRowMap {
    int t; __device__ __forceinline__ int operator()(int j) const { return (j >> 4) * 32 + t * 16 + (j & 15); }
};
struct DnRowMap {
    __device__ __forceinline__ int operator()(int n) const { return ((n & 255) >> 2) * 16 + (n >> 8) * 4 + (n & 3); }
};
template <class SrcCol, class DstRow>
__device__ __forceinline__ void cvt_tile256(const float* src, int ld_src, bf16* dst, int ld_dst, int k0, int n0, int nvalid, SrcCol sc, DstRow dr, const float* kscale, char* smem) {
    float* sm = (float*)smem;
    const int tid = otid();
    {
        const int n4 = (tid & 63) * 4, kk = tid >> 6;
        const int n = n0 + n4;
        const bool ok = n < nvalid;
        const bool vec = ok && sc(n) == n && sc(n + 3) == n + 3;
#pragma unroll
        for (int i = 0; i < 8; ++i) {
            const int k = kk + 8 * i;
            f32x4 v = {0.f, 0.f, 0.f, 0.f};
            const float* row = src + (size_t)(k0 + k) * ld_src;
            if (vec) v = __builtin_nontemporal_load((const f32x4*)(row + n));
            else if (ok) { v[0] = row[sc(n)]; v[1] = row[sc(n + 1)]; v[2] = row[sc(n + 2)]; v[3] = row[sc(n + 3)]; }
            if (kscale) { const float ks = kscale[k0 + k]; v[0] *= ks; v[1] *= ks; v[2] *= ks; v[3] *= ks; }
            float* d = sm + k * 257 + n4;
            d[0] = v[0]; d[1] = v[1]; d[2] = v[2]; d[3] = v[3];
        }
    }
    __syncthreads();
    {
        const int kch = tid & 7, nn = tid >> 3;
#pragma unroll
        for (int i = 0; i < 4; ++i) {
            const int n = nn + 64 * i;
            const float* c = sm + (kch * 8) * 257 + n;
            u32x4 o = {pk2(c[0], c[257]), pk2(c[2 * 257], c[3 * 257]), pk2(c[4 * 257], c[5 * 257]), pk2(c[6 * 257], c[7 * 257])};
            *(u32x4*)(dst + (size_t)dr(n0 + n) * ld_dst + k0 + kch * 8) = o;
        }
    }
    __syncthreads();
}
#define CVT_N_IN   (16 * 7)
#define CVT_N_Q    (4 * 3)
#define CVT_N_KV   (2 * 4)
#define CVT_N_GLU  (4 * 1)
#define CVT_N_OUT  (16 * 4)
#define CVT_N_R    (16 * 2)
#define CVT_N_UP   (130 * 16)
#define CVT_N_DN   (65 * 4 * 4)
#define CVT_TOTAL  (CVT_N_IN + CVT_N_Q + CVT_N_KV + CVT_N_GLU + CVT_N_OUT + CVT_N_R + CVT_N_UP + CVT_N_DN)
#define CVT_EXPERT (CVT_N_UP + CVT_N_DN)
#define CVT_SMALL (CVT_TOTAL - CVT_EXPERT)
__device__ __forceinline__ void job_cvt_expert(const Params& p, int l, int item, char* smem) {
    int it = item;
    if (it < CVT_N_UP) {
        const int et = it / 16, kt = it % 16, e = et >> 1, t = et & 1;
        const float* src = e < 64 ? (t ? p.ew_up : p.ew_gate) + ((size_t)l * 64 + e) * 1024 * 256 : (t ? p.sw_up : p.sw_gate) + (size_t)l * 1024 * 256;
        UpRowMap rm; rm.t = t;
        cvt_tile256(src, 256, p.bt_up + (size_t)e * 512 * 1024, 1024, kt * 64, 0, 256, IdMap(), rm, nullptr, smem); return;
    }
    it -= CVT_N_UP;
    {
        const int e = it / 16, r = it % 16, kt = r / 4, nt = r % 4;
        const float* src = e < 64 ? p.ew_down + ((size_t)l * 64 + e) * 256 * 1024 : p.sw_down + (size_t)l * 256 * 1024;
        cvt_tile256(src, 1024, p.bt_dn + (size_t)e * 1024 * 256, 256, kt * 64, nt * 256, 1024, IdMap(), DnRowMap(), nullptr, smem);
    }
}
__device__ __forceinline__ void job_cvt_small(const Params& p, int l, int item, char* smem) {
    int it = item;
    if (it < CVT_N_IN) { const int kt = it / 7, nt = it % 7; cvt_tile256(p.w_in + (size_t)l * 1024 * NIN, NIN, p.bt_in, 1024, kt * 64, nt * 256, NIN, InColMap(), IdMap(), nullptr, smem); return; }
    it -= CVT_N_IN;
    if (it < CVT_N_Q) { const int kt = it / 3, nt = it % 3; cvt_tile256(p.w_q_up + (size_t)l * 256 * 768, 768, p.bt_q, 256, kt * 64, nt * 256, 768, QColMap(), IdMap(), p.q_norm + l * 256, smem); return; }
    it -= CVT_N_Q;
    if (it < CVT_N_KV) { const int kt = it / 4, nt = it % 4; cvt_tile256(p.w_kv_up + (size_t)l * 128 * 1024, 1024, p.bt_kv, 128, kt * 64, nt * 256, 1024, IdMap(), IdMap(), p.kv_norm + l * 128, smem); return; }
    it -= CVT_N_KV;
    if (it < CVT_N_GLU) { const int kt = it; cvt_tile256(p.glu_w + (size_t)l * 256 * 256, 256, p.bt_glu, 256, kt * 64, 0, 256, IdMap(), IdMap(), nullptr, smem); return; }
    it -= CVT_N_GLU;
    if (it < CVT_N_OUT) { const int kt = it / 4, nt = it % 4; cvt_tile256(p.w_out + (size_t)l * 1024 * 1024, 1024, p.bt_out, 1024, kt * 64, nt * 256, 1024, IdMap(), IdMap(), nullptr, smem); return; }
    it -= CVT_N_OUT;
    { const int kt = it / 2, nt = it % 2; if (nt == 0) cvt_tile(p.router_w + (size_t)l * 1024 * 64, 64, p.bt_rhi, 1024, kt * 64, 0, 64, IdMap(), IdMap(), nullptr, smem, p.bt_rlo); }
}

__device__ __forceinline__ void phase_post_inproj(const Params& p, int l, int item) {
    const int tid = otid(), lane = tid & 63, wave = tid >> 6;
    int t0, t1; wave_token_range(wave, t0, t1); (void)item;
    for (int tb = t0; tb < t1; tb += 4) {
        u32x2 qv4[4]; unsigned kv4[4], kr4[4];
#pragma unroll
        for (int i = 0; i < 4; ++i) {
            const int tok = (tb + i < t1) ? tb + i : t1 - 1;
            const bf16* zr = p.z + (size_t)tok * ZW;
            qv4[i] = __builtin_nontemporal_load((const u32x2*)(zr + Z_QC + 4 * lane));
            kv4[i] = __builtin_nontemporal_load((const unsigned*)(zr + Z_KVC + 2 * lane));
            kr4[i] = *(const unsigned*)(zr + Z_KR + 2 * (lane & 15));
        }
#pragma unroll
        for (int i = 0; i < 4; ++i) {
            const int tok = tb + i;
            if (tok < t1) {
                const int b = tok / SQ, s = tok - b * SQ;
                const u32x2 qv = qv4[i];
                float ss = bflo(qv[0]) * bflo(qv[0]) + bfhi(qv[0]) * bfhi(qv[0]) + bflo(qv[1]) * bflo(qv[1]) + bfhi(qv[1]) * bfhi(qv[1]);
                ss = wave_sum(ss);
                const unsigned kv = kv4[i];
                float s2 = bflo(kv) * bflo(kv) + bfhi(kv) * bfhi(kv);
                s2 = wave_sum(s2);
                if (lane == 0) { p.rq[tok] = rsqrtf(ss * (1.f / 256.f) + 1e-6f); p.rkv[tok] = rsqrtf(s2 * (1.f / 128.f) + 1e-6f); }
                if (lane < 16) {
                    const unsigned kr = kr4[i];
                    float v0 = bflo(kr), v1 = bfhi(kr);
                    if (s >= CTXL) {
                        const int ax = lane >> 3, ii = lane & 7, sl = s - CTXL, pos = ax ? (sl & 63) : (sl >> 6);
                        const float cs = p.rope_tab[(pos * 8 + ii) * 2], sn = p.rope_tab[(pos * 8 + ii) * 2 + 1];
                        const float a0 = v0 * cs - v1 * sn, a1 = v0 * sn + v1 * cs; v0 = a0; v1 = a1;
                    }
                    const unsigned o = pk2(v0, v1);
#pragma unroll
                    for (int hd = 0; hd < 8; ++hd) *(unsigned*)(p.kf + ((size_t)(b * 8 + hd) * SQ + s) * 96 + 64 + 2 * lane) = o;
                }
            }
        }
    }
    const float* cw = p.conv_w + (size_t)l * 3 * 512; const float* cb = p.conv_b + l * 512;
    const int bt0 = (int)(((long)NTOK * blockIdx.x) / gridDim.x), bt1 = (int)(((long)NTOK * (blockIdx.x + 1)) / gridDim.x);
    const int nq = (bt1 - bt0) * 64;
    for (int q0 = tid; q0 < nq; q0 += 1024) {
        u32x4 cur2[2], prv2[2], nxt2[2];
#pragma unroll
        for (int i = 0; i < 2; ++i) {
            const int q = (q0 + 512 * i < nq) ? q0 + 512 * i : q0;
            const int tok = bt0 + (q >> 6), ch0 = (q & 63) * 8;
            const int b = tok / SQ, s = tok - b * SQ;
            const bool hasp = (s != 0) && (s != CTXL), hasn = (s != CTXL - 1) && (s != SQ - 1);
            const bf16* zr = p.z + (size_t)tok * ZW + Z_MLQ + ch0;
            const u32x4 zz = {0u, 0u, 0u, 0u};
            cur2[i] = *(const u32x4*)zr; prv2[i] = zz; nxt2[i] = zz;
            if (hasp) prv2[i] = *(const u32x4*)(zr - ZW);
            if (hasn) nxt2[i] = *(const u32x4*)(zr + ZW);
        }
#pragma unroll
        for (int i = 0; i < 2; ++i) {
            const int q = q0 + 512 * i;
            if (q < nq) {
                const int tok = bt0 + (q >> 6), ch0 = (q & 63) * 8;
                const u32x4 cur = cur2[i], prv = prv2[i], nxt = nxt2[i];
                const float ksc = ch0 >= 256 ? 0.125f : 1.f;
                float o[8];
#pragma unroll
                for (int e = 0; e < 8; ++e) {
                    const unsigned pc = prv[e >> 1], cc = cur[e >> 1], nc = nxt[e >> 1];
                    const float xp = (e & 1) ? bfhi(pc) : bflo(pc), xc = (e & 1) ? bfhi(cc) : bflo(cc), xn = (e & 1) ? bfhi(nc) : bflo(nc);
                    const int ch = ch0 + e;
                    const float a = cb[ch] + cw[ch] * xp + cw[512 + ch] * xc + cw[1024 + ch] * xn;
                    o[e] = siluf_(a) * ksc;
                }
                u32x4 ov = {pk2(o[0], o[1]), pk2(o[2], o[3]), pk2(o[4], o[5]), pk2(o[6], o[7])};
                *(u32x4*)(p.qkc + (size_t)tok * 512 + ch0) = ov;
            }
        }
    }
}

__device__ __forceinline__ int chain_chunk(int dir, int step) { return dir == 0 ? step : (step < 4 ? 3 - step : NCH + 3 - step); }

__device__ __forceinline__ void job_s5_carry(const Params& p, int l, int item) {
    const int id = item * 512 + otid();
    const int pp = id & 63, dir = (id >> 6) & 1, g = (id >> 7) & 15, b = id >> 11;
    const float2 a64 = ((const float2*)p.pw)[(size_t)((l * 16 + g) * 2 + dir) * 64 * 65 + pp * 65 + 64];
    float sr = 0.f, si = 0.f;
    const size_t base = (size_t)g * NROWP * 256 + dir * 128 + pp;
    for (int s0 = 0; s0 < NCH; s0 += 12) {
        float fr[12], fi[12];
#pragma unroll
        for (int u = 0; u < 12; ++u) { const size_t o = base + (size_t)(b * NCH + chain_chunk(dir, s0 + u)) * 256; fr[u] = p.ff[o]; fi[u] = p.ff[o + 64]; }
#pragma unroll
        for (int u = 0; u < 12; ++u) {
            const size_t o = base + (size_t)(b * NCH + chain_chunk(dir, s0 + u)) * 256;
            p.sin_[o] = f2bf(sr); p.sin_[o + 64] = f2bf(si);
            const float nr = a64.x * sr - a64.y * si + fr[u], ni = a64.x * si + a64.y * sr + fi[u];
            sr = nr; si = ni;
        }
    }
}
__device__ __forceinline__ void job_ml_carry(const Params& p, int item) {
    const int chain = item / 5, part = item % 5, tid = otid();
    const int dir = chain & 1;
    if (tid >= 416) return;
    const size_t eoff = (size_t)part * 832 + tid * 2;
    float c0 = 0.f, c1 = 0.f, m = 0.f;
    for (int s0 = 0; s0 < NCH; s0 += 12) {
        unsigned lv[12]; float ml[12], bl[12];
#pragma unroll
        for (int u = 0; u < 12; ++u) {
            const size_t un = (size_t)chain * NCH + chain_chunk(dir, s0 + u);
            lv[u] = *(const unsigned*)(p.cloc + un * CLOC_STRIDE + eoff); ml[u] = p.mlstat[un * 4]; bl[u] = p.mlstat[un * 4 + 1];
        }
#pragma unroll
        for (int u = 0; u < 12; ++u) {
            const size_t un = (size_t)chain * NCH + chain_chunk(dir, s0 + u);
            *(unsigned*)(p.cloc + un * CLOC_STRIDE + eoff) = pk2(c0, c1);
            if (part == 0 && tid == 0) p.mlstat[un * 4 + 2] = m;
            const float mn = fmaxf(bl[u] + m, ml[u]);
            const float a = fexp(bl[u] + m - mn), sc = fexp(ml[u] - mn);
            c0 = a * c0 + sc * bflo(lv[u]); c1 = a * c1 + sc * bfhi(lv[u]); m = mn;
        }
    }
}

__device__ __forceinline__ int scan_sum_i(int v, int lane) {
    (void)lane;
    v += dppi<0x111, 0xf>(0, v); v += dppi<0x112, 0xf>(0, v); v += dppi<0x114, 0xf>(0, v); v += dppi<0x118, 0xf>(0, v);
    v += dppi<0x142, 0xa>(0, v); v += dppi<0x143, 0xc>(0, v);
    return v;
}
__device__ __forceinline__ void phase_route(const Params& p, int l, int item, char* smem) {
    const int lane = otid() & 63, wave = otid() >> 6;
    const float bias = p.router_bias[l * 64 + lane];
    const float NEG = -__builtin_inff();
    int t0, t1; wave_token_range(wave, t0, t1); (void)item;
    int* wl = (int*)(smem + wave * 2048);
    int cnt = 0, seg0 = t0, curb = (t0 < t1) ? t0 / SQ : 0;
    auto flush = [&](int ta, int tb_, int bb) {
        const int base = cnt ? atomicAdd(&p.moe_cnt[(l * 8 + bb) * 64 + lane], cnt) : 0;
        for (int tok = ta; tok < tb_; ++tok) {
            if (l == 1 && tok - bb * SQ < CTXL) continue;
            const int v = (lane < 8) ? wl[(tok - t0) * 8 + lane] : 0;
            const int bs = __shfl(base, v & 63, 64);
            if (lane < 8) p.pos[tok * 8 + lane] = (v >> 6) + bs;
        }
        cnt = 0;
    };
    float lg4[4];
#pragma unroll
    for (int i = 0; i < 4; ++i) lg4[i] = (t0 + i < t1) ? __builtin_nontemporal_load(p.logits + (size_t)(t0 + i) * 64 + lane) : 0.f;
    for (int tb = t0; tb < t1; tb += 4)
#pragma unroll
    for (int ti = 0; ti < 4; ++ti) {
        const int tok = tb + ti;
        if (tok >= t1) break;
        const float lg = lg4[ti];
        if (tok + 4 < t1) lg4[ti] = __builtin_nontemporal_load(p.logits + (size_t)(tok + 4) * 64 + lane);
        const int b = tok / SQ;
        if (b != curb) { flush(seg0, tok, curb); seg0 = tok; curb = b; }
        if (l == 1 && tok - b * SQ < CTXL) continue;
        const float sc = 1.f / (1.f + expf(-lg));
        const float bs = sc + bias;
        float m1 = bs;
        m1 = fmaxf(m1, dppf<0xB1, 0xf>(m1, m1)); m1 = fmaxf(m1, dppf<0x4E, 0xf>(m1, m1)); m1 = fmaxf(m1, dppf<0x141, 0xf>(m1, m1));
        const unsigned long long gm = 0xFFull << (lane & ~7);
        const unsigned long long bal = __ballot(bs == m1) & gm;
        const int first = __ffsll((long long)bal) - 1;
        float m2 = (lane == first) ? NEG : bs;
        m2 = fmaxf(m2, dppf<0xB1, 0xf>(m2, m2)); m2 = fmaxf(m2, dppf<0x4E, 0xf>(m2, m2)); m2 = fmaxf(m2, dppf<0x141, 0xf>(m2, m2));
        const float gsc = m1 + m2;
        const int G = lane >> 3;
        int rank = 0;
#pragma unroll
        for (int g2 = 0; g2 < 8; ++g2) { const float o = readlane_f(gsc, g2 * 8); rank += (o > gsc || (o == gsc && g2 < G)) ? 1 : 0; }
        const float masked = (rank < 4) ? bs : NEG;
        int rk = 0;
#pragma unroll
        for (int j = 0; j < 64; ++j) { const float o = readlane_f(masked, j); rk += (o > masked || (o == masked && j < lane)) ? 1 : 0; }
        const bool sel = rk < 8;
        const float tot = wave_sum(sel ? sc : 0.f);
        if (sel) {
            wl[(tok - t0) * 8 + rk] = lane | (cnt << 6);
            p.tope[tok * 8 + rk] = lane; p.gatew[tok * 8 + rk] = sc / tot * 2.5f;
            ++cnt;
        }
    }
    if (seg0 < t1) flush(seg0, t1, curb);
}
__device__ __forceinline__ void job_tiles(const Params& p, int l, int b, int* s_int) {
    const int tid = otid();
    const int* cnt = p.moe_cnt + (l * 8 + b) * 64;
    if (tid < 64) {
        int* ue = p.up_e + b * UPU_STRIDE; int* ur = p.up_row + b * UPU_STRIDE;
        const int n256 = (cnt[tid] + 255) >> 8;
        const int incl = scan_sum_i(n256, tid), k0 = incl - n256, t = 2 * k0;
        s_int[tid] = t;
        for (int u = 0; u < n256; ++u) { ue[k0 + u] = tid; ur[k0 + u] = (t + 2 * u) * MOE_BM; }
        const int ktot = __builtin_amdgcn_readlane(incl, 63), ttot = 2 * ktot;
        if (tid == 63) { s_int[64] = ttot; p.up_n[b] = ktot + SQ / 256; p.ntb[b * 2] = ttot + SQ / MOE_BM; p.ntb[b * 2 + 1] = ttot * MOE_BM; }
        if (tid < SQ / 256) { ue[ktot + tid] = 64; ur[ktot + tid] = (ttot + 2 * tid) * MOE_BM; }
    }
    __syncthreads();
    if (tid < 64) { for (int t = s_int[tid]; t < s_int[tid + 1]; ++t) p.tile_e[b * MOE_TILES + t] = ((t - s_int[tid]) * MOE_BM < cnt[tid]) ? tid : -1; }
    const int t0 = s_int[64];
    if (tid < SQ / MOE_BM) p.tile_e[b * MOE_TILES + t0 + tid] = 64;
    if (tid < 8) {
        int* lst = p.xl_tile + (size_t)(b * 8 + tid) * XL_STRIDE; int k = 0;
        for (int e = tid; e < 64; e += 8) for (int t = s_int[e]; t < s_int[e + 1]; ++t) if ((t - s_int[e]) * MOE_BM < cnt[e]) lst[k++] = t;
        for (int j = tid; j < SQ / MOE_BM; j += 8) lst[k++] = t0 + j;
        p.xl_cnt[b * 8 + tid] = k;
    }
    __syncthreads();
}
__device__ __forceinline__ void job_slots(const Params& p, int l, int item, int* s_int) {
    (void)item;
    const int tid = otid();
    const int G = gridDim.x, t0 = (int)(((long)NTOK * blockIdx.x) / G), t1 = (int)(((long)NTOK * (blockIdx.x + 1)) / G);
    int cb = -1, base = t0;
    while (base < t1) {
        const int b = base / SQ;
        const int lim = t1 < (b + 1) * SQ ? t1 : (b + 1) * SQ;
        const int cnt = (lim - base) < 64 ? (lim - base) : 64;
        if (b != cb) {
            __syncthreads();
            if (tid < 64) {
                const int n = 2 * ((p.moe_cnt[(l * 8 + b) * 64 + tid] + 255) >> 8);
                const int incl = scan_sum_i(n, tid);
                s_int[tid] = (incl - n) * MOE_BM;
                if (tid == 63) s_int[64] = incl * MOE_BM;
            }
            __syncthreads();
            cb = b;
        }
        const int tok = base + (tid >> 3), k = tid & 7;
        if ((tid >> 3) < cnt && !(l == 1 && tok - b * SQ < CTXL)) {
            const int e = p.tope[tok * 8 + k];
            const int slot = s_int[e] + p.pos[tok * 8 + k];
            p.slottok[(size_t)b * MOE_SLOTS + slot] = tok;
            p.slotgate[(size_t)b * MOE_SLOTS + slot] = p.gatew[tok * 8 + k];
            p.tokslot[tok * 8 + k] = slot;
            if (k == 0) {
                const int s = tok - b * SQ, sl2 = s_int[64] + s;
                p.slottok[(size_t)b * MOE_SLOTS + sl2] = tok;
                p.slotgate[(size_t)b * MOE_SLOTS + sl2] = 1.f;
            }
        }
        base += cnt;
    }
    __syncthreads();
}

#define AT_KROW 208
#define AT_VROW 136
#define AT_BUF (64 * AT_KROW + 64 * AT_VROW)
template <int VAR>
__device__ __forceinline__ void attn_item(const Params& p, int bh, int qt, char* smem) {
    const int tid = otid(), lane = tid & 63, wave = tid >> 6, r = lane & 31, h = lane >> 5;
    const int nkt = (qt == 0) ? (CTXL / 64) : (SQ / 64);
    const int s = qt * 256 + wave * 32 + r;
    const bf16* qrow = p.q + ((size_t)(bh >> 3) * SQ + s) * 768 + (bh & 7) * 96;
    bf16x8 qf[6];
#pragma unroll
    for (int ks = 0; ks < 6; ++ks) qf[ks] = *(const bf16x8*)(qrow + ks * 16 + h * 8);
    const bf16* kbase = p.kf + (size_t)bh * SQ * 96;
    const bf16* vbase = p.vt + (size_t)bh * 64 * SQ;
    const int kkey0 = tid / 12, kpart0 = tid % 12, kkey1 = (tid + 512) / 12, kpart1 = (tid + 512) % 12;
    const int vd = tid >> 3, vpart = tid & 7;
    u32x4 rk0, rk1 = {0u, 0u, 0u, 0u}, rv;
    auto gload = [&](int t) {
        const bf16* kb = kbase + (size_t)t * 64 * 96;
        rk0 = *(const u32x4*)(kb + tid * 8);
        if (tid < 256) rk1 = *(const u32x4*)(kb + (tid + 512) * 8);
        rv = *(const u32x4*)(vbase + (size_t)vd * SQ + t * 64 + vpart * 8);
    };
    auto lstore = [&](int buf) {
        char* base = smem + buf * AT_BUF;
        *(u32x4*)(base + kkey0 * AT_KROW + kpart0 * 16) = rk0;
        if (tid < 256) *(u32x4*)(base + kkey1 * AT_KROW + kpart1 * 16) = rk1;
        char* vb = base + 64 * AT_KROW + vd * AT_VROW + vpart * 16;
        u32x2 a = {rv[0], rv[1]}, b2 = {rv[2], rv[3]};
        *(u32x2*)vb = a; *(u32x2*)(vb + 8) = b2;
    };
    f32x16 o[2];
#pragma unroll
    for (int d = 0; d < 2; ++d)
#pragma unroll
        for (int q = 0; q < 16; ++q) o[d][q] = 0.f;
    float m = -1e30f;
    f32x16 lacc;
#pragma unroll
    for (int q = 0; q < 16; ++q) lacc[q] = 0.f;
    const u32x4 ones4 = {0x3F803F80u, 0x3F803F80u, 0x3F803F80u, 0x3F803F80u};
    const bf16x8 onesf = (bf16x8)ones4;
    gload(0);
    __syncthreads();
    lstore(0);
    __syncthreads();
    for (int t = 0; t < nkt; ++t) {
        if (t + 1 < nkt) gload(t + 1);
        const char* base = smem + (t & 1) * AT_BUF;
        f32x16 sacc[2];
        bf16x8 kfr[2][6];
#pragma unroll
        for (int kb = 0; kb < 2; ++kb)
#pragma unroll
            for (int ks = 0; ks < 6; ++ks) kfr[kb][ks] = *(const bf16x8*)(base + (kb * 32 + r) * AT_KROW + ks * 32 + h * 16);
        asm volatile("" ::: "memory");
#pragma unroll
        for (int kb = 0; kb < 2; ++kb)
#pragma unroll
            for (int q = 0; q < 16; ++q) sacc[kb][q] = 0.f;
#pragma unroll
        for (int ks = 0; ks < 6; ++ks) {
            sacc[0] = MFMA32(kfr[0][ks], qf[ks], sacc[0]);
            sacc[1] = MFMA32(kfr[1][ks], qf[ks], sacc[1]);
        }
        const char* vb = base + 64 * AT_KROW;
        bf16x8 vfr[2][2][2];
#pragma unroll
        for (int kb = 0; kb < 2; ++kb)
#pragma unroll
            for (int s2 = 0; s2 < 2; ++s2)
#pragma unroll
                for (int d = 0; d < 2; ++d) {
                    const char* a = vb + (d * 32 + r) * AT_VROW + (kb * 32 + 16 * s2 + 4 * h) * 2;
                    const u32x2 lo = *(const u32x2*)a, hi = *(const u32x2*)(a + 16);
                    u32x4 t4 = {lo[0], lo[1], hi[0], hi[1]};
                    vfr[d][kb][s2] = (bf16x8)t4;
                }
        asm volatile("" ::: "memory");
        float mx = fmaxf(sacc[0][0], sacc[1][0]);
        if (VAR != 1) {
#pragma unroll
        for (int q = 1; q < 16; ++q) mx = fmaxf(fmaxf(mx, sacc[0][q]), sacc[1][q]);
        {
            typedef unsigned u2_t __attribute__((ext_vector_type(2)));
            const u2_t sw = __builtin_amdgcn_permlane32_swap(__float_as_uint(mx), __float_as_uint(mx), false, false);
            mx = fmaxf(__uint_as_float(sw[0]), __uint_as_float(sw[1]));
        }
        }
        if (VAR != 1 && __any(mx > m + 8.f)) {
            const float mn = fmaxf(m, mx), alpha = fexp2(m - mn);
            m = mn; lacc[0] *= alpha;
#pragma unroll
            for (int d = 0; d < 2; ++d)
#pragma unroll
                for (int q = 0; q < 16; ++q) o[d][q] *= alpha;
        }
        bf16x8 pf[2][2];
#pragma unroll
        for (int kb = 0; kb < 2; ++kb) {
#pragma unroll
            for (int q = 0; q < 16; ++q) if (VAR != 1) sacc[kb][q] = fexp2(sacc[kb][q] - m);
#pragma unroll
            for (int s2 = 0; s2 < 2; ++s2) {
                u32x4 t4 = {pk2(sacc[kb][8 * s2], sacc[kb][8 * s2 + 1]), pk2(sacc[kb][8 * s2 + 2], sacc[kb][8 * s2 + 3]),
                            pk2(sacc[kb][8 * s2 + 4], sacc[kb][8 * s2 + 5]), pk2(sacc[kb][8 * s2 + 6], sacc[kb][8 * s2 + 7])};
                pf[kb][s2] = (bf16x8)t4;
            }
        }
#pragma unroll
        for (int kb = 0; kb < 2; ++kb)
#pragma unroll
            for (int s2 = 0; s2 < 2; ++s2) {
                lacc = MFMA32(onesf, pf[kb][s2], lacc);
                o[0] = MFMA32(vfr[0][kb][s2], pf[kb][s2], o[0]);
                o[1] = MFMA32(vfr[1][kb][s2], pf[kb][s2], o[1]);
            }
        if (t + 1 < nkt) lstore((t + 1) & 1);
        __syncthreads();
    }
    const float inv = 1.f / lacc[0];
    const int b = bh >> 3, hd = bh & 7;
    bf16* orow = (VAR == 0 ? p.cat : p.yc) + ((size_t)b * SQ + s) * 1024 + 256 + hd * 64;
#pragma unroll
    for (int d = 0; d < 2; ++d)
#pragma unroll
        for (int g = 0; g < 4; ++g) st_bf4(orow + d * 32 + 8 * g + 4 * h, o[d][4 * g] * inv, o[d][4 * g + 1] * inv, o[d][4 * g + 2] * inv, o[d][4 * g + 3] * inv);
}

__device__ __forceinline__ void attn_item64(const Params& p, int bh, int qt, char* smem) {
    const int tid = otid(), lane = tid & 63, wave = tid >> 6, r = lane & 31, h = lane >> 5;
    const int nkt = SQ / 64;
    const int s0 = CTXL + qt * 512 + wave * 64 + r;
    bf16x8 qf[2][6];
#pragma unroll
    for (int qb = 0; qb < 2; ++qb) {
        const bf16* qrow = p.q + ((size_t)(bh >> 3) * SQ + s0 + qb * 32) * 768 + (bh & 7) * 96;
#pragma unroll
        for (int ks = 0; ks < 6; ++ks) qf[qb][ks] = *(const bf16x8*)(qrow + ks * 16 + h * 8);
    }
    const bf16* kbase = p.kf + (size_t)bh * SQ * 96;
    const bf16* vbase = p.vt + (size_t)bh * 64 * SQ;
    const int ko1 = 8192 + tid * 8;
    u32x4 rk0, rv; u32x2 rk1;
    auto gload = [&](int t) {
        const char* kb = (const char*)(kbase + (size_t)t * 64 * 96);
        rk0 = *(const u32x4*)(kb + tid * 16);
        rk1 = *(const u32x2*)(kb + ko1);
        rv = *(const u32x4*)(vbase + (size_t)(tid >> 3) * SQ + t * 64 + (tid & 7) * 8);
    };
    auto lstore = [&](int buf) {
        char* base = smem + buf * AT_BUF;
        *(u32x4*)(base + (tid / 12) * AT_KROW + (tid % 12) * 16) = rk0;
        *(u32x2*)(base + (ko1 / 192) * AT_KROW + (ko1 % 192)) = rk1;
        char* vb = base + 64 * AT_KROW + (tid >> 3) * AT_VROW + (tid & 7) * 16;
        u32x2 a = {rv[0], rv[1]}, b2 = {rv[2], rv[3]};
        *(u32x2*)vb = a; *(u32x2*)(vb + 8) = b2;
    };
    f32x16 o[2][2];
#pragma unroll
    for (int qb = 0; qb < 2; ++qb)
#pragma unroll
        for (int d = 0; d < 2; ++d)
#pragma unroll
            for (int q = 0; q < 16; ++q) o[qb][d][q] = 0.f;
    float m[2] = {-1e30f, -1e30f}, lsum[2] = {0.f, 0.f};
    gload(0);
    __syncthreads();
    lstore(0);
    __syncthreads();
    for (int t = 0; t < nkt; ++t) {
        if (t + 1 < nkt) gload(t + 1);
        const char* base = smem + (t & 1) * AT_BUF;
        f32x16 sacc[2][2];
#pragma unroll
        for (int kb = 0; kb < 2; ++kb) {
            bf16x8 kfr[6];
#pragma unroll
            for (int ks = 0; ks < 6; ++ks) kfr[ks] = *(const bf16x8*)(base + (kb * 32 + r) * AT_KROW + ks * 32 + h * 16);
#pragma unroll
            for (int qb = 0; qb < 2; ++qb)
#pragma unroll
                for (int q = 0; q < 16; ++q) sacc[qb][kb][q] = 0.f;
#pragma unroll
            for (int ks = 0; ks < 6; ++ks) {
                sacc[0][kb] = MFMA32(kfr[ks], qf[0][ks], sacc[0][kb]);
                sacc[1][kb] = MFMA32(kfr[ks], qf[1][ks], sacc[1][kb]);
            }
        }
        bf16x8 pf[2][2][2];
#pragma unroll
        for (int qb = 0; qb < 2; ++qb) {
            float mx = fmaxf(sacc[qb][0][0], sacc[qb][1][0]);
#pragma unroll
            for (int q = 1; q < 16; ++q) mx = fmaxf(fmaxf(mx, sacc[qb][0][q]), sacc[qb][1][q]);
            {
                typedef unsigned u2_t __attribute__((ext_vector_type(2)));
                const u2_t sw = __builtin_amdgcn_permlane32_swap(__float_as_uint(mx), __float_as_uint(mx), false, false);
                mx = fmaxf(__uint_as_float(sw[0]), __uint_as_float(sw[1]));
            }
            if (__any(mx > m[qb] + 8.f)) {
                const float mn = fmaxf(m[qb], mx), alpha = fexp2(m[qb] - mn);
                m[qb] = mn; lsum[qb] *= alpha;
#pragma unroll
                for (int d = 0; d < 2; ++d)
#pragma unroll
                    for (int q = 0; q < 16; ++q) o[qb][d][q] *= alpha;
            }
#pragma unroll
            for (int kb = 0; kb < 2; ++kb) {
#pragma unroll
                for (int q = 0; q < 16; ++q) { const float e = fexp2(sacc[qb][kb][q] - m[qb]); sacc[qb][kb][q] = e; lsum[qb] += e; }
#pragma unroll
                for (int s2 = 0; s2 < 2; ++s2) {
                    u32x4 t4 = {pk2(sacc[qb][kb][8 * s2], sacc[qb][kb][8 * s2 + 1]), pk2(sacc[qb][kb][8 * s2 + 2], sacc[qb][kb][8 * s2 + 3]),
                                pk2(sacc[qb][kb][8 * s2 + 4], sacc[qb][kb][8 * s2 + 5]), pk2(sacc[qb][kb][8 * s2 + 6], sacc[qb][kb][8 * s2 + 7])};
                    pf[qb][kb][s2] = (bf16x8)t4;
                }
            }
        }
        const char* vb = base + 64 * AT_KROW;
#pragma unroll
        for (int kb = 0; kb < 2; ++kb)
#pragma unroll
            for (int s2 = 0; s2 < 2; ++s2)
#pragma unroll
                for (int d = 0; d < 2; ++d) {
                    const char* a = vb + (d * 32 + r) * AT_VROW + (kb * 32 + 16 * s2 + 4 * h) * 2;
                    const u32x2 lo = *(const u32x2*)a, hi = *(const u32x2*)(a + 16);
                    u32x4 t4 = {lo[0], lo[1], hi[0], hi[1]};
                    const bf16x8 vf = (bf16x8)t4;
                    o[0][d] = MFMA32(vf, pf[0][kb][s2], o[0][d]);
                    o[1][d] = MFMA32(vf, pf[1][kb][s2], o[1][d]);
                }
        if (t + 1 < nkt) lstore((t + 1) & 1);
        __syncthreads();
    }
    const int b = bh >> 3, hd = bh & 7;
    char* st = smem + 2 * AT_BUF + wave * (64 * 144);
#pragma unroll
    for (int qb = 0; qb < 2; ++qb) {
        float l = lsum[qb]; l += __shfl_xor(l, 32, 64);
        const float inv = 1.f / l;
#pragma unroll
        for (int d = 0; d < 2; ++d)
#pragma unroll
            for (int g = 0; g < 4; ++g) {
                u32x2 v; v[0] = pk2(o[qb][d][4 * g] * inv, o[qb][d][4 * g + 1] * inv); v[1] = pk2(o[qb][d][4 * g + 2] * inv, o[qb][d][4 * g + 3] * inv);
                *(u32x2*)(st + (qb * 32 + r) * 144 + (d * 32 + 8 * g + 4 * h) * 2) = v;
            }
    }
    __builtin_amdgcn_wave_barrier();
    bf16* obase = p.cat + ((size_t)b * SQ + CTXL + qt * 512 + wave * 64) * 1024 + 256 + hd * 64;
#pragma unroll
    for (int it = 0; it < 8; ++it) {
        const int row = it * 8 + (lane >> 3), c8 = lane & 7;
        const u32x4 v = *(const u32x4*)(st + row * 144 + c8 * 16);
        *(u32x4*)(obase + (size_t)row * 1024 + c8 * 8) = v;
    }
    __builtin_amdgcn_wave_barrier();
}

#define ML_ROWB 144
__device__ __forceinline__ float logsigmoid_(float x) { return fminf(x, 0.f) - log1pf(expf(-fabsf(x))); }
__device__ __forceinline__ float scan_sum(float v, int lane) { (void)lane; return dpp_scan_sum(v); }
__device__ __forceinline__ float scan_max(float v, int lane) { (void)lane; return dpp_scan_max(v); }
#define MLA_SLOT (64 * ML_ROWB + 96 * ML_ROWB + 256)
__device__ __forceinline__ void phase_ml_a(const Params& p, int l, int item, char* smem) {
    const int tid = otid(), lane = tid & 63, us = tid >> 7, tl = tid & 127, hw = (tid >> 6) & 1, r = lane & 31, h = lane >> 5;
    const int u = item * 4 + us;
    const int c = u % NCH, dir = (u / NCH) & 1, hd = (u / (NCH * 2)) & 3, b = u / (NCH * 8);
    const int tok0 = b * SQ + c * 64;
    char* sl = smem + us * MLA_SLOT;
    bf16* s_kt = (bf16*)sl; bf16* s_vt = (bf16*)(sl + 64 * ML_ROWB); float* s_e = (float*)(sl + 160 * ML_ROWB);
    const int pq = tl >> 3, part = tl & 7;
    u32x4 kv[4], vv[4];
#pragma unroll
    for (int i = 0; i < 4; ++i) {
        const int pos = pq * 4 + i;
        kv[i] = *(const u32x4*)(p.qkc + (size_t)(tok0 + pos) * 512 + 256 + hd * 64 + part * 8);
        vv[i] = *(const u32x4*)(p.z + (size_t)(tok0 + pos) * ZW + Z_MLV + hd * 64 + part * 8);
    }
    if (hw == 0) {
        const int pos = dir ? 63 - lane : lane, tok = tok0 + pos;
        const float gi = p.gates[(size_t)tok * 16 + dir * 4 + hd] + p.gate_b[l * 16 + dir * 4 + hd];
        const float gf = p.gates[(size_t)tok * 16 + 8 + dir * 4 + hd] + p.gate_b[l * 16 + 8 + dir * 4 + hd];
        const float bc = scan_sum(logsigmoid_(gf), lane);
        const float bl = readlane_f(bc, 63);
        const float we = bl - bc + gi;
        const float ml = wave_max(we);
        s_e[pos] = expf(we - ml);
        if (lane == 0) { p.mlstat[(size_t)u * 4] = ml; p.mlstat[(size_t)u * 4 + 1] = bl; }
    }
    __syncthreads();
    {
        float e[4];
#pragma unroll
        for (int i = 0; i < 4; ++i) e[i] = s_e[pq * 4 + i];
#pragma unroll
        for (int j = 0; j < 8; ++j) {
            float kx[4]; unsigned vx[4];
#pragma unroll
            for (int i = 0; i < 4; ++i) {
                const unsigned kw = kv[i][j >> 1], vw = vv[i][j >> 1];
                kx[i] = ((j & 1) ? bfhi(kw) : bflo(kw)) * e[i];
                vx[i] = (j & 1) ? (vw >> 16) : (vw & 0xffffu);
            }
            u32x2 ko = {pk2(kx[0], kx[1]), pk2(kx[2], kx[3])};
            u32x2 vo = {vx[0] | (vx[1] << 16), vx[2] | (vx[3] << 16)};
            *(u32x2*)((char*)s_kt + (part * 8 + j) * ML_ROWB + pq * 8) = ko;
            *(u32x2*)((char*)s_vt + (part * 8 + j) * ML_ROWB + pq * 8) = vo;
        }
    }
    if (tl < 64) s_vt[64 * 72 + tl] = 0x3F80;
    __syncthreads();
    f32x16 acc[3];
#pragma unroll
    for (int rt = 0; rt < 3; ++rt)
#pragma unroll
        for (int q = 0; q < 16; ++q) acc[rt][q] = 0.f;
#pragma unroll
    for (int ks = 0; ks < 4; ++ks) {
        const bf16x8 ktf = *(const bf16x8*)((const char*)s_kt + (hw * 32 + r) * ML_ROWB + ks * 32 + h * 16);
#pragma unroll
        for (int rt = 0; rt < 3; ++rt) {
            const bf16x8 vtf = *(const bf16x8*)((const char*)s_vt + (rt * 32 + r) * ML_ROWB + ks * 32 + h * 16);
            acc[rt] = MFMA32(vtf, ktf, acc[rt]);
        }
    }
    bf16* cl = p.cloc + (size_t)u * CLOC_STRIDE;
#pragma unroll
    for (int rt = 0; rt < 2; ++rt)
#pragma unroll
        for (int q = 0; q < 16; ++q) { const int d = rt * 32 + (q & 3) + 8 * (q >> 2) + 4 * h; cl[d * 64 + hw * 32 + r] = f2bf(acc[rt][q]); }
    if (h == 0) cl[64 * 64 + hw * 32 + r] = f2bf(acc[2][0]);
}
#define MLC_SLOT (64 * ML_ROWB + 64 * ML_ROWB + 96 * ML_ROWB + 1024)
__device__ __forceinline__ void phase_ml_c(const Params& p, int l, int item, char* smem) {
    const int tid = otid(), lane = tid & 63, us = tid >> 7, tl = tid & 127, hw = (tid >> 6) & 1, r = lane & 31, h = lane >> 5;
    const int pair = us >> 1, dir = us & 1, pr = item * 2 + pair;
    const int c = pr % NCH, hd = (pr / NCH) & 3, b = pr / (NCH * 4);
    const int u = ((b * 4 + hd) * 2 + dir) * NCH + c;
    const int tok0 = b * SQ + c * 64;
    char* sl = smem + us * MLC_SLOT;
    char* s_k = sl; char* s_vt = sl + 64 * ML_ROWB; char* s_ci = sl + 128 * ML_ROWB;
    float* s_bm = (float*)(sl + 224 * ML_ROWB); float* s_a1 = s_bm + 64; float* s_wi = s_bm + 128; float* s_em = s_bm + 192;
    {
        const int pq = tl >> 3, part = tl & 7;
        u32x4 vv[4];
#pragma unroll
        for (int i = 0; i < 4; ++i) {
            const int pos = pq * 4 + i;
            const u32x4 kv = *(const u32x4*)(p.qkc + (size_t)(tok0 + pos) * 512 + 256 + hd * 64 + part * 8);
            *(u32x4*)(s_k + pos * ML_ROWB + part * 16) = kv;
            vv[i] = *(const u32x4*)(p.z + (size_t)(tok0 + pos) * ZW + Z_MLV + hd * 64 + part * 8);
        }
#pragma unroll
        for (int j = 0; j < 8; ++j) {
            unsigned vx[4];
#pragma unroll
            for (int i = 0; i < 4; ++i) { const unsigned vw = vv[i][j >> 1]; vx[i] = (j & 1) ? (vw >> 16) : (vw & 0xffffu); }
            u32x2 vo = {vx[0] | (vx[1] << 16), vx[2] | (vx[3] << 16)};
            *(u32x2*)(s_vt + (part * 8 + j) * ML_ROWB + pq * 8) = vo;
        }
    }
#pragma unroll
    for (int q = 0; q < 5; ++q) {
        const int idx = tl + 128 * q;
        if (idx < 520) { const int row = idx >> 3, part = idx & 7; *(u32x4*)(s_ci + row * ML_ROWB + part * 16) = *(const u32x4*)(p.cloc + (size_t)u * CLOC_STRIDE + row * 64 + part * 8); }
    }
    const int t = hw * 32 + r;
    bf16x8 qf[4];
#pragma unroll
    for (int ks = 0; ks < 4; ++ks) qf[ks] = *(const bf16x8*)(p.qkc + (size_t)(tok0 + t) * 512 + hd * 64 + ks * 16 + h * 8);
    if (hw == 0) {
        const int pos = dir ? 63 - lane : lane, tok = tok0 + pos;
        const float gi = p.gates[(size_t)tok * 16 + dir * 4 + hd] + p.gate_b[l * 16 + dir * 4 + hd];
        const float gf = p.gates[(size_t)tok * 16 + 8 + dir * 4 + hd] + p.gate_b[l * 16 + 8 + dir * 4 + hd];
        const float bc = scan_sum(logsigmoid_(gf), lane);
        const float a1 = gi - bc;
        const float pm = scan_max(a1, lane);
        const float li = bc + p.mlstat[(size_t)u * 4 + 2];
        const float mt = fmaxf(li, bc + pm);
        s_bm[pos] = (bc - mt) * LOG2E; s_a1[pos] = a1 * LOG2E; s_wi[pos] = expf(li - mt); s_em[pos] = expf(-mt);
    }
    __syncthreads();
    f32x16 sacc[2];
#pragma unroll
    for (int sb = 0; sb < 2; ++sb) {
#pragma unroll
        for (int q = 0; q < 16; ++q) sacc[sb][q] = 0.f;
#pragma unroll
        for (int ks = 0; ks < 4; ++ks) sacc[sb] = MFMA32(*(const bf16x8*)(s_k + (sb * 32 + r) * ML_ROWB + ks * 32 + h * 16), qf[ks], sacc[sb]);
    }
    const float bt = s_bm[t], wi = s_wi[t], em = s_em[t];
    float dsum = 0.f;
    bf16x8 pf[2][2];
#pragma unroll
    for (int sb = 0; sb < 2; ++sb) {
#pragma unroll
        for (int q = 0; q < 16; ++q) {
            const int sp = sb * 32 + (q & 3) + 8 * (q >> 2) + 4 * h;
            const bool valid = dir ? (sp >= t) : (sp <= t);
            const float v = valid ? sacc[sb][q] * fexp2(bt + s_a1[sp]) : 0.f;
            sacc[sb][q] = v; dsum += v;
        }
#pragma unroll
        for (int s2 = 0; s2 < 2; ++s2) {
            u32x4 t4 = {pk2(sacc[sb][8 * s2], sacc[sb][8 * s2 + 1]), pk2(sacc[sb][8 * s2 + 2], sacc[sb][8 * s2 + 3]),
                        pk2(sacc[sb][8 * s2 + 4], sacc[sb][8 * s2 + 5]), pk2(sacc[sb][8 * s2 + 6], sacc[sb][8 * s2 + 7])};
            pf[sb][s2] = (bf16x8)t4;
        }
    }
    f32x16 an[3];
#pragma unroll
    for (int rt = 0; rt < 3; ++rt) {
#pragma unroll
        for (int q = 0; q < 16; ++q) an[rt][q] = 0.f;
#pragma unroll
        for (int ks = 0; ks < 4; ++ks) an[rt] = MFMA32(*(const bf16x8*)(s_ci + (rt * 32 + r) * ML_ROWB + ks * 32 + h * 16), qf[ks], an[rt]);
    }
#pragma unroll
    for (int rt = 0; rt < 2; ++rt)
#pragma unroll
        for (int q = 0; q < 16; ++q) an[rt][q] *= wi;
    const float ninq = __shfl(an[2][0], r, 64);
#pragma unroll
    for (int d = 0; d < 2; ++d)
#pragma unroll
        for (int sb = 0; sb < 2; ++sb)
#pragma unroll
            for (int s2 = 0; s2 < 2; ++s2) {
                const char* a = s_vt + (d * 32 + r) * ML_ROWB + (sb * 32 + 16 * s2 + 4 * h) * 2;
                const u32x2 lo = *(const u32x2*)a, hi = *(const u32x2*)(a + 16);
                u32x4 t4 = {lo[0], lo[1], hi[0], hi[1]};
                an[d] = MFMA32((bf16x8)t4, pf[sb][s2], an[d]);
            }
    dsum += __shfl_xor(dsum, 32, 64);
    const float den = dsum + wi * ninq;
    const float inv = 1.f / fmaxf(fabsf(den), em);
    __syncthreads();
    float* hs = (float*)(smem + pair * 2 * MLC_SLOT) + dir * 64 * 65;
#pragma unroll
    for (int d = 0; d < 2; ++d)
#pragma unroll
        for (int q = 0; q < 16; ++q) { const int dd = d * 32 + (q & 3) + 8 * (q >> 2) + 4 * h; hs[t * 65 + dd] = an[d][q] * inv; }
    __syncthreads();
    {
        const int tp = tid & 255, tt = tp >> 2, qd = tp & 3;
        const float* h0 = (const float*)(smem + pair * 2 * MLC_SLOT) + tt * 65 + qd * 16;
        const bf16* orow = p.z + (size_t)(tok0 + tt) * ZW + Z_MLO + hd * 64 + qd * 16;
        const u32x4 o0 = *(const u32x4*)orow, o1 = *(const u32x4*)(orow + 8);
        float v[16]; float sm = 0.f;
#pragma unroll
        for (int j = 0; j < 16; ++j) {
            const unsigned w = j < 8 ? o0[j >> 1] : o1[(j - 8) >> 1];
            const float og = (j & 1) ? bfhi(w) : bflo(w);
            v[j] = sigmoidf_(og) * (h0[j] + h0[64 * 65 + j]); sm += v[j];
        }
        sm += __shfl_xor(sm, 1, 64); sm += __shfl_xor(sm, 2, 64);
        const float mu = sm * (1.f / 64.f);
        float vq = 0.f;
#pragma unroll
        for (int j = 0; j < 16; ++j) { v[j] -= mu; vq += v[j] * v[j]; }
        vq += __shfl_xor(vq, 1, 64); vq += __shfl_xor(vq, 2, 64);
        const float rs = rsqrtf(vq * (1.f / 64.f) + LN_EPS);
        const float* ng = p.ml_norm_g + l * 256 + hd * 64 + qd * 16;
        bf16* dst = p.cat + (size_t)(tok0 + tt) * 1024 + 768 + hd * 64 + qd * 16;
#pragma unroll
        for (int j = 0; j < 16; j += 4) st_bf4(dst + j, v[j] * rs * ng[j], v[j + 1] * rs * ng[j + 1], v[j + 2] * rs * ng[j + 2], v[j + 3] * rs * ng[j + 3]);
    }
}

#define PROBE_REPEAT 0
#ifndef DBG_STOP
#define DBG_STOP 0
#endif
#ifndef DBG_L
#define DBG_L 0
#endif
__device__ __forceinline__ void dbg_scan(const Params& p, const void* base, size_t rows, size_t stride, size_t c0, size_t c1, bool isbf, int bit = 0) {
    const size_t cpr = (c1 - c0) >> 4, total = rows * cpr;
    unsigned cs = 0, nf = 0;
    for (size_t i = (size_t)blockIdx.x * 512 + threadIdx.x; i < total; i += (size_t)gridDim.x * 512) {
        const size_t r = i / cpr, c = i - r * cpr;
        const u32x4 v = *(const u32x4*)((const char*)base + r * stride + c0 + c * 16);
#pragma unroll
        for (int k = 0; k < 4; ++k) {
            const unsigned w = v[k]; cs += w * 2654435761u + (w >> 7);
            if (isbf) { if ((w & 0x7F80u) >= 0x4480u || ((w >> 16) & 0x7F80u) >= 0x4480u) ++nf; }
            else { if ((w & 0x7F800000u) >= 0x44800000u) ++nf; }
        }
    }
    atomicAdd(&p.ctr[250], cs); if (nf) atomicOr(&p.ctr[251], 1u << bit);
}
#define SMEM_HDR 512
#define SMEM_BYTES (SMEM_HDR + 6 * ASTAT_SLAB + 8 * 32 * STG_ROWB)
#define NCTR 512

typedef const Params __attribute__((address_space(4)))* kparams_t;
__device__ __forceinline__ const Params& fresh_params() {
    kparams_t q = (kparams_t)__builtin_amdgcn_kernarg_segment_ptr();
    asm volatile("" : "+s"(q));
    return *(const Params*)q;
}
#define STAGE_BEGIN { const Params& p = fresh_params();
#define STAGE_END }
extern "C" __global__ void __launch_bounds__(512) mega_kernel(Params p_in) {
    (void)p_in;
    extern __shared__ __attribute__((aligned(16))) char smem_raw[];
    int* s_item = (int*)(smem_raw + 16);
    int* s_int = (int*)(smem_raw + 64);
    char* sm = smem_raw + SMEM_HDR;
    if (threadIdx.x == 0) *(uint4*)smem_raw = make_uint4(0u, 0u, 0u, 0u);
    __syncthreads();
    XcdBarrier bar = xcd_barrier_post(fresh_params().bar, (volatile LAS unsigned*)smem_raw);

    STAGE_BEGIN
    run_items(p.ctr + 0, 192, s_item, [&](int it) { job_modv(p, it, sm); });
    run_items(p.ctr + 1, 1, s_item, [&](int) { job_rope_tab(p); });
    run_items(p.ctr + 2, 64, s_item, [&](int it) { job_s5_tables(p, it, sm); });
    STAGE_END
    xcd_barrier(bar);

#if DBG_STOP
#define DBG_CHECK(N) if (DBG_STOP == (N) && l == DBG_L) break;
#else
#define DBG_CHECK(N)
#endif
    for (int l = 0; l < 2; ++l) {
        unsigned* C = fresh_params().ctr + 8 + l * 64;
        if (l == 0) {
            STAGE_BEGIN
            run_items(C + 0, CVT_SMALL, s_item, [&](int it) { job_cvt_small(p, 0, it, sm); });
            run_items(C + 1, 1024, s_item, [&](int it) { job_s5_expand(p, 0, it); });
            phase_ln_mod(p, 0, 0);
            STAGE_END
            xcd_barrier(bar);
        }
        DBG_CHECK(1)
        STAGE_BEGIN
        {
            g8::GridOrder S8; S8.A = (const char*)p.h; S8.Bt = (const char*)p.bt_in; S8.K = 1024; S8.nM = NTOK / 256; S8.nN = 7; S8.nwg = S8.nM * S8.nN; S8.G = (int)gridDim.x; S8.c = (int)blockIdx.x; S8.skipctx = 0;
            EpiInproj8 e8; e8.ug = p.ug; e8.z = p.z; e8.gates = p.gates;
            __syncthreads();
            g8::gemm_phase<false, true>((LAS unsigned char*)sm, 1024, S8, e8);
        }
        STAGE_END
        xcd_barrier(bar);
        DBG_CHECK(2)
        STAGE_BEGIN
        run_items(C + 4, 16 * 9 * 2, s_item, [&](int it) {
            const int g = it / 18, r = it % 18, mt = r >> 1, nt = r & 1;
            const Seg sg[1] = {{p.ug + (size_t)g * NROWP * 1024, p.gg + (size_t)g * 256 * 1024, 1024, 1024, 1024}};
            EpiF32 e; e.C = p.ff + (size_t)g * NROWP * 256; e.ldc = 256; e.mvalid = NROW; e.nvalid = 256;
            gemm_tile<128, 1>(sg, nullptr, mt * 128, nt * 128, e, sm);
        });
        phase_post_inproj(p, l, 0);
        STAGE_END
        xcd_barrier(bar);
        DBG_CHECK(3)
        STAGE_BEGIN
        run_items(C + 6, 32, s_item, [&](int it) { job_s5_carry(p, l, it); });
        run_items(C + 7, NUNIT / 4, s_item, [&](int it) { phase_ml_a(p, l, it, sm); });
        run_items(C + 8, NTOK / 128, s_item, [&](int mt) {
            EpiQ e; e.rq = p.rq; e.tab = p.rope_tab; e.q = p.q; e.stg = sm + 6 * ASTAT_SLAB;
            gemm_astat<4>(p.z + Z_QC, ZW, nullptr, mt * 128, p.bt_q, 256, 6, e, sm);
        });
        run_items(C + 9, NTOK / 128, s_item, [&](int mt) {
            EpiKV e; e.rkv = p.rkv; e.kf = p.kf; e.vt = p.vt; e.stg = sm + 6 * ASTAT_SLAB;
            gemm_astat<2>(p.z + Z_KVC, ZW, nullptr, mt * 128, p.bt_kv, 128, 8, e, sm);
        });
        STAGE_END
        xcd_barrier(bar);
        DBG_CHECK(4)
        STAGE_BEGIN
        run_items(C + 12, 64 * 16, s_item, [&](int it) { attn_item64(p, it >> 4, it & 15, sm); });
        if (l == 0) run_items(C + 59, 64, s_item, [&](int it) { attn_item<0>(p, it, 0, sm); });
        run_items(C + 10, 64 * 5, s_item, [&](int it) { job_ml_carry(p, it); });
        run_items(C + 11, 16 * 9 * 4, s_item, [&](int it) {
            const int g = it / 36, r = it % 36, mt = r >> 2, nt = r & 3;
            const Seg sg[2] = {{p.ug + (size_t)g * NROWP * 1024, p.wg + (size_t)g * 1024 * 1024, 1024, 1024, 1024},
                               {p.sin_ + (size_t)g * NROWP * 256, p.eg + (size_t)g * 1024 * 256, 256, 256, 256}};
            EpiS5Y e; e.gs = p.gs; e.g = g;
            gemm_tile<128, 2, 256>(sg, nullptr, mt * 128, nt * 256, e, sm);
        });
        STAGE_END
        xcd_barrier(bar);
        DBG_CHECK(5)
        STAGE_BEGIN
        run_items(C + 13, NTOK / 128, s_item, [&](int mt) {
            EpiGlu e; e.gs = p.gs; e.bias = p.glu_b + l * 256; e.cat = p.cat; e.stg = sm + 6 * ASTAT_SLAB;
            gemm_astat<4>(p.gs, 256, nullptr, mt * 128, p.bt_glu, 256, 2, e, sm);
        });
        run_items(C + 14, NB * 4 * NCH / 2, s_item, [&](int it) { phase_ml_c(p, l, it, sm); });
        STAGE_END
        xcd_barrier(bar);
        DBG_CHECK(6)
        STAGE_BEGIN
        {
            g8::GridOrder S8; S8.A = (const char*)p.cat; S8.Bt = (const char*)p.bt_out; S8.K = 1024; S8.skipctx = (l == 1); S8.nM = S8.skipctx ? NB * 32 : NTOK / 256; S8.nN = 4; S8.nwg = S8.nM * S8.nN; S8.G = (int)gridDim.x; S8.c = (int)blockIdx.x;
            EpiBf16_8 e8; e8.C = p.z; e8.ldc = 1024;
            __syncthreads();
            g8::gemm_phase<false, true>((LAS unsigned char*)sm, 1024, S8, e8);
        }
        run_items(C + 63, CVT_EXPERT, s_item, [&](int it) { job_cvt_expert(p, l, it, sm); });
        STAGE_END
        xcd_barrier(bar);
        DBG_CHECK(7)
        STAGE_BEGIN
        phase_post_mixer<0>(p, l, 0);
        STAGE_END
        xcd_barrier(bar);
        DBG_CHECK(8)
        STAGE_BEGIN
        run_items(C + 17, l == 1 ? NB * 32 : NTOK / 256, s_item, [&](int it0) {
            const int it = (l == 1) ? (it0 >> 5) * 33 + 1 + (it0 & 31) : it0;
            const Seg sg[2] = {{p.h, p.bt_rhi, 1024, 1024, 1024}, {p.cat, p.bt_rhi, 1024, 1024, 1024}};
            EpiRouterSum e; e.C = p.logits; e.stg = sm;
            gemm_tile<256, 2>(sg, nullptr, it * 256, 0, e, sm);
        });
        STAGE_END
        xcd_barrier(bar);
        DBG_CHECK(9)
        STAGE_BEGIN
        phase_route(p, l, 0, sm);
        run_items(C + 19, (NB * MOE_SLOTS / 4 + 2047) / 2048, s_item, [&](int it) {
            const u32x4 zz = {0u, 0u, 0u, 0u};
            for (int k = 0; k < 4; ++k) { const int idx = it * 2048 + k * 512 + otid(); if (idx < NB * MOE_SLOTS / 4) { ((u32x4*)p.slottok)[idx] = zz; ((u32x4*)p.slotgate)[idx] = zz; } }
        });
        STAGE_END
        xcd_barrier(bar);
        DBG_CHECK(10)
        STAGE_BEGIN
        run_items(C + 20, NB, s_item, [&](int it) { job_tiles(p, l, it, s_int); });
        job_slots(p, l, 0, s_int);
        STAGE_END
        xcd_barrier(bar);
        DBG_CHECK(11)
        for (int sgi = 0; sgi < NB + 2; ++sgi) {
            STAGE_BEGIN
            if (sgi < NB) {
                const int b = sgi;
                UpOrder S8; S8.A = (const char*)p.h; S8.Bt = (const char*)p.bt_up; S8.slottok = p.slottok + (size_t)b * MOE_SLOTS; S8.ue = p.up_e + b * UPU_STRIDE; S8.ur = p.up_row + b * UPU_STRIDE;
                S8.nu2 = 2 * p.up_n[b]; S8.G = (int)gridDim.x; S8.c = (int)blockIdx.x;
                EpiUp8 e8; e8.slotgate = p.slotgate + (size_t)b * MOE_SLOTS; e8.hc = (b & 1) ? p.hc1 : p.hc;
                __syncthreads();
                g8::gemm_phase<true>((LAS unsigned char*)sm, 1024, S8, e8);
            }
            if (sgi >= 2) { const int b = sgi - 2; const bf16* yb = (b & 1) ? p.yc1 : p.yc; phase_combine(p, l, b, 0, yb); }
            if (l == 0 && sgi == NB + 1) {
                run_items(C + 64 + 0, CVT_SMALL, s_item, [&](int it) { job_cvt_small(p, 1, it, sm); });
                run_items(C + 64 + 1, 1024, s_item, [&](int it) { job_s5_expand(p, 1, it); });
            }
            if (sgi >= 1 && sgi <= NB) {
                const int b = sgi - 1;
                const bf16* hb = (b & 1) ? p.hc1 : p.hc; bf16* yb = (b & 1) ? p.yc1 : p.yc;
                run_items_xcd(p.ctr + 256 + ((l * 8 + b) * 2 + 1) * 8, p.xl_cnt + b * 8, 1, (int)(bar.x & 7u), s_item, [&](int x, int it) {
                    const int t = p.xl_tile[(size_t)(b * 8 + x) * XL_STRIDE + it], ex = p.tile_e[b * MOE_TILES + t];
                    gemm_astat256<4, true>(hb, 256, t * 128, p.bt_dn + (size_t)ex * 1024 * 256, 256, 4, yb, 1024, sm);
                });
            }
            STAGE_END
            xcd_barrier(bar);
        }
        DBG_CHECK(12)
    }
#if DBG_STOP
    {
        const Params& p = fresh_params();
        const size_t T = NTOK;
        if (DBG_STOP == 1) { dbg_scan(p, p.h, T, 2048, 0, 2048, true); dbg_scan(p, p.bt_in, NINP, 2048, 0, 2048, true); dbg_scan(p, p.bt_up, 65 * 512, 2048, 0, 2048, true); dbg_scan(p, p.bt_dn, 65 * 1024, 512, 0, 512, true);
                             dbg_scan(p, p.wg, 16 * 1024, 2048, 0, 2048, true); dbg_scan(p, p.eg, 16 * 1024, 512, 0, 512, true); dbg_scan(p, p.gg, 16 * 256, 2048, 0, 2048, true); dbg_scan(p, p.modv, 18, 6144 * 4, 0, 6144 * 4, false); }
        if (DBG_STOP == 2) { dbg_scan(p, p.z, T, ZW * 2, 0, ZW * 2, true); dbg_scan(p, p.gates, T, 64, 0, 64, false); for (int g = 0; g < 16; ++g) dbg_scan(p, p.ug + (size_t)g * NROWP * 1024, NROW, 2048, 0, 2048, true); }
        if (DBG_STOP == 3) { for (int g = 0; g < 16; ++g) dbg_scan(p, p.ff + (size_t)g * NROWP * 256, NROW, 1024, 0, 1024, false); dbg_scan(p, p.qkc, T, 1024, 0, 1024, true); dbg_scan(p, p.rq, 1, T * 4, 0, T * 4, false); dbg_scan(p, p.rkv, 1, T * 4, 0, T * 4, false); dbg_scan(p, p.kf, T * 8, 192, 128, 192, true); }
        if (DBG_STOP == 4) { dbg_scan(p, p.cloc, (size_t)NUNIT * 65, 128, 0, 64, true, 0); dbg_scan(p, p.cloc, (size_t)NUNIT * 65, 128, 64, 128, true, 1);
                             dbg_scan(p, p.cloc, NUNIT, CLOC_STRIDE * 2, 0, 4096, true, 2); dbg_scan(p, p.cloc, NUNIT, CLOC_STRIDE * 2, 4096, 8192, true, 3); dbg_scan(p, p.cloc, NUNIT, CLOC_STRIDE * 2, 8192, 8320, true, 4); }
        if (DBG_STOP == 5) { dbg_scan(p, p.cloc, NUNIT, CLOC_STRIDE * 2, 0, CLOC_STRIDE * 2, true); dbg_scan(p, p.gs, T, 512, 0, 512, true); dbg_scan(p, p.cat, T, 2048, 512, 1536, true); }
        if (DBG_STOP == 6) {
            dbg_scan(p, p.z, T, ZW * 2, 0, ZW * 2, true, 0); dbg_scan(p, p.gates, T, 64, 0, 64, false, 0); for (int g = 0; g < 16; ++g) dbg_scan(p, p.ug + (size_t)g * NROWP * 1024, NROW, 2048, 0, 2048, true, 0);
            dbg_scan(p, p.qkc, T, 1024, 0, 1024, true, 0); dbg_scan(p, p.rq, 1, T * 4, 0, T * 4, false, 0); dbg_scan(p, p.rkv, 1, T * 4, 0, T * 4, false, 0);
            for (int g = 0; g < 16; ++g) { dbg_scan(p, p.ff + (size_t)g * NROWP * 256, NROW, 1024, 0, 1024, false, 1); dbg_scan(p, p.sin_ + (size_t)g * NROWP * 256, NROW, 512, 0, 512, true, 1); }
            dbg_scan(p, p.gs, T, 512, 0, 512, true, 1); dbg_scan(p, p.cat, T, 2048, 0, 512, true, 1);
            dbg_scan(p, p.q, T * 8, 192, 0, 192, true, 2); dbg_scan(p, p.kf, T * 8, 192, 0, 192, true, 2); dbg_scan(p, p.vt, (size_t)NB * 8 * 64, SQ * 2, 0, SQ * 2, true, 2);
            dbg_scan(p, p.cat, T, 2048, 512, 1536, true, 3);
            dbg_scan(p, p.cloc, NUNIT, CLOC_STRIDE * 2, 0, CLOC_STRIDE * 2, true, 4); dbg_scan(p, p.cat, T, 2048, 1536, 2048, true, 4);
        }
        if (DBG_STOP == 7) { dbg_scan(p, p.z, T, 2048, 0, 2048, true); }
        if (DBG_STOP == 8) { dbg_scan(p, p.out, (size_t)NB * SEQL, 4096, 0, 4096, false); dbg_scan(p, p.ctxres, NB * CTXL, 4096, 0, 4096, false); dbg_scan(p, p.h, T, 2048, 0, 2048, true); dbg_scan(p, p.cat, T, 2048, 0, 2048, true); }
        if (DBG_STOP == 9) { dbg_scan(p, p.logits, T, 256, 0, 256, false); }
        if (DBG_STOP == 10) { dbg_scan(p, p.tope, T, 32, 0, 32, false); dbg_scan(p, p.gatew, T, 32, 0, 32, false); }
        if (DBG_STOP == 12) { dbg_scan(p, p.out, (size_t)NB * SEQL, 4096, 0, 4096, false); dbg_scan(p, p.ctxres, NB * CTXL, 4096, 0, 4096, false); }
        xcd_barrier(bar);
        const unsigned cs = __hip_atomic_load(&p.ctr[250], __ATOMIC_RELAXED, __HIP_MEMORY_SCOPE_AGENT), nf = __hip_atomic_load(&p.ctr[251], __ATOMIC_RELAXED, __HIP_MEMORY_SCOPE_AGENT);
        const float code = (DBG_STOP == 6 || DBG_STOP == 4) ? 1.f + (float)nf : 1.f + (nf ? 4.f : 0.f) + (float)((cs >> 3) & 3u);
        const f32x4 cv = {code, code, code, code};
        for (size_t i = (size_t)blockIdx.x * 512 + threadIdx.x; i < (size_t)NB * SEQL * DM / 4; i += (size_t)gridDim.x * 512) ((f32x4*)p.out)[i] = cv;
    }
#endif
}

static inline size_t al256(size_t x) { return (x + 255) & ~(size_t)255; }

extern "C" void kernel_launch(void* const* d_in, const int* in_sizes, int n_in, void* d_out, int out_size, void* d_ws, size_t ws_size, hipStream_t stream) {
    (void)in_sizes; (void)n_in; (void)out_size;
    Params p; memset(&p, 0, sizeof(p));
    const float* const* in = (const float* const*)d_in;
    p.x = in[0]; p.c = in[1]; p.ctx = in[2]; p.c_ctx = in[3]; p.ada_w = in[4]; p.ada_b = in[5]; p.w_in = in[6];
    p.lam_re = in[7]; p.lam_im = in[8]; p.log_step = in[9]; p.b_re = in[10]; p.b_im = in[11]; p.c_re = in[12]; p.c_im = in[13];
    p.s5_d = in[14]; p.glu_w = in[15]; p.glu_b = in[16]; p.q_norm = in[17]; p.w_q_up = in[18]; p.kv_norm = in[19]; p.w_kv_up = in[20];
    p.conv_w = in[21]; p.conv_b = in[22]; p.gate_b = in[23]; p.ml_norm_g = in[24]; p.w_out = in[25]; p.ln1_g = in[26]; p.ln1_b = in[27];
    p.ln2_g = in[28]; p.ln2_b = in[29]; p.router_w = in[30]; p.router_bias = in[31]; p.ew_gate = in[32]; p.ew_up = in[33]; p.ew_down = in[34];
    p.sw_gate = in[35]; p.sw_up = in[36]; p.sw_down = in[37];
    p.out = (float*)d_out;

    char* ws = (char*)d_ws; size_t off = 0;
    auto take = [&](size_t bytes) { char* r = ws + off; off += al256(bytes); return r; };
    const size_t zero_bytes = al256(XCD_BAR_WORDS * 4) + al256(NCTR * 4) + al256(2 * 8 * 64 * 4);
    p.bar = (unsigned*)take(XCD_BAR_WORDS * 4); p.ctr = (unsigned*)take(NCTR * 4); p.moe_cnt = (int*)take(2 * 8 * 64 * 4);
    p.modv = (float*)take((size_t)2 * 9 * 6144 * 4); p.rope_tab = (float*)take(1024 * 2 * 4);
    p.klag = (float*)take((size_t)64 * 16384 * 4); p.pw = (float*)take((size_t)64 * 64 * 65 * 8); p.bbar = (float*)take((size_t)64 * 1024 * 8);
    p.ctxres = (float*)take((size_t)NB * CTXL * DM * 4); p.gates = (float*)take((size_t)NTOK * 16 * 4);
    p.rq = (float*)take((size_t)NTOK * 4); p.rkv = (float*)take((size_t)NTOK * 4); p.mlstat = (float*)take((size_t)NUNIT * 4 * 4);
    p.bt_in = (bf16*)take((size_t)NINP * 1024 * 2); p.bt_q = (bf16*)take((size_t)768 * 256 * 2); p.bt_kv = (bf16*)take((size_t)1024 * 128 * 2);
    p.bt_glu = (bf16*)take((size_t)256 * 256 * 2); p.bt_out = (bf16*)take((size_t)1024 * 1024 * 2);
    p.bt_rhi = (bf16*)take((size_t)128 * 1024 * 2); p.bt_rlo = p.bt_rhi + (size_t)64 * 1024;
    p.bt_up = (bf16*)take((size_t)65 * 512 * 1024 * 2); p.bt_dn = (bf16*)take((size_t)65 * 1024 * 256 * 2);
    p.wg = (bf16*)take((size_t)16 * 1024 * 1024 * 2); p.eg = (bf16*)take((size_t)16 * 1024 * 256 * 2); p.gg = (bf16*)take((size_t)16 * 256 * 1024 * 2);
    {
        const size_t qkc_b = al256((size_t)NTOK * 512 * 2), cloc_b = al256((size_t)NUNIT * CLOC_STRIDE * 2), h_b = al256((size_t)NTOK * DM * 2);
        const size_t reg = (qkc_b + cloc_b) > h_b ? (qkc_b + cloc_b) : h_b;
        char* r = take(reg); p.h = (bf16*)r; p.qkc = (bf16*)r; p.cloc = (bf16*)(r + qkc_b);
    }
    p.z = (bf16*)take((size_t)NTOK * ZW * 2);
    p.cat = (bf16*)take((size_t)NTOK * DM * 2);
    {
        const size_t ug_b = al256((size_t)16 * NROWP * 1024 * 2), sin_b = al256((size_t)16 * NROWP * 256 * 2), ff_b = al256((size_t)16 * NROWP * 256 * 4), gs_b = al256((size_t)NTOK * 256 * 2);
        const size_t s5_total = ug_b + sin_b + ff_b + gs_b;
        const size_t lg_b = al256((size_t)NTOK * 64 * 4), t8_b = al256((size_t)NTOK * 8 * 4), sl_b = al256((size_t)NB * MOE_SLOTS * 4), te_b = al256((size_t)NB * MOE_TILES * 4), nt_b = al256(64), xl_b = al256((size_t)NB * 8 * XL_STRIDE * 4), xc_b = al256(NB * 8 * 4), uu_b = al256((size_t)NB * UPU_STRIDE * 4);
        const size_t rt_total = lg_b + 4 * t8_b + 2 * sl_b + te_b + nt_b + xl_b + xc_b + 2 * uu_b + 256;
        char* r = take(s5_total > rt_total ? s5_total : rt_total);
        p.ug = (bf16*)r; p.sin_ = (bf16*)(r + ug_b); p.ff = (float*)(r + ug_b + sin_b); p.gs = (bf16*)(r + ug_b + sin_b + ff_b);
        char* q = r;
        p.logits = (float*)q; q += lg_b; p.tope = (int*)q; q += t8_b; p.pos = (int*)q; q += t8_b; p.tokslot = (int*)q; q += t8_b; p.gatew = (float*)q; q += t8_b;
        p.slottok = (int*)q; q += sl_b; p.slotgate = (float*)q; q += sl_b; p.tile_e = (int*)q; q += te_b; p.ntb = (int*)q; q += nt_b; p.xl_tile = (int*)q; q += xl_b; p.xl_cnt = (int*)q; q += xc_b; p.up_e = (int*)q; q += uu_b; p.up_row = (int*)q; q += uu_b; p.up_n = (int*)q; q += 256;
    }
    {
        const size_t q_b = al256((size_t)NTOK * 768 * 2), kf_b = q_b, vt_b = al256((size_t)NTOK * 512 * 2);
        const size_t hc_b = al256((size_t)MOE_SLOTS * 256 * 2), yc_b = al256((size_t)MOE_SLOTS * 1024 * 2);
        const size_t a_total = q_b + kf_b + vt_b, m_total = hc_b + yc_b;
        char* r = take(a_total > m_total ? a_total : m_total);
        p.q = (bf16*)r; p.kf = (bf16*)(r + q_b); p.vt = (bf16*)(r + q_b + kf_b);
        p.yc = (bf16*)r;
        p.yc1 = p.z; p.hc = p.cat; p.hc1 = (bf16*)((char*)p.cat + hc_b);
        if (yc_b > al256((size_t)NTOK * ZW * 2) || 2 * hc_b > al256((size_t)NTOK * DM * 2) || yc_b > a_total) { fprintf(stderr, "MoE buffers do not fit\n"); return; }
    }
    if (off > ws_size) { fprintf(stderr, "workspace too small: need %zu have %zu\n", off, ws_size); return; }

    static int configured = 0;
    if (!configured) { hipFuncSetAttribute((const void*)mega_kernel, hipFuncAttributeMaxDynamicSharedMemorySize, SMEM_BYTES); configured = 1; }
    int dev = 0, cus = 0; hipGetDevice(&dev); hipDeviceGetAttribute(&cus, hipDeviceAttributeMultiprocessorCount, dev);
    if (cus <= 0) cus = 256;
    hipMemsetAsync(d_ws, 0, zero_bytes, stream);
    hipLaunchKernelGGL(mega_kernel, dim3(cus), dim3(512), SMEM_BYTES, stream, p);
}
```

```cpp
#include <hip/hip_runtime.h>
#include <stdint.h>
#include <string.h>
#include <stdio.h>

#define DM 1024
#define NB 8
#define SEQL 8192
#define CTXL 256
#define SQ 8448
#define NTOK (NB * SQ)
#define NCH 132
#define NROW (NB * NCH)
#define NROWP 1152
#define NIN 1712
#define NINP 1792
#define ZW 1440
#define Z_QC 0
#define Z_KVC 256
#define Z_KR 384
#define Z_MLQ 416
#define Z_MLV 928
#define Z_MLO 1184
#define NUNIT (NB * 4 * 2 * NCH)
#define CLOC_STRIDE (65 * 64)
#define MOE_BM 128
#define MOE_TILES 722
#define MOE_SLOTS (MOE_TILES * MOE_BM)
#define UPU_STRIDE 384
#define ALPHA_DN 1.41421356237f
#define LN_EPS 1e-5f
#define QSCALE (0.10206207261596577f * 1.4426950408889634f)
#define LOG2E 1.4426950408889634f

typedef unsigned short bf16;
typedef short bf16x8 __attribute__((ext_vector_type(8)));
typedef float f32x16 __attribute__((ext_vector_type(16)));
typedef float f32x4 __attribute__((ext_vector_type(4)));
typedef unsigned u32x4 __attribute__((ext_vector_type(4)));
typedef unsigned u32x2 __attribute__((ext_vector_type(2)));

#define MFMA32(a, b, c) __builtin_amdgcn_mfma_f32_32x32x16_bf16((a), (b), (c), 0, 0, 0)
__device__ __forceinline__ int otid() { int t = (int)threadIdx.x; asm volatile("" : "+v"(t)); return t; }

typedef __bf16 bf2_t __attribute__((ext_vector_type(2)));
typedef float f2_t __attribute__((ext_vector_type(2)));
__device__ __forceinline__ unsigned pk2(float lo, float hi) { f2_t v = {lo, hi}; bf2_t b = __builtin_convertvector(v, bf2_t); return __builtin_bit_cast(unsigned, b); }
__device__ __forceinline__ bf16 f2bf(float x) { return (bf16)(pk2(x, 0.f) & 0xffffu); }
__device__ __forceinline__ float bf2f(bf16 x) { return __uint_as_float(((unsigned)x) << 16); }
__device__ __forceinline__ float bflo(unsigned u) { return __uint_as_float(u << 16); }
__device__ __forceinline__ float bfhi(unsigned u) { return __uint_as_float(u & 0xffff0000u); }
__device__ __forceinline__ float fexp2(float x) { return __builtin_amdgcn_exp2f(x); }
__device__ __forceinline__ float fexp(float x) { return __builtin_amdgcn_exp2f(x * LOG2E); }
__device__ __forceinline__ float frcp(float x) { return __builtin_amdgcn_rcpf(x); }
__device__ __forceinline__ float sigmoidf_(float x) { return frcp(1.f + fexp(-x)); }
__device__ __forceinline__ float siluf_(float x) { return x * sigmoidf_(x); }
__device__ __forceinline__ float gelu_tanh(float x) {
    const float u = 0.7978845608028654f * (x + 0.044715f * x * x * x);
    const float t = 1.f - 2.f * frcp(fexp(2.f * u) + 1.f);
    return 0.5f * x * (1.f + t);
}
template <int CTRL, int RM> __device__ __forceinline__ float dppf(float ident, float v) {
    return __int_as_float(__builtin_amdgcn_update_dpp(__float_as_int(ident), __float_as_int(v), CTRL, RM, 0xf, false));
}
template <int CTRL, int RM> __device__ __forceinline__ int dppi(int ident, int v) { return __builtin_amdgcn_update_dpp(ident, v, CTRL, RM, 0xf, false); }
__device__ __forceinline__ float dpp_scan_sum(float v) {
    v += dppf<0x111, 0xf>(0.f, v); v += dppf<0x112, 0xf>(0.f, v); v += dppf<0x114, 0xf>(0.f, v); v += dppf<0x118, 0xf>(0.f, v);
    v += dppf<0x142, 0xa>(0.f, v); v += dppf<0x143, 0xc>(0.f, v);
    return v;
}
__device__ __forceinline__ float dpp_scan_max(float v) {
    const float NI = -__builtin_inff();
    v = fmaxf(v, dppf<0x111, 0xf>(NI, v)); v = fmaxf(v, dppf<0x112, 0xf>(NI, v)); v = fmaxf(v, dppf<0x114, 0xf>(NI, v)); v = fmaxf(v, dppf<0x118, 0xf>(NI, v));
    v = fmaxf(v, dppf<0x142, 0xa>(NI, v)); v = fmaxf(v, dppf<0x143, 0xc>(NI, v));
    return v;
}
__device__ __forceinline__ float readlane_f(float v, int l) { return __int_as_float(__builtin_amdgcn_readlane(__float_as_int(v), l)); }
__device__ __forceinline__ float wave_sum(float v) { return readlane_f(dpp_scan_sum(v), 63); }
__device__ __forceinline__ float wave_max(float v) { return readlane_f(dpp_scan_max(v), 63); }

#define XB_TMO      128
#define XB_XCNT(j)  (256  + 64 * (j))
#define XB_XSUB(j)  (1280 + 64 * (j))
#define XB_XGEN(j)  (2304 + 64 * (j))
#define XB_TOP      3328
#define XB_TOPGEN   3392
#define XCD_BAR_WORDS 3456
#define XB_SPIN_CAP (1u << 21)
#define LAS __attribute__((address_space(3)))

__device__ __forceinline__ unsigned xb_ld(unsigned* p)              { return __hip_atomic_load(p, __ATOMIC_RELAXED, __HIP_MEMORY_SCOPE_AGENT); }
__device__ __forceinline__ unsigned xb_add(unsigned* p, unsigned v) { return __hip_atomic_fetch_add(p, v, __ATOMIC_RELAXED, __HIP_MEMORY_SCOPE_AGENT); }
__device__ __forceinline__ unsigned xb_xcc_id() { return (unsigned)__builtin_amdgcn_s_getreg((3 << 11) | 20) & 0xFu; }
#define XB_SPIN(cond, bar) do { unsigned _sp = 0; while (cond) { __builtin_amdgcn_s_sleep(1); \
    if ((++_sp & 255u) == 0u) { if (xb_ld(&(bar)[XB_TMO])) break; if (_sp > XB_SPIN_CAP) { atomicAdd(&(bar)[XB_TMO], 1u); break; } } } } while (0)

struct XcdBarrier { unsigned* bar; unsigned x; volatile LAS unsigned* st; };

__device__ __forceinline__ XcdBarrier xcd_barrier_post(unsigned* bar, volatile LAS unsigned* st) {
    XcdBarrier b; b.bar = bar; b.x = xb_xcc_id(); b.st = st;
    if (threadIdx.x == 0) (void)xb_add(&bar[XB_XCNT(b.x)], 1u);
    return b;
}
__device__ __forceinline__ void xcd_barrier_complete(unsigned* bar, unsigned x, unsigned& nloc, unsigned& nx) {
    const unsigned G = gridDim.x * gridDim.y * gridDim.z;
    unsigned sum, cnt, mine, sp = 0u;
    for (;;) {
        sum = 0u; cnt = 0u; mine = 0u;
#pragma unroll
        for (unsigned j = 0; j < 16; ++j) { const unsigned c = xb_ld(&bar[XB_XCNT(j)]); sum += c; cnt += (c > 0u) ? 1u : 0u; mine = (j == x) ? c : mine; }
        if (sum == G) break;
        __builtin_amdgcn_s_sleep(1);
        if ((++sp & 255u) == 0u) { if (xb_ld(&bar[XB_TMO])) break; if (sp > XB_SPIN_CAP) { atomicAdd(&bar[XB_TMO], 1u); break; } }
    }
    nloc = mine > 0u ? mine : 1u; nx = cnt > 0u ? cnt : 1u;
}
__device__ __forceinline__ void xcd_barrier(const XcdBarrier& b) {
    asm volatile("s_waitcnt vmcnt(0)" ::: "memory");
    __syncthreads();
    if (threadIdx.x == 0) {
        unsigned* bar = b.bar;
        __builtin_amdgcn_s_waitcnt(0);
        const unsigned bx = xb_xcc_id();
        unsigned nloc = b.st[0], nx = b.st[1];
        if (nloc == 0u) { xcd_barrier_complete(bar, bx, nloc, nx); b.st[0] = nloc; b.st[1] = nx; }
        const unsigned old = xb_add(&bar[XB_XSUB(bx)], 1u);
        const unsigned gen = old / nloc;
        if (old + 1u == (gen + 1u) * nloc) {
            __builtin_amdgcn_fence(__ATOMIC_RELEASE, "agent");
            asm volatile("s_waitcnt vmcnt(0)" ::: "memory");
            const unsigned og = xb_add(&bar[XB_TOP], 1u);
            const unsigned tg = og / nx;
            if (og + 1u == (tg + 1u) * nx) xb_add(&bar[XB_TOPGEN], 1u);
            else XB_SPIN(xb_ld(&bar[XB_TOPGEN]) == tg, bar);
            __builtin_amdgcn_fence(__ATOMIC_ACQUIRE, "agent");
            xb_add(&bar[XB_XGEN(bx)], 1u);
            asm volatile("s_waitcnt vmcnt(0)" ::: "memory");
        } else {
            XB_SPIN(xb_ld(&bar[XB_XGEN(bx)]) == gen, bar);
            __builtin_amdgcn_fence(__ATOMIC_ACQUIRE, "agent");
            asm volatile("s_waitcnt vmcnt(0)" ::: "memory");
        }
    }
    __syncthreads();
}

struct Params {
    const float *x, *c, *ctx, *c_ctx, *ada_w, *ada_b, *w_in, *lam_re, *lam_im, *log_step, *b_re, *b_im, *c_re, *c_im, *s5_d, *glu_w, *glu_b;
    const float *q_norm, *w_q_up, *kv_norm, *w_kv_up, *conv_w, *conv_b, *gate_b, *ml_norm_g, *w_out, *ln1_g, *ln1_b, *ln2_g, *ln2_b;
    const float *router_w, *router_bias, *ew_gate, *ew_up, *ew_down, *sw_gate, *sw_up, *sw_down;
    float* out;
    unsigned* bar; unsigned* ctr; int* moe_cnt;
    float *modv, *rope_tab, *klag, *pw, *bbar, *ctxres, *gates, *rq, *rkv, *mlstat;
    bf16 *bt_in, *bt_q, *bt_kv, *bt_glu, *bt_out, *bt_rhi, *bt_rlo, *bt_up, *bt_dn;
    bf16 *wg, *eg, *gg;
    bf16 *h;
    bf16 *qkc, *cloc;
    bf16 *z;
    bf16 *cat;
    bf16 *ug, *sin_; float* ff; bf16* gs;
    float* logits; int *tope, *pos, *tokslot, *slottok, *tile_e, *ntb, *xl_tile, *xl_cnt, *up_e, *up_row, *up_n; float *gatew, *slotgate;
    bf16 *q, *kf, *vt;
    bf16 *hc, *yc, *hc1, *yc1;
};

template <class F>
__device__ __forceinline__ void run_items(unsigned* ctr, int total, int* s_item, F&& f) {
    for (;;) {
        __syncthreads();
        if (threadIdx.x == 0) *s_item = (int)atomicAdd(ctr, 1u);
        __syncthreads();
        const int it = *s_item;
        if (it >= total) break;
        f(it);
    }
}

#define XL_STRIDE 672
template <class F>
__device__ __forceinline__ void run_items_xcd(unsigned* ctr8, const int* cnt8, int mult, int myx, int* s_item, F&& f) {
    for (int k = 0; k < 8; ++k) {
        const int x = (myx + k) & 7;
        const int total = cnt8[x] * mult;
        for (;;) {
            __syncthreads();
            if (threadIdx.x == 0) *s_item = (int)atomicAdd(ctr8 + x, 1u);
            __syncthreads();
            const int it = *s_item;
            if (it >= total) break;
            f(x, it);
        }
    }
}

struct Seg { const bf16* A; const bf16* B; int lda, ldb, K; };
#define GEMM_ROWB 144
#define STG_ROWB 144

template <int BM, int NSEG, int BN = 128, class Epi>
__device__ __forceinline__ void gemm_tile(const Seg (&seg)[NSEG], const int* __restrict__ rowidx, int m0, int n0, const Epi& epi, char* smem) {
    constexpr int AI = BM / 64, BI = BN / 64, WNW = BN / 64, WMW = 8 / WNW, WM = BM / WMW, MI = WM / 32;
    constexpr int BUFB = (BM + BN) * GEMM_ROWB;
    const int tid = otid(), lane = tid & 63, wave = tid >> 6;
    const int kc = tid & 7, r0 = tid >> 3;
    const int wm = wave / WNW, wn = wave % WNW;
    int arow[AI];
#pragma unroll
    for (int i = 0; i < AI; ++i) { const int r = m0 + r0 + 64 * i; arow[i] = rowidx ? rowidx[r] : r; }
    int total = 0;
#pragma unroll
    for (int s = 0; s < NSEG; ++s) total += seg[s].K >> 6;
    u32x4 ra0[AI], rb0[BI], ra1[AI], rb1[BI];
    const bf16* cA = seg[0].A; const bf16* cB = seg[0].B; int clda = seg[0].lda, cldb = seg[0].ldb, cnk = seg[0].K >> 6, ckt = 0, cs = 0;
    auto gload = [&](u32x4 (&ra)[AI], u32x4 (&rb)[BI]) {
        const int ko = ckt * 64 + kc * 8;
#pragma unroll
        for (int i = 0; i < AI; ++i) ra[i] = *(const u32x4*)(cA + (size_t)arow[i] * clda + ko);
#pragma unroll
        for (int i = 0; i < BI; ++i) rb[i] = *(const u32x4*)(cB + (size_t)(n0 + r0 + 64 * i) * cldb + ko);
        ++ckt;
        if (ckt == cnk) {
            ++cs; ckt = 0;
            if (NSEG > 1 && cs == 1) { cA = seg[NSEG > 1 ? 1 : 0].A; cB = seg[NSEG > 1 ? 1 : 0].B; clda = seg[NSEG > 1 ? 1 : 0].lda; cldb = seg[NSEG > 1 ? 1 : 0].ldb; cnk = seg[NSEG > 1 ? 1 : 0].K >> 6; }
            if (NSEG > 2 && cs == 2) { cA = seg[NSEG > 2 ? 2 : 0].A; cB = seg[NSEG > 2 ? 2 : 0].B; clda = seg[NSEG > 2 ? 2 : 0].lda; cldb = seg[NSEG > 2 ? 2 : 0].ldb; cnk = seg[NSEG > 2 ? 2 : 0].K >> 6; }
        }
    };
    auto lstore = [&](int buf, const u32x4 (&ra)[AI], const u32x4 (&rb)[BI]) {
        char* base = smem + buf * BUFB;
#pragma unroll
        for (int i = 0; i < AI; ++i) *(u32x4*)(base + (r0 + 64 * i) * GEMM_ROWB + kc * 16) = ra[i];
#pragma unroll
        for (int i = 0; i < BI; ++i) *(u32x4*)(base + (BM + r0 + 64 * i) * GEMM_ROWB + kc * 16) = rb[i];
    };
    f32x16 acc[MI][2];
#pragma unroll
    for (int i = 0; i < MI; ++i)
#pragma unroll
        for (int j = 0; j < 2; ++j)
#pragma unroll
            for (int q = 0; q < 16; ++q) acc[i][j][q] = 0.f;
    auto compute = [&](int buf) {
        const char* base = smem + buf * BUFB;
        const char* pa = base + (wm * WM + (lane & 31)) * GEMM_ROWB + (lane >> 5) * 16;
        const char* pb = base + (BM + wn * 64 + (lane & 31)) * GEMM_ROWB + (lane >> 5) * 16;
#pragma unroll
        for (int ks = 0; ks < 4; ++ks) {
            bf16x8 af[MI], bfr[2];
#pragma unroll
            for (int i = 0; i < MI; ++i) af[i] = *(const bf16x8*)(pa + i * 32 * GEMM_ROWB + ks * 32);
#pragma unroll
            for (int j = 0; j < 2; ++j) bfr[j] = *(const bf16x8*)(pb + j * 32 * GEMM_ROWB + ks * 32);
#pragma unroll
            for (int i = 0; i < MI; ++i)
#pragma unroll
                for (int j = 0; j < 2; ++j) acc[i][j] = MFMA32(bfr[j], af[i], acc[i][j]);
        }
    };
    gload(ra0, rb0);
    if (total > 1) gload(ra1, rb1);
    __syncthreads();
    lstore(0, ra0, rb0);
    if (total > 2) gload(ra0, rb0);
    __syncthreads();
    for (int t = 0; t < total; t += 2) {
        compute(0);
        if (t + 1 < total) lstore(1, ra1, rb1);
        if (t + 3 < total) gload(ra1, rb1);
        __syncthreads();
        if (t + 1 >= total) break;
        compute(1);
        if (t + 2 < total) lstore(0, ra0, rb0);
        if (t + 4 < total) gload(ra0, rb0);
        __syncthreads();
    }
    epi.template run<MI>(acc, m0 + wm * WM, n0 + wn * 64, lane);
}

#define ASTAT_SLAB (128 * GEMM_ROWB)
template <int KT, class Epi>
__device__ __forceinline__ void gemm_astat(const bf16* A, int lda, const int* __restrict__ rowidx, int m0, const bf16* B, int ldb, int NT, const Epi& epi, char* smem) {
    const int tid = otid(), lane = tid & 63, wave = tid >> 6;
    const int kc = tid & 7, r0 = tid >> 3;
    const int wm = wave >> 1, wn = wave & 1;
    char* sA = smem; char* sB = smem + KT * ASTAT_SLAB;
    {
        u32x4 ra[KT][2];
#pragma unroll
        for (int i = 0; i < 2; ++i) {
            const int r = m0 + r0 + 64 * i; const int gr = rowidx ? rowidx[r] : r;
#pragma unroll
            for (int kt = 0; kt < KT; ++kt) ra[kt][i] = *(const u32x4*)(A + (size_t)gr * lda + kt * 64 + kc * 8);
        }
        __syncthreads();
#pragma unroll
        for (int kt = 0; kt < KT; ++kt)
#pragma unroll
            for (int i = 0; i < 2; ++i) *(u32x4*)(sA + kt * ASTAT_SLAB + (r0 + 64 * i) * GEMM_ROWB + kc * 16) = ra[kt][i];
    }
    const int total = NT * KT;
    int gq = 0;
    constexpr int D = 4;
    u32x4 rb[D][2];
    auto gload = [&](u32x4 (&r)[2]) {
        const int nt = gq / KT, kt = gq - nt * KT;
#pragma unroll
        for (int i = 0; i < 2; ++i) r[i] = *(const u32x4*)(B + (size_t)(nt * 128 + r0 + 64 * i) * ldb + kt * 64 + kc * 8);
        ++gq;
    };
    auto lstore = [&](int buf, const u32x4 (&r)[2]) {
#pragma unroll
        for (int i = 0; i < 2; ++i) *(u32x4*)(sB + buf * ASTAT_SLAB + (r0 + 64 * i) * GEMM_ROWB + kc * 16) = r[i];
    };
    f32x16 acc[1][2];
#pragma unroll
    for (int j = 0; j < 2; ++j)
#pragma unroll
        for (int q = 0; q < 16; ++q) acc[0][j][q] = 0.f;
    auto compute = [&](int buf, int q) {
        const int nt = q / KT, kt = q - nt * KT;
        const char* pa = sA + kt * ASTAT_SLAB + (wm * 32 + (lane & 31)) * GEMM_ROWB + (lane >> 5) * 16;
        const char* pb = sB + buf * ASTAT_SLAB + (wn * 64 + (lane & 31)) * GEMM_ROWB + (lane >> 5) * 16;
#pragma unroll
        for (int ks = 0; ks < 4; ++ks) {
            const bf16x8 af = *(const bf16x8*)(pa + ks * 32);
#pragma unroll
            for (int j = 0; j < 2; ++j) { const bf16x8 bfr = *(const bf16x8*)(pb + j * 32 * GEMM_ROWB + ks * 32); acc[0][j] = MFMA32(bfr, af, acc[0][j]); }
        }
        if (kt == KT - 1) {
            epi.template run<1>(acc, m0 + wm * 32, nt * 128 + wn * 64, lane);
#pragma unroll
            for (int j = 0; j < 2; ++j)
#pragma unroll
                for (int qq = 0; qq < 16; ++qq) acc[0][j][qq] = 0.f;
        }
    };
#pragma unroll
    for (int i = 0; i < D; ++i) if (i < total) gload(rb[i]);
    lstore(0, rb[0]);
    if (D < total) gload(rb[0]);
    __syncthreads();
    for (int t = 0; t < total; t += D) {
#pragma unroll
        for (int u = 0; u < D; ++u) {
            const int q = t + u;
            if (q < total) {
                compute(u & 1, q);
                if (q + 1 < total) lstore((u + 1) & 1, rb[(u + 1) % D]);
                if (q + 1 + D < total) gload(rb[(u + 1) % D]);
                __syncthreads();
            }
        }
    }
}

template <int KT, bool FP8 = false>
__device__ __forceinline__ void gemm_astat256(const bf16* A, int lda, int m0, const bf16* B, int ldb, int NT, bf16* C, int ldc, char* smem) {
    const int tid = otid(), lane = tid & 63, wave = tid >> 6;
    const int kc = tid & 7, r0 = tid >> 3;
    const int wm = wave >> 2, wn = wave & 3;
    char* sA = smem; char* sB = smem + KT * ASTAT_SLAB;
    {
        u32x4 ra[KT][2];
#pragma unroll
        for (int i = 0; i < 2; ++i)
#pragma unroll
            for (int kt = 0; kt < KT; ++kt) ra[kt][i] = *(const u32x4*)(A + (size_t)(m0 + r0 + 64 * i) * lda + kt * 64 + kc * 8);
        __syncthreads();
#pragma unroll
        for (int kt = 0; kt < KT; ++kt)
#pragma unroll
            for (int i = 0; i < 2; ++i) *(u32x4*)(sA + kt * ASTAT_SLAB + (r0 + 64 * i) * GEMM_ROWB + kc * 16) = ra[kt][i];
    }
    const int total = NT * KT;
    int gq = 0;
    constexpr int D = 4;
    u32x4 rb[D][4];
    auto gload = [&](u32x4 (&r)[4]) {
        const int nt = gq / KT, kt = gq - nt * KT;
#pragma unroll
        for (int i = 0; i < 4; ++i) r[i] = *(const u32x4*)(B + (size_t)(nt * 256 + r0 + 64 * i) * ldb + kt * 64 + kc * 8);
        ++gq;
    };
    auto lstore = [&](int buf, const u32x4 (&r)[4]) {
#pragma unroll
        for (int i = 0; i < 4; ++i) *(u32x4*)(sB + buf * 2 * ASTAT_SLAB + (r0 + 64 * i) * GEMM_ROWB + kc * 16) = r[i];
    };
    f32x16 acc[2][2];
#pragma unroll
    for (int i = 0; i < 2; ++i)
#pragma unroll
        for (int j = 0; j < 2; ++j)
#pragma unroll
            for (int q = 0; q < 16; ++q) acc[i][j][q] = 0.f;
    auto compute = [&](int buf, int q) {
        const int nt = q / KT, kt = q - nt * KT;
        const char* pa = sA + kt * ASTAT_SLAB + (wm * 64 + (lane & 31)) * GEMM_ROWB + (lane >> 5) * 16;
        const char* pb = sB + buf * 2 * ASTAT_SLAB + (wn * 64 + (lane & 31)) * GEMM_ROWB + (lane >> 5) * 16;
#pragma unroll
        for (int ks = 0; ks < 4; ++ks) {
            bf16x8 af[2], bfr[2];
#pragma unroll
            for (int i = 0; i < 2; ++i) af[i] = *(const bf16x8*)(pa + i * 32 * GEMM_ROWB + ks * 32);
#pragma unroll
            for (int j = 0; j < 2; ++j) bfr[j] = *(const bf16x8*)(pb + j * 32 * GEMM_ROWB + ks * 32);
#pragma unroll
            for (int i = 0; i < 2; ++i)
#pragma unroll
                for (int j = 0; j < 2; ++j) acc[i][j] = MFMA32(bfr[j], af[i], acc[i][j]);
        }
        if (kt == KT - 1) {
            __syncthreads();
            char* st = sB + buf * 2 * ASTAT_SLAB + wave * (32 * STG_ROWB);
            if (FP8) {
#pragma unroll
                for (int i = 0; i < 2; ++i) {
#pragma unroll
                    for (int j = 0; j < 2; ++j)
#pragma unroll
                        for (int g = 0; g < 4; ++g) {
                            int w = 0;
                            w = __builtin_amdgcn_cvt_pk_fp8_f32(acc[i][j][4 * g] * 16.f, acc[i][j][4 * g + 1] * 16.f, w, false);
                            w = __builtin_amdgcn_cvt_pk_fp8_f32(acc[i][j][4 * g + 2] * 16.f, acc[i][j][4 * g + 3] * 16.f, w, true);
                            *(int*)(st + (lane & 31) * 80 + (j * 32 + 8 * g + 4 * (lane >> 5))) = w;
                        }
                    __builtin_amdgcn_wave_barrier();
#pragma unroll
                    for (int it = 0; it < 2; ++it) {
                        const int row = it * 16 + (lane >> 2), c4 = lane & 3;
                        const u32x4 v = *(const u32x4*)(st + row * 80 + c4 * 16);
                        *(u32x4*)((char*)C + (size_t)(m0 + wm * 64 + i * 32 + row) * ldc + nt * 256 + wn * 64 + c4 * 16) = v;
                    }
                    __builtin_amdgcn_wave_barrier();
                }
            } else
#pragma unroll
            for (int i = 0; i < 2; ++i) {
#pragma unroll
                for (int j = 0; j < 2; ++j)
#pragma unroll
                    for (int g = 0; g < 4; ++g) {
                        u32x2 v; v[0] = pk2(acc[i][j][4 * g], acc[i][j][4 * g + 1]); v[1] = pk2(acc[i][j][4 * g + 2], acc[i][j][4 * g + 3]);
                        *(u32x2*)(st + (lane & 31) * STG_ROWB + (j * 32 + 8 * g + 4 * (lane >> 5)) * 2) = v;
                    }
                __builtin_amdgcn_wave_barrier();
#pragma unroll
                for (int it = 0; it < 4; ++it) {
                    const int row = it * 8 + (lane >> 3), c8 = lane & 7;
                    const u32x4 v = *(const u32x4*)(st + row * STG_ROWB + c8 * 16);
                    *(u32x4*)(C + (size_t)(m0 + wm * 64 + i * 32 + row) * ldc + nt * 256 + wn * 64 + c8 * 8) = v;
                }
                __builtin_amdgcn_wave_barrier();
            }
#pragma unroll
            for (int i = 0; i < 2; ++i)
#pragma unroll
                for (int j = 0; j < 2; ++j)
#pragma unroll
                    for (int qq = 0; qq < 16; ++qq) acc[i][j][qq] = 0.f;
        }
    };
#pragma unroll
    for (int i = 0; i < D; ++i) if (i < total) gload(rb[i]);
    lstore(0, rb[0]);
    if (D < total) gload(rb[0]);
    __syncthreads();
    for (int t = 0; t < total; t += D) {
#pragma unroll
        for (int u = 0; u < D; ++u) {
            const int q = t + u;
            if (q < total) {
                compute(u & 1, q);
                if (q + 1 < total) lstore((u + 1) & 1, rb[(u + 1) % D]);
                if (q + 1 + D < total) gload(rb[(u + 1) % D]);
                __syncthreads();
            }
        }
    }
}

namespace g8 {
typedef float f32x4v __attribute__((ext_vector_type(4)));
constexpr int BK = 64, HALF = 128, HTB = HALF * BK * 2, STAGE_BYTES = 8 * HTB;
__device__ __forceinline__ int lds_byte(int r, int c) { const int st = (r >> 4) * 2 + (c >> 5), rr = r & 15, cc = c & 31, ob = rr * 64 + cc * 2; return st * 1024 + (ob ^ (((ob >> 9) & 1) << 5)); }
__device__ __forceinline__ void stage_rc(int b, int& R, int& C) { const int st = b / 1024, sb = b % 1024, swz = sb ^ (((sb >> 9) & 1) << 5); R = (st >> 1) * 16 + swz / 64; C = (st & 1) * 32 + (swz % 64) / 2; }
struct Unit { const char* A; const char* B; const int* rows; int pm, pn; };

template <bool GATHER, bool PERM = false, class Epi, class Sched>
__device__ __forceinline__ void gemm_phase(LAS unsigned char* lds, int K, const Sched& S, const Epi& E) {
    const int tid = otid(), wid = __builtin_amdgcn_readfirstlane(tid >> 6), lane = tid & 63, wr = wid >> 2, wc = wid & 3, fr = lane & 15, fq = lane >> 4;
    const int nt = K / BK;
    unsigned voffB[2];
#pragma unroll
    for (int i = 0; i < 2; ++i) { int R_, C_; stage_rc(tid * 16 + i * 8192, R_, C_);
        const int Rb = PERM ? ((R_ & ~31) + 8 * ((R_ & 15) >> 2) + 4 * ((R_ & 31) >> 4) + (R_ & 3)) : R_;
        voffB[i] = (unsigned)(Rb * K + C_) * 2u; }
    const size_t kstep = (size_t)(BK * 2);
    const size_t hstepB = (size_t)HALF * K * 2;
    const unsigned ldsw = (unsigned)wid * 1024u;
    const int aoff = lds_byte(wr * 64 + fr, fq * 8), boff = lds_byte(wc * 32 + fr, fq * 8);
#define G8_SA(b, h) (((b) * 2 + (h)) * HTB)
#define G8_SB(b, h) ((4 + (b) * 2 + (h)) * HTB)
#define G8_STAGE(bufoff, gbase, voff) do { _Pragma("unroll") for (int _i = 0; _i < 2; ++_i) \
        __builtin_amdgcn_global_load_lds((const unsigned*)((const char*)(gbase) + (voff)[_i]), (LAS unsigned*)(lds + (bufoff) + ldsw + _i * 8192), 16, 0, 0); } while (0)
#define G8_LDA(dst, b, h) do { _Pragma("unroll") for (int m = 0; m < 4; ++m) _Pragma("unroll") for (int k = 0; k < 2; ++k) dst[m][k] = *(const LAS bf16x8*)(lds + G8_SA(b, h) + aoff + m * 2048 + k * 1024); } while (0)
#define G8_LDB(dst, b, h) do { _Pragma("unroll") for (int n = 0; n < 2; ++n) _Pragma("unroll") for (int k = 0; k < 2; ++k) dst[n][k] = *(const LAS bf16x8*)(lds + G8_SB(b, h) + boff + n * 2048 + k * 1024); } while (0)
#define G8_MMA(ai, bj, At, Bt) do { __builtin_amdgcn_s_setprio(1); _Pragma("unroll") for (int m = 0; m < 4; ++m) _Pragma("unroll") for (int n = 0; n < 2; ++n) _Pragma("unroll") for (int k = 0; k < 2; ++k) \
        acc[ai][bj][m][n] = __builtin_amdgcn_mfma_f32_16x16x32_bf16(Bt[n][k], At[m][k], acc[ai][bj][m][n], 0, 0, 0); __builtin_amdgcn_s_setprio(0); } while (0)
#define G8_WAIT_V(n) asm volatile("s_waitcnt vmcnt(" #n ")" ::: "memory")
#define G8_WAIT_L(n) asm volatile("s_waitcnt lgkmcnt(" #n ")" ::: "memory")
#define G8_BAR __builtin_amdgcn_s_barrier()
#define G8_SCHED __builtin_amdgcn_sched_barrier(0)
    auto set_voffA = [&](const Unit& u, unsigned (&v)[2][2]) {
#pragma unroll
        for (int h2 = 0; h2 < 2; ++h2)
#pragma unroll
            for (int i = 0; i < 2; ++i) { int R_, C_; stage_rc(otid() * 16 + i * 8192, R_, C_); const int rr = h2 * HALF + R_; const int row = u.rows ? u.rows[rr] : rr; v[h2][i] = (unsigned)(row * K + C_) * 2u; }
    };
    Unit cur, nxt; int ui = 0;
    if (!S.next(0, cur)) return;
    f32x4v acc[2][2][4][2];
#pragma unroll
    for (int a = 0; a < 2; ++a)
#pragma unroll
        for (int b = 0; b < 2; ++b)
#pragma unroll
            for (int m = 0; m < 4; ++m)
#pragma unroll
                for (int n = 0; n < 2; ++n) acc[a][b][m][n] = (f32x4v){0.f, 0.f, 0.f, 0.f};
    bf16x8 At[4][2], B0[2][2], B1[2][2];
    unsigned vA[2][2], nvA[2][2];
    set_voffA(cur, vA);
    const char* cA = cur.A; const char* cB = cur.B;
    G8_STAGE(G8_SB(0, 0), cB, voffB); G8_STAGE(G8_SA(0, 0), cA, vA[0]); G8_STAGE(G8_SB(0, 1), cB + hstepB, voffB); G8_STAGE(G8_SA(0, 1), cA, vA[1]);
    if (wr == 1) G8_BAR;
    G8_WAIT_V(4); G8_BAR;
    G8_STAGE(G8_SB(1, 0), cB + kstep, voffB); G8_STAGE(G8_SA(1, 0), cA + kstep, vA[0]); G8_STAGE(G8_SB(1, 1), cB + hstepB + kstep, voffB);
    G8_WAIT_V(6); G8_BAR;
    for (;;) {
        const bool has_next = S.next(ui + 1, nxt);
        const char* nA = has_next ? nxt.A : cA; const char* nB = has_next ? nxt.B : cB;
        if (GATHER) {
            if (has_next) set_voffA(nxt, nvA);
            else {
#pragma unroll
                for (int h2 = 0; h2 < 2; ++h2)
#pragma unroll
                    for (int i = 0; i < 2; ++i) nvA[h2][i] = vA[h2][i];
            }
        }
        for (int t = 0; t < nt; t += 2) {
            const bool last = (t == nt - 2);
            const char* a1 = cA + (size_t)(t + 1) * kstep;
            const char* a2 = last ? nA : cA + (size_t)(t + 2) * kstep; const char* b2 = last ? nB : cB + (size_t)(t + 2) * kstep;
            const char* a3 = a2 + kstep; const char* b3 = b2 + kstep;
            G8_LDB(B0, 0, 0); G8_SCHED; G8_LDA(At, 0, 0); G8_STAGE(G8_SA(1, 1), a1, vA[1]);
            if (GATHER && last) {
#pragma unroll
                for (int h2 = 0; h2 < 2; ++h2)
#pragma unroll
                    for (int i = 0; i < 2; ++i) vA[h2][i] = nvA[h2][i];
            }
            G8_WAIT_L(8); G8_BAR; G8_WAIT_L(0); G8_MMA(0, 0, At, B0); G8_BAR; G8_SCHED;
            G8_LDB(B1, 0, 1); G8_STAGE(G8_SB(0, 0), b2, voffB);
            G8_BAR; G8_WAIT_L(0); G8_MMA(0, 1, At, B1); G8_BAR;
            G8_LDA(At, 0, 1); G8_STAGE(G8_SA(0, 0), a2, vA[0]);
            G8_BAR; G8_WAIT_L(0); G8_MMA(1, 0, At, B0); G8_BAR; G8_SCHED;
            G8_STAGE(G8_SB(0, 1), b2 + hstepB, voffB);
            G8_WAIT_V(6); G8_BAR; G8_MMA(1, 1, At, B1); G8_BAR;
            G8_LDB(B0, 1, 0); G8_SCHED; G8_LDA(At, 1, 0); G8_STAGE(G8_SA(0, 1), a2, vA[1]);
            G8_WAIT_L(8); G8_BAR; G8_WAIT_L(0); G8_MMA(0, 0, At, B0); G8_BAR; G8_SCHED;
            G8_LDB(B1, 1, 1); G8_STAGE(G8_SB(1, 0), b3, voffB);
            G8_BAR; G8_WAIT_L(0); G8_MMA(0, 1, At, B1); G8_BAR;
            G8_LDA(At, 1, 1); G8_STAGE(G8_SA(1, 0), a3, vA[0]);
            G8_BAR; G8_WAIT_L(0); G8_MMA(1, 0, At, B0); G8_BAR; G8_SCHED;
            G8_STAGE(G8_SB(1, 1), b3 + hstepB, voffB);
            G8_WAIT_V(6); G8_BAR; G8_MMA(1, 1, At, B1); G8_BAR;
        }
        E(acc, cur, wr, wc, fr, fq);
        if (!has_next) break;
#pragma unroll
        for (int a = 0; a < 2; ++a)
#pragma unroll
            for (int b = 0; b < 2; ++b)
#pragma unroll
                for (int m = 0; m < 4; ++m)
#pragma unroll
                    for (int n = 0; n < 2; ++n) acc[a][b][m][n] = (f32x4v){0.f, 0.f, 0.f, 0.f};
        cur = nxt; cA = nA; cB = nB; ++ui;
    }
    G8_WAIT_V(0);
    if (wr == 0) G8_BAR;
    G8_BAR;
#undef G8_SA
#undef G8_SB
#undef G8_STAGE
#undef G8_LDA
#undef G8_LDB
#undef G8_MMA
#undef G8_WAIT_V
#undef G8_WAIT_L
#undef G8_BAR
#undef G8_SCHED
}
struct GridOrder {
    const char* A; const char* Bt; int K, nM, nN, nwg, G, c, skipctx;
    __device__ __forceinline__ bool next(int i, Unit& u) const {
        const long L = (long)i * G + c; if (L >= nwg) return false;
        int wgid = (int)L; { const int q = nwg / 8, r = nwg % 8, xcd = wgid % 8, off = wgid / 8; wgid = (xcd < r ? xcd * (q + 1) : r * (q + 1) + (xcd - r) * q) + off; }
        const int nig = 8 * nN, gid = wgid / nig, fm = gid * 8, gsz = (nM - fm) < 8 ? (nM - fm) : 8;
        u.pm = fm + ((wgid % nig) % gsz); u.pn = (wgid % nig) / gsz;
        if (skipctx) u.pm = (u.pm >> 5) * 33 + 1 + (u.pm & 31);
        u.A = A + (size_t)u.pm * 256 * K * 2; u.B = Bt + (size_t)u.pn * 256 * K * 2; u.rows = nullptr; return true;
    }
};
}

#define EPI_FOR(MI)                                                                                   \
    _Pragma("unroll") for (int i_ = 0; i_ < MI; ++i_)                                                 \
    _Pragma("unroll") for (int j_ = 0; j_ < 2; ++j_)                                                  \
    _Pragma("unroll") for (int g_ = 0; g_ < 4; ++g_)
#define EPI_M (mb + i_ * 32 + (lane & 31))
#define EPI_N (nb + j_ * 32 + 8 * g_ + 4 * (lane >> 5))
#define EPI_V(q) (acc[i_][j_][4 * g_ + (q)])

__device__ __forceinline__ void st_bf4(bf16* p, float a, float b, float c, float d) { u32x2 v; v[0] = pk2(a, b); v[1] = pk2(c, d); *(u32x2*)p = v; }
template <int MI>
__device__ __forceinline__ void stage_store_bf16(f32x16 (&acc)[MI][2], char* stg, bf16* C, int ldc, int mb, int nb, int lane) {
#pragma unroll
    for (int i = 0; i < MI; ++i)
#pragma unroll
        for (int j = 0; j < 2; ++j)
#pragma unroll
            for (int g = 0; g < 4; ++g) {
                u32x2 v; v[0] = pk2(acc[i][j][4 * g], acc[i][j][4 * g + 1]); v[1] = pk2(acc[i][j][4 * g + 2], acc[i][j][4 * g + 3]);
                *(u32x2*)(stg + (i * 32 + (lane & 31)) * STG_ROWB + (j * 32 + 8 * g + 4 * (lane >> 5)) * 2) = v;
            }
    __builtin_amdgcn_wave_barrier();
#pragma unroll
    for (int it = 0; it < MI * 4; ++it) {
        const int row = it * 8 + (lane >> 3), ch = lane & 7;
        const u32x4 v = *(const u32x4*)(stg + row * STG_ROWB + ch * 16);
        *(u32x4*)(C + (size_t)(mb + row) * ldc + nb + ch * 8) = v;
    }
    __builtin_amdgcn_wave_barrier();
}
struct EpiBf16Stg {
    bf16* C; int ldc; char* stg;
    template <int MI> __device__ __forceinline__ void run(f32x16 (&acc)[MI][2], int mb, int nb, int lane) const {
        const int wave = otid() >> 6;
        stage_store_bf16<MI>(acc, stg + wave * (MI * 32 * STG_ROWB), C, ldc, mb, nb, lane);
    }
};

struct EpiInproj {
    bf16* ug; bf16* z; float* gates; char* stg;
    template <int MI> __device__ __forceinline__ void run(f32x16 (&acc)[MI][2], int mb, int nb, int lane) const {
        if (nb >= 256 && nb + 64 <= 1696) { stage_store_bf16<MI>(acc, stg + (otid() >> 6) * (MI * 32 * STG_ROWB), z, ZW, mb, nb - 256, lane); return; }
        EPI_FOR(MI) {
            const int m = EPI_M, n = EPI_N;
            const float v0 = EPI_V(0), v1 = EPI_V(1), v2 = EPI_V(2), v3 = EPI_V(3);
            if (n < 256) {
                const int g = n >> 4, cc = n & 15, b = m / SQ, s = m - b * SQ;
                const int row = b * NCH + (s >> 6), j = s & 63;
                st_bf4(ug + ((size_t)g * NROWP + row) * 1024 + j * 16 + cc, v0, v1, v2, v3);
            } else if (n < 1696) {
                st_bf4(z + (size_t)m * ZW + (n - 256), v0, v1, v2, v3);
            } else if (n < 1712) {
                f32x4 v = {v0, v1, v2, v3};
                *(f32x4*)(gates + (size_t)m * 16 + (n - 1696)) = v;
            }
        }
    }
};
struct EpiRouterSum {
    float* C; char* stg;
    template <int MI> __device__ __forceinline__ void run(f32x16 (&acc)[MI][2], int mb, int nb, int lane) const {
        float* st = (float*)stg + (otid() >> 7) * (MI * 2 * 16 * 64);
        if (nb >= 64) {
#pragma unroll
            for (int i = 0; i < MI; ++i)
#pragma unroll
                for (int j = 0; j < 2; ++j)
#pragma unroll
                    for (int q = 0; q < 16; ++q) st[((i * 2 + j) * 16 + q) * 64 + lane] = acc[i][j][q];
        }
        __syncthreads();
        if (nb < 64) {
#pragma unroll
            for (int i = 0; i < MI; ++i)
#pragma unroll
                for (int j = 0; j < 2; ++j)
#pragma unroll
                    for (int q = 0; q < 16; ++q) acc[i][j][q] += st[((i * 2 + j) * 16 + q) * 64 + lane];
            EPI_FOR(MI) {
                const int m = EPI_M, n = EPI_N;
                if (m < NTOK) { f32x4 v = {EPI_V(0), EPI_V(1), EPI_V(2), EPI_V(3)}; *(f32x4*)(C + (size_t)m * 64 + n) = v; }
            }
        }
    }
};
struct EpiF32 {
    float* C; int ldc, mvalid, nvalid;
    template <int MI> __device__ __forceinline__ void run(f32x16 (&acc)[MI][2], int mb, int nb, int lane) const {
        EPI_FOR(MI) {
            const int m = EPI_M, n = EPI_N;
            if (m < mvalid && n < nvalid) { f32x4 v = {EPI_V(0), EPI_V(1), EPI_V(2), EPI_V(3)}; *(f32x4*)(C + (size_t)m * ldc + n) = v; }
        }
    }
};
struct EpiBf16 {
    bf16* C; int ldc;
    template <int MI> __device__ __forceinline__ void run(f32x16 (&acc)[MI][2], int mb, int nb, int lane) const {
        EPI_FOR(MI) { st_bf4(C + (size_t)EPI_M * ldc + EPI_N, EPI_V(0), EPI_V(1), EPI_V(2), EPI_V(3)); }
    }
};
struct EpiS5Y {
    bf16* gs; int g;
    template <int MI> __device__ __forceinline__ void run(f32x16 (&acc)[MI][2], int mb, int nb, int lane) const {
        EPI_FOR(MI) {
            const int m = EPI_M, n = EPI_N;
            if (m < NROW) {
                const int b = m / NCH, c = m - b * NCH, i = n >> 4, cc = n & 15;
                const size_t tok = (size_t)b * SQ + c * 64 + i;
                st_bf4(gs + tok * 256 + g * 16 + cc, gelu_tanh(EPI_V(0)), gelu_tanh(EPI_V(1)), gelu_tanh(EPI_V(2)), gelu_tanh(EPI_V(3)));
            }
        }
    }
};
struct EpiGlu {
    const bf16* gs; const float* bias; bf16* cat; char* stg;
    template <int MI> __device__ __forceinline__ void run(f32x16 (&acc)[MI][2], int mb, int nb, int lane) const {
        EPI_FOR(MI) {
            const int m = EPI_M, n = EPI_N;
            const u32x2 gv = *(const u32x2*)(gs + (size_t)m * 256 + n);
            const f32x4 bv = *(const f32x4*)(bias + n);
            acc[i_][j_][4 * g_] = bflo(gv[0]) * sigmoidf_(EPI_V(0) + bv[0]); acc[i_][j_][4 * g_ + 1] = bfhi(gv[0]) * sigmoidf_(EPI_V(1) + bv[1]);
            acc[i_][j_][4 * g_ + 2] = bflo(gv[1]) * sigmoidf_(EPI_V(2) + bv[2]); acc[i_][j_][4 * g_ + 3] = bfhi(gv[1]) * sigmoidf_(EPI_V(3) + bv[3]);
        }
        stage_store_bf16<MI>(acc, stg + (otid() >> 6) * (MI * 32 * STG_ROWB), cat, 1024, mb, nb, lane);
    }
};
struct EpiQ {
    const float* rq; const float* tab; bf16* q; char* stg;
    template <int MI> __device__ __forceinline__ void run(f32x16 (&acc)[MI][2], int mb, int nb, int lane) const {
        EPI_FOR(MI) {
            const int m = EPI_M, n = EPI_N;
            const int b = m / SQ, s = m - b * SQ, hd = n / 96, d = n - hd * 96;
            const float sc = rq[m] * QSCALE;
            float v0 = EPI_V(0) * sc, v1 = EPI_V(1) * sc, v2 = EPI_V(2) * sc, v3 = EPI_V(3) * sc;
            if (d >= 64 && s >= CTXL) {
                const int r = d - 64, ax = r >> 4, i0 = (r & 15) >> 1, sl = s - CTXL;
                const int pos = ax ? (sl & 63) : (sl >> 6);
                const f32x4 cs = *(const f32x4*)(tab + (pos * 8 + i0) * 2);
                const float a0 = v0 * cs[0] - v1 * cs[1], a1 = v0 * cs[1] + v1 * cs[0];
                const float a2 = v2 * cs[2] - v3 * cs[3], a3 = v2 * cs[3] + v3 * cs[2];
                v0 = a0; v1 = a1; v2 = a2; v3 = a3;
            }
            acc[i_][j_][4 * g_] = v0; acc[i_][j_][4 * g_ + 1] = v1; acc[i_][j_][4 * g_ + 2] = v2; acc[i_][j_][4 * g_ + 3] = v3;
        }
        stage_store_bf16<MI>(acc, stg + (otid() >> 6) * (MI * 32 * STG_ROWB), q, 768, mb, nb, lane);
    }
};
struct EpiKV {
    const float* rkv; bf16* kf; bf16* vt; char* stg;
    template <int MI> __device__ __forceinline__ void run(f32x16 (&acc)[MI][2], int mb, int nb, int lane) const {
        const int hd = nb >> 7;
        if ((nb & 64) == 0) {
            const int b = mb / SQ, s0 = mb - b * SQ;
            EPI_FOR(MI) { const float sc = rkv[EPI_M]; acc[i_][j_][4 * g_] *= sc; acc[i_][j_][4 * g_ + 1] *= sc; acc[i_][j_][4 * g_ + 2] *= sc; acc[i_][j_][4 * g_ + 3] *= sc; }
            stage_store_bf16<MI>(acc, stg + (otid() >> 6) * (MI * 32 * STG_ROWB), kf + (size_t)(b * 8 + hd) * SQ * 96, 96, s0, 0, lane);
            return;
        }
        EPI_FOR(MI) {
            const int m = EPI_M, n = EPI_N;
            const int b = m / SQ, s = m - b * SQ, d2 = n & 127;
            const float sc = rkv[m];
            const float v0 = EPI_V(0) * sc, v1 = EPI_V(1) * sc, v2 = EPI_V(2) * sc, v3 = EPI_V(3) * sc;
            bf16* p = vt + ((size_t)(b * 8 + hd) * 64 + (d2 - 64)) * SQ + s;
            p[0] = f2bf(v0); p[SQ] = f2bf(v1); p[2 * SQ] = f2bf(v2); p[3 * SQ] = f2bf(v3);
        }
    }
};
struct EpiMoeUp {
    const float* slotgate; bf16* hc; char* stg;
    template <int MI> __device__ __forceinline__ void run(f32x16 (&acc)[MI][2], int mb, int nb, int lane) const {
        char* st = stg + (otid() >> 6) * (MI * 32 * 80);
#pragma unroll
        for (int i_ = 0; i_ < MI; ++i_)
#pragma unroll
            for (int g_ = 0; g_ < 4; ++g_) {
                const int rl = i_ * 32 + (lane & 31);
                const float gw = slotgate[mb + rl];
                float o[4];
#pragma unroll
                for (int q = 0; q < 4; ++q) o[q] = gw * siluf_(acc[i_][0][4 * g_ + q]) * acc[i_][1][4 * g_ + q];
                u32x2 v; v[0] = pk2(o[0], o[1]); v[1] = pk2(o[2], o[3]);
                *(u32x2*)(st + rl * 80 + (8 * g_ + 4 * (lane >> 5)) * 2) = v;
            }
        __builtin_amdgcn_wave_barrier();
#pragma unroll
        for (int it = 0; it < MI * 2; ++it) {
            const int row = it * 16 + (lane >> 2), ch = lane & 3;
            const u32x4 v = *(const u32x4*)(st + row * 80 + ch * 16);
            *(u32x4*)(hc + (size_t)(mb + row) * 256 + (nb >> 1) + ch * 8) = v;
        }
        __builtin_amdgcn_wave_barrier();
    }
};

struct EpiInproj8 {
    bf16* ug; bf16* z; float* gates;
    __device__ __forceinline__ void operator()(const g8::f32x4v (&acc)[2][2][4][2], const g8::Unit& u, int wr, int wc, int fr, int fq) const {
#pragma unroll
        for (int ai = 0; ai < 2; ++ai)
#pragma unroll
            for (int mm = 0; mm < 4; ++mm) {
                const int m = u.pm * 256 + 128 * ai + 64 * wr + 16 * mm + fr;
                const int b = m / SQ, s = m - b * SQ;
#pragma unroll
                for (int bj = 0; bj < 2; ++bj) {
                    const int n = u.pn * 256 + 128 * bj + 32 * wc + 8 * fq;
                    const g8::f32x4v a = acc[ai][bj][mm][0], c = acc[ai][bj][mm][1];
                    if (n < 1696) {
                        u32x4 o = {pk2(a[0], a[1]), pk2(a[2], a[3]), pk2(c[0], c[1]), pk2(c[2], c[3])};
                        if (n < 256) {
                            const int g = n >> 4, cc = n & 15, row = b * NCH + (s >> 6), j = s & 63;
                            *(u32x4*)(ug + ((size_t)g * NROWP + row) * 1024 + j * 16 + cc) = o;
                        } else *(u32x4*)(z + (size_t)m * ZW + (n - 256)) = o;
                    } else if (n < 1712) {
                        f32x4 w0 = {a[0], a[1], a[2], a[3]}, w1 = {c[0], c[1], c[2], c[3]};
                        *(f32x4*)(gates + (size_t)m * 16 + (n - 1696)) = w0; *(f32x4*)(gates + (size_t)m * 16 + (n - 1696) + 4) = w1;
                    }
                }
            }
    }
};
struct EpiBf16_8 {
    bf16* C; int ldc;
    __device__ __forceinline__ void operator()(const g8::f32x4v (&acc)[2][2][4][2], const g8::Unit& u, int wr, int wc, int fr, int fq) const {
#pragma unroll
        for (int ai = 0; ai < 2; ++ai)
#pragma unroll
            for (int mm = 0; mm < 4; ++mm) {
                bf16* rowp = C + (size_t)(u.pm * 256 + 128 * ai + 64 * wr + 16 * mm + fr) * ldc + u.pn * 256 + 32 * wc + 8 * fq;
#pragma unroll
                for (int bj = 0; bj < 2; ++bj) {
                    const g8::f32x4v a = acc[ai][bj][mm][0], b = acc[ai][bj][mm][1];
                    u32x4 o = {pk2(a[0], a[1]), pk2(a[2], a[3]), pk2(b[0], b[1]), pk2(b[2], b[3])};
                    *(u32x4*)(rowp + 128 * bj) = o;
                }
            }
    }
};
struct EpiUp8 {
    const float* slotgate; bf16* hc;
    __device__ __forceinline__ void operator()(const g8::f32x4v (&acc)[2][2][4][2], const g8::Unit& u, int wr, int wc, int fr, int fq) const {
#pragma unroll
        for (int ai = 0; ai < 2; ++ai)
#pragma unroll
            for (int mm = 0; mm < 4; ++mm) {
                const int slot = u.pm + 128 * ai + 64 * wr + 16 * mm + fr;
                const float gw = slotgate[slot];
#pragma unroll
                for (int bj = 0; bj < 2; ++bj) {
                    const g8::f32x4v gv = acc[ai][bj][mm][0], uv = acc[ai][bj][mm][1];
                    const int j = u.pn * 128 + 64 * bj + 16 * wc + 4 * fq;
                    st_bf4(hc + (size_t)slot * 256 + j, gw * siluf_(gv[0]) * uv[0], gw * siluf_(gv[1]) * uv[1], gw * siluf_(gv[2]) * uv[2], gw * siluf_(gv[3]) * uv[3]);
                }
            }
    }
};
struct UpOrder {
    const char* A; const char* Bt; const int* slottok; const int* ue; const int* ur; int nu2, G, c;
    __device__ __forceinline__ bool next(int i, g8::Unit& u) const {
        const int L = i * G + c; if (L >= nu2) return false;
        const int k = L >> 1, pn = L & 1, e = ue[k], row0 = ur[k];
        u.A = A; u.rows = slottok + row0; u.B = Bt + ((size_t)e * 512 + pn * 256) * 1024 * 2; u.pm = row0; u.pn = pn; return true;
    }
};

__device__ __forceinline__ const float* res_row_in(const Params& p, int layer, int tok) {
    const int b = tok / SQ, s = tok - b * SQ;
    if (layer == 0) return s < CTXL ? p.ctx + ((size_t)b * CTXL + s) * DM : p.x + ((size_t)b * SEQL + (s - CTXL)) * DM;
    return s < CTXL ? p.ctxres + ((size_t)b * CTXL + s) * DM : p.out + ((size_t)b * SEQL + (s - CTXL)) * DM;
}
__device__ __forceinline__ float* res_row_out(const Params& p, int tok) {
    const int b = tok / SQ, s = tok - b * SQ;
    return s < CTXL ? p.ctxres + ((size_t)b * CTXL + s) * DM : p.out + ((size_t)b * SEQL + (s - CTXL)) * DM;
}
__device__ __forceinline__ void row_ln(float (&v)[16]) {
    float s = 0.f;
#pragma unroll
    for (int i = 0; i < 16; ++i) s += v[i];
    const float mu = wave_sum(s) * (1.f / 1024.f);
    float q = 0.f;
#pragma unroll
    for (int i = 0; i < 16; ++i) { v[i] -= mu; q += v[i] * v[i]; }
    const float rs = rsqrtf(wave_sum(q) * (1.f / 1024.f) + LN_EPS);
#pragma unroll
    for (int i = 0; i < 16; ++i) v[i] *= rs;
}
__device__ __forceinline__ void row_ld(const float* r, int lane, float (&v)[16]) {
#pragma unroll
    for (int j = 0; j < 4; ++j) { const f32x4 t = *(const f32x4*)(r + 4 * lane + 256 * j); v[4 * j] = t[0]; v[4 * j + 1] = t[1]; v[4 * j + 2] = t[2]; v[4 * j + 3] = t[3]; }
}
__device__ __forceinline__ void row_ld_nt(const float* r, int lane, float (&v)[16]) {
#pragma unroll
    for (int j = 0; j < 4; ++j) { const f32x4 t = __builtin_nontemporal_load((const f32x4*)(r + 4 * lane + 256 * j)); v[4 * j] = t[0]; v[4 * j + 1] = t[1]; v[4 * j + 2] = t[2]; v[4 * j + 3] = t[3]; }
}
__device__ __forceinline__ void row_ld_bf_nt(const bf16* r, int lane, float (&v)[16]) {
#pragma unroll
    for (int j = 0; j < 4; ++j) { const u32x2 t = __builtin_nontemporal_load((const u32x2*)(r + 4 * lane + 256 * j)); v[4 * j] = bflo(t[0]); v[4 * j + 1] = bfhi(t[0]); v[4 * j + 2] = bflo(t[1]); v[4 * j + 3] = bfhi(t[1]); }
}
__device__ __forceinline__ void row_st(float* r, int lane, const float (&v)[16]) {
#pragma unroll
    for (int j = 0; j < 4; ++j) { f32x4 t = {v[4 * j], v[4 * j + 1], v[4 * j + 2], v[4 * j + 3]}; *(f32x4*)(r + 4 * lane + 256 * j) = t; }
}
__device__ __forceinline__ void row_st_bf(bf16* r, int lane, const float (&v)[16]) {
#pragma unroll
    for (int j = 0; j < 4; ++j) st_bf4(r + 4 * lane + 256 * j, v[4 * j], v[4 * j + 1], v[4 * j + 2], v[4 * j + 3]);
}
__device__ __forceinline__ void row_ld_f8(const unsigned char* r, int lane, float (&v)[16]) {
    typedef float f2v __attribute__((ext_vector_type(2)));
#pragma unroll
    for (int j = 0; j < 4; ++j) {
        const int w = __builtin_nontemporal_load((const int*)(r + 4 * lane + 256 * j));
        const f2v lo = __builtin_amdgcn_cvt_pk_f32_fp8(w, false), hi = __builtin_amdgcn_cvt_pk_f32_fp8(w, true);
        v[4 * j] = lo[0] * 0.0625f; v[4 * j + 1] = lo[1] * 0.0625f; v[4 * j + 2] = hi[0] * 0.0625f; v[4 * j + 3] = hi[1] * 0.0625f;
    }
}
__device__ __forceinline__ void row_ld_bf(const bf16* r, int lane, float (&v)[16]) {
#pragma unroll
    for (int j = 0; j < 4; ++j) { const u32x2 t = *(const u32x2*)(r + 4 * lane + 256 * j); v[4 * j] = bflo(t[0]); v[4 * j + 1] = bfhi(t[0]); v[4 * j + 2] = bflo(t[1]); v[4 * j + 3] = bfhi(t[1]); }
}

__device__ __forceinline__ void wave_token_range(int wave, int& t0, int& t1) {
    const int G = gridDim.x, b = blockIdx.x;
    const int b0 = (int)(((long)NTOK * b) / G), b1 = (int)(((long)NTOK * (b + 1)) / G), n = b1 - b0;
    t0 = b0 + (n * wave) / 8; t1 = b0 + (n * (wave + 1)) / 8;
}
__device__ __forceinline__ void phase_ln_mod(const Params& p, int layer, int item) {
    const int lane = otid() & 63, wave = otid() >> 6;
    int t0, t1; wave_token_range(wave, t0, t1); (void)item;
    float sh[16], sc[16];
    int ckey = -1;
    for (int tok = t0; tok < t1; ++tok) {
        const int b = tok / SQ, s = tok - b * SQ;
        const int key = s < CTXL ? 8 : b;
        if (key != ckey) { const float* mv = p.modv + (size_t)(layer * 9 + key) * 6144; row_ld(mv, lane, sh); row_ld(mv + 1024, lane, sc); ckey = key; }
        float v[16];
        row_ld_nt(res_row_in(p, layer, tok), lane, v);
        row_ln(v);
#pragma unroll
        for (int k = 0; k < 16; ++k) v[k] = v[k] * (1.f + sc[k]) + sh[k];
        row_st_bf(p.h + (size_t)tok * DM, lane, v);
    }
}
template <int DUMMY>
__device__ __forceinline__ void phase_post_mixer(const Params& p, int layer, int item) {
    const int lane = otid() & 63, wave = otid() >> 6;
    const bf16* y = p.z;
    bf16* fhi = p.h; bf16* flo = p.cat;
    int t0, t1; if (DUMMY) { t0 = item * 64 + wave * 8; t1 = t0 + 8; } else wave_token_range(wave, t0, t1);
    float g1[16], lng[16], lnb[16], sh2[16], sc2[16];
    row_ld(p.ln1_g + layer * DM, lane, lng); row_ld(p.ln1_b + layer * DM, lane, lnb);
    int ckey = -1;
    for (int tok = t0; tok < t1; ++tok) {
        const int b = tok / SQ, s = tok - b * SQ;
        if (!DUMMY && layer == 1 && s < CTXL) continue;
        const int key = s < CTXL ? 8 : b;
        if (key != ckey) { const float* mv = p.modv + (size_t)(layer * 9 + key) * 6144; row_ld(mv + 2048, lane, g1); row_ld(mv + 3072, lane, sh2); row_ld(mv + 4096, lane, sc2); ckey = key; }
        float v[16], t[16];
        if (layer == 0) row_ld_nt(res_row_in(p, 0, tok), lane, v); else row_ld_bf_nt((const bf16*)res_row_out(p, tok), lane, v);
        row_ld_bf_nt(y + (size_t)tok * DM, lane, t);
#pragma unroll
        for (int k = 0; k < 16; ++k) v[k] = ALPHA_DN * v[k] + g1[k] * t[k];
        row_ln(v);
#pragma unroll
        for (int k = 0; k < 16; ++k) v[k] = v[k] * lng[k] + lnb[k];
        if (DUMMY) row_st((float*)p.yc + (size_t)(blockIdx.x * 8 + wave) * 1024, lane, v); else row_st_bf((bf16*)res_row_out(p, tok), lane, v);
        row_ln(v);
        float lo[16];
#pragma unroll
        for (int k = 0; k < 16; ++k) { v[k] = v[k] * (1.f + sc2[k]) + sh2[k]; const float hi = bf2f(f2bf(v[k])); lo[k] = v[k] - hi; }
        row_st_bf(DUMMY ? p.yc + (size_t)(4096 + blockIdx.x * 8 + wave) * 2048 : fhi + (size_t)tok * DM, lane, v);
        row_st_bf(DUMMY ? p.yc + (size_t)(8192 + blockIdx.x * 8 + wave) * 2048 : flo + (size_t)tok * DM, lane, lo);
    }
}
struct CombRows { u32x4 y[9]; u32x2 x[4]; };
__device__ __forceinline__ void comb_issue(const Params& p, int b, int s, int off_sh, const bf16* yc, int lane, CombRows& R) {
    const int tok = b * SQ + s;
    const unsigned char* yb = (const unsigned char*)yc;
    R.y[0] = __builtin_nontemporal_load((const u32x4*)(yb + (size_t)(off_sh + s) * DM + 16 * lane));
#pragma unroll
    for (int k = 0; k < 8; ++k) {
        const int slot = p.tokslot[tok * 8 + k];
        R.y[1 + k] = __builtin_nontemporal_load((const u32x4*)(yb + (size_t)slot * DM + 16 * lane));
    }
    const bf16* xr = (const bf16*)res_row_out(p, tok);
#pragma unroll
    for (int j = 0; j < 4; ++j) R.x[j] = __builtin_nontemporal_load((const u32x2*)(xr + 4 * lane + 256 * j));
}
__device__ __forceinline__ void phase_combine(const Params& p, int layer, int b, int item, const bf16* yc, char* smem) {
    typedef float f2v __attribute__((ext_vector_type(2)));
    const int lane = otid() & 63, wave = otid() >> 6;
    const int off_sh = p.ntb[b * 2 + 1];
    (void)item;
    float* srow = (float*)smem;
    __syncthreads();
    {
        const int c4 = lane * 4;
        const float* src = wave == 0 ? p.ln2_g + layer * DM : wave == 1 ? p.ln2_b + layer * DM
                         : wave < 4 ? p.modv + (size_t)(layer * 9 + (wave == 2 ? b : 8)) * 6144 + 5120
                         : p.modv + (size_t)(9 + ((wave & 1) ? 8 : b)) * 6144 + (wave >= 6 ? 1024 : 0);
#pragma unroll
        for (int j = 0; j < 4; ++j) *(f32x4*)(srow + wave * 1024 + c4 + 256 * j) = *(const f32x4*)(src + c4 + 256 * j);
    }
    __syncthreads();
    const int G = gridDim.x, nb0 = (int)(((long)SQ * blockIdx.x) / G), nb1 = (int)(((long)SQ * (blockIdx.x + 1)) / G), nn = nb1 - nb0;
    int sa = nb0 + (nn * wave) / 8; const int sb = nb0 + (nn * (wave + 1)) / 8;
    if (layer == 1 && sa < CTXL) sa = CTXL;
    if (sa >= sb) return;
    CombRows R;
    comb_issue(p, b, sa, off_sh, yc, lane, R);
    for (int s = sa; s < sb; ++s) {
        const int tok = b * SQ + s;
        const int cx = s < CTXL ? 1 : 0;
        float f[16], t[16], v[16];
#pragma unroll
        for (int q = 0; q < 16; ++q) f[q] = 0.f;
#pragma unroll
        for (int k = 0; k < 9; ++k)
#pragma unroll
            for (int j = 0; j < 4; ++j) {
                const f2v lo = __builtin_amdgcn_cvt_pk_f32_fp8((int)R.y[k][j], false), hi = __builtin_amdgcn_cvt_pk_f32_fp8((int)R.y[k][j], true);
                f[4 * j] += lo[0]; f[4 * j + 1] += lo[1]; f[4 * j + 2] += hi[0]; f[4 * j + 3] += hi[1];
            }
#pragma unroll
        for (int j = 0; j < 4; ++j) { v[4 * j] = bflo(R.x[j][0]); v[4 * j + 1] = bfhi(R.x[j][0]); v[4 * j + 2] = bflo(R.x[j][1]); v[4 * j + 3] = bfhi(R.x[j][1]); }
        if (s + 1 < sb) comb_issue(p, b, s + 1, off_sh, yc, lane, R);
        float* xr = res_row_out(p, tok);
        row_ld(srow + (2 + cx) * 1024, lane, t);
#pragma unroll
        for (int q = 0; q < 16; ++q) v[q] = ALPHA_DN * v[q] + t[q] * (f[q] * 0.0625f);
        row_ln(v);
        row_ld(srow, lane, t); row_ld(srow + 1024, lane, f);
#pragma unroll
        for (int q = 0; q < 16; ++q) v[q] = v[q] * t[q] + f[q];
        if (layer != 0) row_st(xr, lane, v); else row_st_bf((bf16*)xr, lane, v);
        if (layer == 0) {
            row_ln(v);
            row_ld(srow + (4 + cx) * 1024, lane, t); row_ld(srow + (6 + cx) * 1024, lane, f);
#pragma unroll
            for (int q = 0; q < 16; ++q) v[q] = v[q] * (1.f + f[q]) + t[q];
            row_st_bf(p.h + (size_t)tok * DM, lane, v);
        }
    }
}

__device__ __forceinline__ void job_modv(const Params& p, int item, char* smem) {
    float* sc = (float*)smem;
    float* red = sc + 9 * 1024;
    const int tid = otid();
    for (int i = tid; i < 9 * 1024; i += 512) { const int r = i >> 10, k = i & 1023; const float cv = r < 8 ? p.c[r * 1024 + k] : p.c_ctx[k]; sc[i] = siluf_(cv); }
    __syncthreads();
    const int layer = item / 96, col = (item % 96) * 64 + (tid & 63), sl = tid >> 6;
    const float* w = p.ada_w + (size_t)layer * 1024 * 6144 + col + (size_t)sl * 128 * 6144;
    const float* scs = sc + sl * 128;
    float acc[9];
#pragma unroll
    for (int r = 0; r < 9; ++r) acc[r] = 0.f;
    for (int k = 0; k < 128; k += 8) {
        float wv[8];
#pragma unroll
        for (int u = 0; u < 8; ++u) wv[u] = w[(size_t)(k + u) * 6144];
#pragma unroll
        for (int u = 0; u < 8; ++u)
#pragma unroll
            for (int r = 0; r < 9; ++r) acc[r] += scs[r * 1024 + k + u] * wv[u];
    }
#pragma unroll
    for (int r = 0; r < 9; ++r) red[(sl * 9 + r) * 64 + (tid & 63)] = acc[r];
    __syncthreads();
    for (int e = tid; e < 9 * 64; e += 512) {
        const int r = e >> 6, c = e & 63;
        float v = 0.f;
#pragma unroll
        for (int q = 0; q < 8; ++q) v += red[(q * 9 + r) * 64 + c];
        const int cc = (item % 96) * 64 + c;
        p.modv[(size_t)(layer * 9 + r) * 6144 + cc] = v + p.ada_b[layer * 6144 + cc];
    }
}
__device__ __forceinline__ void job_rope_tab(const Params& p) {
    for (int e = otid(); e < 1024; e += 512) {
        const int pos = e >> 3, i = e & 7;
        const float invf = powf(10000.f, -(float)i / 8.f);
        const float ang = (float)pos * invf;
        p.rope_tab[e * 2] = cosf(ang); p.rope_tab[e * 2 + 1] = sinf(ang);
    }
}
__device__ __forceinline__ void job_s5_tables(const Params& p, int item, char* smem) {
    float2* s_pw = (float2*)smem;
    float2* s_bb = s_pw + 64 * 65;
    float2* s_cc = s_bb + 64 * 16;
    const int tid = otid();
    const int dir = item & 1, g = (item >> 1) & 15, l = item >> 5;
    const int lg = (l * 2 + dir) * 16 + g;
    const int og = (l * 16 + g) * 2 + dir;
    const float step = expf(p.log_step[lg]);
    for (int e = tid; e < 64 * 65; e += 512) {
        const int pp = e / 65, d = e - pp * 65;
        const float lr = p.lam_re[lg * 64 + pp] * step, li = p.lam_im[lg * 64 + pp] * step;
        const float mag = expf(lr * (float)d), ang = li * (float)d;
        const float2 v = make_float2(mag * cosf(ang), mag * sinf(ang));
        s_pw[e] = v; ((float2*)p.pw)[(size_t)og * 64 * 65 + e] = v;
    }
    for (int e = tid; e < 1024; e += 512) {
        const int pp = e >> 4;
        const float lre = p.lam_re[lg * 64 + pp], lim = p.lam_im[lg * 64 + pp];
        const float lr = lre * step, li = lim * step;
        const float mag = expf(lr);
        const float ar = mag * cosf(li) - 1.f, ai = mag * sinf(li);
        const float den = 1.f / (lre * lre + lim * lim);
        const float qr = (ar * lre + ai * lim) * den, qi = (ai * lre - ar * lim) * den;
        const float br = p.b_re[(size_t)lg * 1024 + e], bi = p.b_im[(size_t)lg * 1024 + e];
        const float2 v = make_float2(qr * br - qi * bi, qr * bi + qi * br);
        s_bb[e] = v; ((float2*)p.bbar)[(size_t)og * 1024 + e] = v;
        s_cc[e] = make_float2(p.c_re[(size_t)lg * 1024 + e], p.c_im[(size_t)lg * 1024 + e]);
    }
    __syncthreads();
    for (int q = 0; q < 32; ++q) {
        const int idx = tid + 512 * q, d = idx >> 8, c = (idx >> 4) & 15, c2 = idx & 15;
        float acc = 0.f;
        for (int pp = 0; pp < 64; ++pp) {
            const float2 C = s_cc[c * 64 + pp], P = s_pw[pp * 65 + d], B = s_bb[pp * 16 + c2];
            const float xr = C.x * P.x - C.y * P.y, xi = C.x * P.y + C.y * P.x;
            acc += xr * B.x - xi * B.y;
        }
        p.klag[(size_t)og * 16384 + idx] = acc;
    }
}
__device__ __forceinline__ void job_s5_expand(const Params& p, int l, int item) {
    const int tid = otid(), g = item >> 6, i = item & 63;
    const float* kf = p.klag + (size_t)((l * 16 + g) * 2 + 0) * 16384;
    const float* kb = p.klag + (size_t)((l * 16 + g) * 2 + 1) * 16384;
    {
        const int c = tid >> 5, kk = tid & 31;
        const float dsk = p.s5_d[l * 256 + g * 16 + c];
#pragma unroll
        for (int q = 0; q < 4; ++q) {
            const int col0 = kk * 8 + 256 * q, j = col0 >> 4, c0 = col0 & 15;
            float v[8];
#pragma unroll
            for (int e = 0; e < 8; ++e) {
                const int c2 = c0 + e;
                float a = 0.f;
                if (j <= i) a += kf[(i - j) * 256 + c * 16 + c2];
                if (j >= i) a += kb[(j - i) * 256 + c * 16 + c2];
                if (j == i && c2 == c) a += dsk;
                v[e] = a;
            }
            u32x4 o = {pk2(v[0], v[1]), pk2(v[2], v[3]), pk2(v[4], v[5]), pk2(v[6], v[7])};
            *(u32x4*)(p.wg + ((size_t)g * 1024 + i * 16 + c) * 1024 + col0) = o;
        }
    }
    {
        const int c = tid >> 5, col0 = (tid & 31) * 8;
        const int dir = col0 >> 7, ri = (col0 >> 6) & 1, p0 = col0 & 63;
        const int lg = (l * 2 + dir) * 16 + g, og = (l * 16 + g) * 2 + dir;
        const int e = dir ? 64 - i : i + 1;
        float v[8];
#pragma unroll
        for (int u = 0; u < 8; ++u) {
            const int pp = p0 + u;
            const float cr = p.c_re[(size_t)lg * 1024 + c * 64 + pp], ci = p.c_im[(size_t)lg * 1024 + c * 64 + pp];
            const float2 P = ((const float2*)p.pw)[(size_t)og * 64 * 65 + pp * 65 + e];
            v[u] = ri ? -(cr * P.y + ci * P.x) : (cr * P.x - ci * P.y);
        }
        u32x4 o = {pk2(v[0], v[1]), pk2(v[2], v[3]), pk2(v[4], v[5]), pk2(v[6], v[7])};
        *(u32x4*)(p.eg + ((size_t)g * 1024 + i * 16 + c) * 256 + col0) = o;
    }
    {
        const int n2 = 4 * i + (tid >> 7), col0 = (tid & 127) * 8;
        const int dir = n2 >> 7, ri = (n2 >> 6) & 1, pp = n2 & 63;
        const int og = (l * 16 + g) * 2 + dir;
        const int j = col0 >> 4, c0 = col0 & 15;
        const int pe = dir ? j : 63 - j;
        const float2 P = ((const float2*)p.pw)[(size_t)og * 64 * 65 + pp * 65 + pe];
        float v[8];
#pragma unroll
        for (int u = 0; u < 8; ++u) {
            const float2 B = ((const float2*)p.bbar)[(size_t)og * 1024 + pp * 16 + c0 + u];
            v[u] = ri ? (P.x * B.y + P.y * B.x) : (P.x * B.x - P.y * B.y);
        }
        u32x4 o = {pk2(v[0], v[1]), pk2(v[2], v[3]), pk2(v[4], v[5]), pk2(v[6], v[7])};
        *(u32x4*)(p.gg + ((size_t)g * 256 + n2) * 1024 + col0) = o;
    }
}

template <class SrcCol, class DstRow>
__device__ __forceinline__ void cvt_tile(const float* src, int ld_src, bf16* dst, int ld_dst, int k0, int n0, int nvalid, SrcCol sc, DstRow dr, const float* kscale, char* smem, bf16* dst_lo = nullptr) {
    float* sm = (float*)smem;
    const int tid = otid();
    {
        const int n = tid & 63, kk = tid >> 6;
        const bool ok = (n0 + n) < nvalid;
        const int col = ok ? sc(n0 + n) : 0;
#pragma unroll
        for (int i = 0; i < 8; ++i) {
            const int k = kk + 8 * i;
            float v = ok ? src[(size_t)(k0 + k) * ld_src + col] : 0.f;
            if (kscale) v *= kscale[k0 + k];
            sm[k * 65 + n] = v;
        }
    }
    __syncthreads();
    {
        const int k = tid & 63, nn = tid >> 6;
#pragma unroll
        for (int i = 0; i < 8; ++i) {
            const int n = nn + 8 * i;
            const float v = sm[k * 65 + n];
            const bf16 hi = f2bf(v);
            dst[(size_t)dr(n0 + n) * ld_dst + k0 + k] = hi;
            if (dst_lo) dst_lo[(size_t)dr(n0 + n) * ld_dst + k0 + k] = f2bf(v - bf2f(hi));
        }
    }
    __syncthreads();
}
struct IdMap { __device__ __forceinline__ int operator()(int n) const { return n; } };
struct InColMap {
    __device__ __forceinline__ int operator()(int n) const {
        if (n < 640 || n >= 672) return n;
        const int r = n - 640, ax = r >> 4, q = r & 15, i = q >> 1, t = q & 1;
        return 640 + ax * 16 + t * 8 + i;
    }
};
struct QColMap {
    __device__ __forceinline__ int operator()(int n) const {
        const int hd = n / 96, d = n - hd * 96;
        if (d < 64) return n;
        const int r = d - 64, ax = r >> 4, q = r & 15, i = q >> 1, t = q & 1;
        return hd * 96 + 64 + ax * 16 + t * 8 + i;
    }
};
struct UpRowMap {
    int t; __device__ __forceinline__ int operator()(int j) const { return (j >> 4) * 32 + t * 16 + (j & 15); }
};
struct DnRowMap {
    __device__ __forceinline__ int operator()(int n) const { return ((n & 255) >> 2) * 16 + (n >> 8) * 4 + (n & 3); }
};
template <class SrcCol, class DstRow>
__device__ __forceinline__ void cvt_tile256(const float* src, int ld_src, bf16* dst, int ld_dst, int k0, int n0, int nvalid, SrcCol sc, DstRow dr, const float* kscale, char* smem) {
    float* sm = (float*)smem;
    const int tid = otid();
    {
        const int n4 = (tid & 63) * 4, kk = tid >> 6;
        const int n = n0 + n4;
        const bool ok = n < nvalid;
        const bool vec = ok && sc(n) == n && sc(n + 3) == n + 3;
#pragma unroll
        for (int i = 0; i < 8; ++i) {
            const int k = kk + 8 * i;
            f32x4 v = {0.f, 0.f, 0.f, 0.f};
            const float* row = src + (size_t)(k0 + k) * ld_src;
            if (vec) v = __builtin_nontemporal_load((const f32x4*)(row + n));
            else if (ok) { v[0] = row[sc(n)]; v[1] = row[sc(n + 1)]; v[2] = row[sc(n + 2)]; v[3] = row[sc(n + 3)]; }
            if (kscale) { const float ks = kscale[k0 + k]; v[0] *= ks; v[1] *= ks; v[2] *= ks; v[3] *= ks; }
            float* d = sm + k * 257 + n4;
            d[0] = v[0]; d[1] = v[1]; d[2] = v[2]; d[3] = v[3];
        }
    }
    __syncthreads();
    {
        const int kch = tid & 7, nn = tid >> 3;
#pragma unroll
        for (int i = 0; i < 4; ++i) {
            const int n = nn + 64 * i;
            const float* c = sm + (kch * 8) * 257 + n;
            u32x4 o = {pk2(c[0], c[257]), pk2(c[2 * 257], c[3 * 257]), pk2(c[4 * 257], c[5 * 257]), pk2(c[6 * 257], c[7 * 257])};
            *(u32x4*)(dst + (size_t)dr(n0 + n) * ld_dst + k0 + kch * 8) = o;
        }
    }
    __syncthreads();
}
#define CVT_N_IN   (16 * 7)
#define CVT_N_Q    (4 * 3)
#define CVT_N_KV   (2 * 4)
#define CVT_N_GLU  (4 * 1)
#define CVT_N_OUT  (16 * 4)
#define CVT_N_R    (16 * 2)
#define CVT_N_UP   (130 * 16)
#define CVT_N_DN   (65 * 4 * 4)
#define CVT_TOTAL  (CVT_N_IN + CVT_N_Q + CVT_N_KV + CVT_N_GLU + CVT_N_OUT + CVT_N_R + CVT_N_UP + CVT_N_DN)
#define CVT_EXPERT (CVT_N_UP + CVT_N_DN)
#define CVT_SMALL (CVT_TOTAL - CVT_EXPERT)
__device__ __forceinline__ void job_cvt_expert(const Params& p, int l, int item, char* smem) {
    int it = item;
    if (it < CVT_N_UP) {
        const int et = it / 16, kt = it % 16, e = et >> 1, t = et & 1;
        const float* src = e < 64 ? (t ? p.ew_up : p.ew_gate) + ((size_t)l * 64 + e) * 1024 * 256 : (t ? p.sw_up : p.sw_gate) + (size_t)l * 1024 * 256;
        UpRowMap rm; rm.t = t;
        cvt_tile256(src, 256, p.bt_up + (size_t)e * 512 * 1024, 1024, kt * 64, 0, 256, IdMap(), rm, nullptr, smem); return;
    }
    it -= CVT_N_UP;
    {
        const int e = it / 16, r = it % 16, kt = r / 4, nt = r % 4;
        const float* src = e < 64 ? p.ew_down + ((size_t)l * 64 + e) * 256 * 1024 : p.sw_down + (size_t)l * 256 * 1024;
        cvt_tile256(src, 1024, p.bt_dn + (size_t)e * 1024 * 256, 256, kt * 64, nt * 256, 1024, IdMap(), DnRowMap(), nullptr, smem);
    }
}
__device__ __forceinline__ void job_cvt_small(const Params& p, int l, int item, char* smem) {
    int it = item;
    if (it < CVT_N_IN) { const int kt = it / 7, nt = it % 7; cvt_tile256(p.w_in + (size_t)l * 1024 * NIN, NIN, p.bt_in, 1024, kt * 64, nt * 256, NIN, InColMap(), IdMap(), nullptr, smem); return; }
    it -= CVT_N_IN;
    if (it < CVT_N_Q) { const int kt = it / 3, nt = it % 3; cvt_tile256(p.w_q_up + (size_t)l * 256 * 768, 768, p.bt_q, 256, kt * 64, nt * 256, 768, QColMap(), IdMap(), p.q_norm + l * 256, smem); return; }
    it -= CVT_N_Q;
    if (it < CVT_N_KV) { const int kt = it / 4, nt = it % 4; cvt_tile256(p.w_kv_up + (size_t)l * 128 * 1024, 1024, p.bt_kv, 128, kt * 64, nt * 256, 1024, IdMap(), IdMap(), p.kv_norm + l * 128, smem); return; }
    it -= CVT_N_KV;
    if (it < CVT_N_GLU) { const int kt = it; cvt_tile256(p.glu_w + (size_t)l * 256 * 256, 256, p.bt_glu, 256, kt * 64, 0, 256, IdMap(), IdMap(), nullptr, smem); return; }
    it -= CVT_N_GLU;
    if (it < CVT_N_OUT) { const int kt = it / 4, nt = it % 4; cvt_tile256(p.w_out + (size_t)l * 1024 * 1024, 1024, p.bt_out, 1024, kt * 64, nt * 256, 1024, IdMap(), IdMap(), nullptr, smem); return; }
    it -= CVT_N_OUT;
    { const int kt = it / 2, nt = it % 2; if (nt == 0) cvt_tile(p.router_w + (size_t)l * 1024 * 64, 64, p.bt_rhi, 1024, kt * 64, 0, 64, IdMap(), IdMap(), nullptr, smem, p.bt_rlo); }
}

__device__ __forceinline__ void phase_post_inproj(const Params& p, int l, int item) {
    const int tid = otid(), lane = tid & 63, wave = tid >> 6;
    int t0, t1; wave_token_range(wave, t0, t1); (void)item;
    for (int tb = t0; tb < t1; tb += 4) {
        u32x2 qv4[4]; unsigned kv4[4], kr4[4];
#pragma unroll
        for (int i = 0; i < 4; ++i) {
            const int tok = (tb + i < t1) ? tb + i : t1 - 1;
            const bf16* zr = p.z + (size_t)tok * ZW;
            qv4[i] = __builtin_nontemporal_load((const u32x2*)(zr + Z_QC + 4 * lane));
            kv4[i] = __builtin_nontemporal_load((const unsigned*)(zr + Z_KVC + 2 * lane));
            kr4[i] = *(const unsigned*)(zr + Z_KR + 2 * (lane & 15));
        }
#pragma unroll
        for (int i = 0; i < 4; ++i) {
            const int tok = tb + i;
            if (tok < t1) {
                const int b = tok / SQ, s = tok - b * SQ;
                const u32x2 qv = qv4[i];
                float ss = bflo(qv[0]) * bflo(qv[0]) + bfhi(qv[0]) * bfhi(qv[0]) + bflo(qv[1]) * bflo(qv[1]) + bfhi(qv[1]) * bfhi(qv[1]);
                ss = wave_sum(ss);
                const unsigned kv = kv4[i];
                float s2 = bflo(kv) * bflo(kv) + bfhi(kv) * bfhi(kv);
                s2 = wave_sum(s2);
                if (lane == 0) { p.rq[tok] = rsqrtf(ss * (1.f / 256.f) + 1e-6f); p.rkv[tok] = rsqrtf(s2 * (1.f / 128.f) + 1e-6f); }
                if (lane < 16) {
                    const unsigned kr = kr4[i];
                    float v0 = bflo(kr), v1 = bfhi(kr);
                    if (s >= CTXL) {
                        const int ax = lane >> 3, ii = lane & 7, sl = s - CTXL, pos = ax ? (sl & 63) : (sl >> 6);
                        const float cs = p.rope_tab[(pos * 8 + ii) * 2], sn = p.rope_tab[(pos * 8 + ii) * 2 + 1];
                        const float a0 = v0 * cs - v1 * sn, a1 = v0 * sn + v1 * cs; v0 = a0; v1 = a1;
                    }
                    const unsigned o = pk2(v0, v1);
#pragma unroll
                    for (int hd = 0; hd < 8; ++hd) *(unsigned*)(p.kf + ((size_t)(b * 8 + hd) * SQ + s) * 96 + 64 + 2 * lane) = o;
                }
            }
        }
    }
    const float* cw = p.conv_w + (size_t)l * 3 * 512; const float* cb = p.conv_b + l * 512;
    const int bt0 = (int)(((long)NTOK * blockIdx.x) / gridDim.x), bt1 = (int)(((long)NTOK * (blockIdx.x + 1)) / gridDim.x);
    const int nq = (bt1 - bt0) * 64;
    float cw0[8], cw1[8], cw2[8], cbb[8];
    {
        const int chh = (tid & 63) * 8;
#pragma unroll
        for (int j = 0; j < 2; ++j) {
            const f32x4 a0 = *(const f32x4*)(cw + chh + 4 * j), a1 = *(const f32x4*)(cw + 512 + chh + 4 * j), a2 = *(const f32x4*)(cw + 1024 + chh + 4 * j), bb = *(const f32x4*)(cb + chh + 4 * j);
#pragma unroll
            for (int i = 0; i < 4; ++i) { cw0[4 * j + i] = a0[i]; cw1[4 * j + i] = a1[i]; cw2[4 * j + i] = a2[i]; cbb[4 * j + i] = bb[i]; }
        }
    }
    for (int q0 = tid; q0 < nq; q0 += 1024) {
        u32x4 cur2[2], prv2[2], nxt2[2];
#pragma unroll
        for (int i = 0; i < 2; ++i) {
            const int q = (q0 + 512 * i < nq) ? q0 + 512 * i : q0;
            const int tok = bt0 + (q >> 6), ch0 = (q & 63) * 8;
            const int b = tok / SQ, s = tok - b * SQ;
            const bool hasp = (s != 0) && (s != CTXL), hasn = (s != CTXL - 1) && (s != SQ - 1);
            const bf16* zr = p.z + (size_t)tok * ZW + Z_MLQ + ch0;
            const u32x4 zz = {0u, 0u, 0u, 0u};
            cur2[i] = *(const u32x4*)zr; prv2[i] = zz; nxt2[i] = zz;
            if (hasp) prv2[i] = *(const u32x4*)(zr - ZW);
            if (hasn) nxt2[i] = *(const u32x4*)(zr + ZW);
        }
#pragma unroll
        for (int i = 0; i < 2; ++i) {
            const int q = q0 + 512 * i;
            if (q < nq) {
                const int tok = bt0 + (q >> 6), ch0 = (q & 63) * 8;
                const u32x4 cur = cur2[i], prv = prv2[i], nxt = nxt2[i];
                const float ksc = ch0 >= 256 ? 0.125f : 1.f;
                float o[8];
#pragma unroll
                for (int e = 0; e < 8; ++e) {
                    const unsigned pc = prv[e >> 1], cc = cur[e >> 1], nc = nxt[e >> 1];
                    const float xp = (e & 1) ? bfhi(pc) : bflo(pc), xc = (e & 1) ? bfhi(cc) : bflo(cc), xn = (e & 1) ? bfhi(nc) : bflo(nc);
                    const float a = cbb[e] + cw0[e] * xp + cw1[e] * xc + cw2[e] * xn;
                    o[e] = siluf_(a) * ksc;
                }
                u32x4 ov = {pk2(o[0], o[1]), pk2(o[2], o[3]), pk2(o[4], o[5]), pk2(o[6], o[7])};
                *(u32x4*)(p.qkc + (size_t)tok * 512 + ch0) = ov;
            }
        }
    }
}

__device__ __forceinline__ int chain_chunk(int dir, int step) { return dir == 0 ? step : (step < 4 ? 3 - step : NCH + 3 - step); }

__device__ __forceinline__ void job_s5_carry(const Params& p, int l, int item) {
    const int id = item * 512 + otid();
    const int pp = id & 63, dir = (id >> 6) & 1, g = (id >> 7) & 15, b = id >> 11;
    const float2 a64 = ((const float2*)p.pw)[(size_t)((l * 16 + g) * 2 + dir) * 64 * 65 + pp * 65 + 64];
    float sr = 0.f, si = 0.f;
    const size_t base = (size_t)g * NROWP * 256 + dir * 128 + pp;
    for (int s0 = 0; s0 < NCH; s0 += 12) {
        float fr[12], fi[12];
#pragma unroll
        for (int u = 0; u < 12; ++u) { const size_t o = base + (size_t)(b * NCH + chain_chunk(dir, s0 + u)) * 256; fr[u] = p.ff[o]; fi[u] = p.ff[o + 64]; }
#pragma unroll
        for (int u = 0; u < 12; ++u) {
            const size_t o = base + (size_t)(b * NCH + chain_chunk(dir, s0 + u)) * 256;
            p.sin_[o] = f2bf(sr); p.sin_[o + 64] = f2bf(si);
            const float nr = a64.x * sr - a64.y * si + fr[u], ni = a64.x * si + a64.y * sr + fi[u];
            sr = nr; si = ni;
        }
    }
}
__device__ __forceinline__ void job_ml_carry(const Params& p, int item) {
    const int chain = item / 5, part = item % 5, tid = otid();
    const int dir = chain & 1;
    if (tid >= 416) return;
    const size_t eoff = (size_t)part * 832 + tid * 2;
    float c0 = 0.f, c1 = 0.f, m = 0.f;
    for (int s0 = 0; s0 < NCH; s0 += 12) {
        unsigned lv[12]; float ml[12], bl[12];
#pragma unroll
        for (int u = 0; u < 12; ++u) {
            const size_t un = (size_t)chain * NCH + chain_chunk(dir, s0 + u);
            lv[u] = *(const unsigned*)(p.cloc + un * CLOC_STRIDE + eoff); ml[u] = p.mlstat[un * 4]; bl[u] = p.mlstat[un * 4 + 1];
        }
#pragma unroll
        for (int u = 0; u < 12; ++u) {
            const size_t un = (size_t)chain * NCH + chain_chunk(dir, s0 + u);
            *(unsigned*)(p.cloc + un * CLOC_STRIDE + eoff) = pk2(c0, c1);
            if (part == 0 && tid == 0) p.mlstat[un * 4 + 2] = m;
            const float mn = fmaxf(bl[u] + m, ml[u]);
            const float a = fexp(bl[u] + m - mn), sc = fexp(ml[u] - mn);
            c0 = a * c0 + sc * bflo(lv[u]); c1 = a * c1 + sc * bfhi(lv[u]); m = mn;
        }
    }
}

__device__ __forceinline__ int scan_sum_i(int v, int lane) {
    (void)lane;
    v += dppi<0x111, 0xf>(0, v); v += dppi<0x112, 0xf>(0, v); v += dppi<0x114, 0xf>(0, v); v += dppi<0x118, 0xf>(0, v);
    v += dppi<0x142, 0xa>(0, v); v += dppi<0x143, 0xc>(0, v);
    return v;
}
__device__ __forceinline__ void phase_route(const Params& p, int l, int item, char* smem) {
    const int lane = otid() & 63, wave = otid() >> 6;
    const float bias = p.router_bias[l * 64 + lane];
    const float NEG = -__builtin_inff();
    int t0, t1; wave_token_range(wave, t0, t1); (void)item;
    int* wl = (int*)(smem + wave * 2048);
    int cnt = 0, seg0 = t0, curb = (t0 < t1) ? t0 / SQ : 0;
    auto flush = [&](int ta, int tb_, int bb) {
        const int base = cnt ? atomicAdd(&p.moe_cnt[(l * 8 + bb) * 64 + lane], cnt) : 0;
        for (int tok = ta; tok < tb_; ++tok) {
            if (l == 1 && tok - bb * SQ < CTXL) continue;
            const int v = (lane < 8) ? wl[(tok - t0) * 8 + lane] : 0;
            const int bs = __shfl(base, v & 63, 64);
            if (lane < 8) p.pos[tok * 8 + lane] = (v >> 6) + bs;
        }
        cnt = 0;
    };
    float lg4[4];
#pragma unroll
    for (int i = 0; i < 4; ++i) lg4[i] = (t0 + i < t1) ? __builtin_nontemporal_load(p.logits + (size_t)(t0 + i) * 64 + lane) : 0.f;
    for (int tb = t0; tb < t1; tb += 4)
#pragma unroll
    for (int ti = 0; ti < 4; ++ti) {
        const int tok = tb + ti;
        if (tok >= t1) break;
        const float lg = lg4[ti];
        if (tok + 4 < t1) lg4[ti] = __builtin_nontemporal_load(p.logits + (size_t)(tok + 4) * 64 + lane);
        const int b = tok / SQ;
        if (b != curb) { flush(seg0, tok, curb); seg0 = tok; curb = b; }
        if (l == 1 && tok - b * SQ < CTXL) continue;
        const float sc = 1.f / (1.f + expf(-lg));
        const float bs = sc + bias;
        float m1 = bs;
        m1 = fmaxf(m1, dppf<0xB1, 0xf>(m1, m1)); m1 = fmaxf(m1, dppf<0x4E, 0xf>(m1, m1)); m1 = fmaxf(m1, dppf<0x141, 0xf>(m1, m1));
        const unsigned long long gm = 0xFFull << (lane & ~7);
        const unsigned long long bal = __ballot(bs == m1) & gm;
        const int first = __ffsll((long long)bal) - 1;
        float m2 = (lane == first) ? NEG : bs;
        m2 = fmaxf(m2, dppf<0xB1, 0xf>(m2, m2)); m2 = fmaxf(m2, dppf<0x4E, 0xf>(m2, m2)); m2 = fmaxf(m2, dppf<0x141, 0xf>(m2, m2));
        const float gsc = m1 + m2;
        const int G = lane >> 3;
        int rank = 0;
#pragma unroll
        for (int g2 = 0; g2 < 8; ++g2) { const float o = readlane_f(gsc, g2 * 8); rank += (o > gsc || (o == gsc && g2 < G)) ? 1 : 0; }
        const float kth = wave_max(rank == 3 ? gsc : NEG);
        const float masked = (gsc >= kth) ? bs : NEG;
        int rk = 0;
#pragma unroll
        for (int j = 0; j < 64; ++j) { const float o = readlane_f(masked, j); rk += (o > masked || (o == masked && j < lane)) ? 1 : 0; }
        const bool sel = rk < 8;
        const float tot = wave_sum(sel ? sc : 0.f);
        if (sel) {
            wl[(tok - t0) * 8 + rk] = lane | (cnt << 6);
            p.tope[tok * 8 + rk] = lane; p.gatew[tok * 8 + rk] = sc / tot * 2.5f;
            ++cnt;
        }
    }
    if (seg0 < t1) flush(seg0, t1, curb);
}
__device__ __forceinline__ void job_tiles(const Params& p, int l, int b, int* s_int) {
    const int tid = otid();
    const int* cnt = p.moe_cnt + (l * 8 + b) * 64;
    if (tid < 64) {
        int* ue = p.up_e + b * UPU_STRIDE; int* ur = p.up_row + b * UPU_STRIDE;
        const int n256 = (cnt[tid] + 255) >> 8;
        const int incl = scan_sum_i(n256, tid), k0 = incl - n256, t = 2 * k0;
        s_int[tid] = t;
        for (int u = 0; u < n256; ++u) { ue[k0 + u] = tid; ur[k0 + u] = (t + 2 * u) * MOE_BM; }
        const int ktot = __builtin_amdgcn_readlane(incl, 63), ttot = 2 * ktot;
        if (tid == 63) { s_int[64] = ttot; p.up_n[b] = ktot + SQ / 256; p.ntb[b * 2] = ttot + SQ / MOE_BM; p.ntb[b * 2 + 1] = ttot * MOE_BM; }
        if (tid < SQ / 256) { ue[ktot + tid] = 64; ur[ktot + tid] = (ttot + 2 * tid) * MOE_BM; }
    }
    __syncthreads();
    if (tid < 64) { for (int t = s_int[tid]; t < s_int[tid + 1]; ++t) p.tile_e[b * MOE_TILES + t] = ((t - s_int[tid]) * MOE_BM < cnt[tid]) ? tid : -1; }
    const int t0 = s_int[64];
    if (tid < SQ / MOE_BM) p.tile_e[b * MOE_TILES + t0 + tid] = 64;
    if (tid < 8) {
        int* lst = p.xl_tile + (size_t)(b * 8 + tid) * XL_STRIDE; int k = 0;
        for (int e = tid; e < 64; e += 8) for (int t = s_int[e]; t < s_int[e + 1]; ++t) if ((t - s_int[e]) * MOE_BM < cnt[e]) lst[k++] = t;
        for (int j = tid; j < SQ / MOE_BM; j += 8) lst[k++] = t0 + j;
        p.xl_cnt[b * 8 + tid] = k;
    }
    __syncthreads();
}
__device__ __forceinline__ void job_slots(const Params& p, int l, int item, int* s_int) {
    (void)item;
    const int tid = otid();
    const int G = gridDim.x, t0 = (int)(((long)NTOK * blockIdx.x) / G), t1 = (int)(((long)NTOK * (blockIdx.x + 1)) / G);
    int cb = -1, base = t0;
    while (base < t1) {
        const int b = base / SQ;
        const int lim = t1 < (b + 1) * SQ ? t1 : (b + 1) * SQ;
        const int cnt = (lim - base) < 64 ? (lim - base) : 64;
        if (b != cb) {
            __syncthreads();
            if (tid < 64) {
                const int n = 2 * ((p.moe_cnt[(l * 8 + b) * 64 + tid] + 255) >> 8);
                const int incl = scan_sum_i(n, tid);
                s_int[tid] = (incl - n) * MOE_BM;
                if (tid == 63) s_int[64] = incl * MOE_BM;
            }
            __syncthreads();
            cb = b;
        }
        const int tok = base + (tid >> 3), k = tid & 7;
        if ((tid >> 3) < cnt && !(l == 1 && tok - b * SQ < CTXL)) {
            const int e = p.tope[tok * 8 + k];
            const int slot = s_int[e] + p.pos[tok * 8 + k];
            p.slottok[(size_t)b * MOE_SLOTS + slot] = tok;
            p.slotgate[(size_t)b * MOE_SLOTS + slot] = p.gatew[tok * 8 + k];
            p.tokslot[tok * 8 + k] = slot;
            if (k == 0) {
                const int s = tok - b * SQ, sl2 = s_int[64] + s;
                p.slottok[(size_t)b * MOE_SLOTS + sl2] = tok;
                p.slotgate[(size_t)b * MOE_SLOTS + sl2] = 1.f;
            }
        }
        base += cnt;
    }
    __syncthreads();
}

#define AT_KROW 208
#define AT_VROW 136
#define AT_BUF (64 * AT_KROW + 64 * AT_VROW)
template <int VAR>
__device__ __forceinline__ void attn_item(const Params& p, int bh, int qt, char* smem) {
    const int tid = otid(), lane = tid & 63, wave = tid >> 6, r = lane & 31, h = lane >> 5;
    const int nkt = (qt == 0) ? (CTXL / 64) : (SQ / 64);
    const int s = qt * 256 + wave * 32 + r;
    const bf16* qrow = p.q + ((size_t)(bh >> 3) * SQ + s) * 768 + (bh & 7) * 96;
    bf16x8 qf[6];
#pragma unroll
    for (int ks = 0; ks < 6; ++ks) qf[ks] = *(const bf16x8*)(qrow + ks * 16 + h * 8);
    const bf16* kbase = p.kf + (size_t)bh * SQ * 96;
    const bf16* vbase = p.vt + (size_t)bh * 64 * SQ;
    const int kkey0 = tid / 12, kpart0 = tid % 12, kkey1 = (tid + 512) / 12, kpart1 = (tid + 512) % 12;
    const int vd = tid >> 3, vpart = tid & 7;
    u32x4 rk0, rk1 = {0u, 0u, 0u, 0u}, rv;
    auto gload = [&](int t) {
        const bf16* kb = kbase + (size_t)t * 64 * 96;
        rk0 = *(const u32x4*)(kb + tid * 8);
        if (tid < 256) rk1 = *(const u32x4*)(kb + (tid + 512) * 8);
        rv = *(const u32x4*)(vbase + (size_t)vd * SQ + t * 64 + vpart * 8);
    };
    auto lstore = [&](int buf) {
        char* base = smem + buf * AT_BUF;
        *(u32x4*)(base + kkey0 * AT_KROW + kpart0 * 16) = rk0;
        if (tid < 256) *(u32x4*)(base + kkey1 * AT_KROW + kpart1 * 16) = rk1;
        char* vb = base + 64 * AT_KROW + vd * AT_VROW + vpart * 16;
        u32x2 a = {rv[0], rv[1]}, b2 = {rv[2], rv[3]};
        *(u32x2*)vb = a; *(u32x2*)(vb + 8) = b2;
    };
    f32x16 o[2];
#pragma unroll
    for (int d = 0; d < 2; ++d)
#pragma unroll
        for (int q = 0; q < 16; ++q) o[d][q] = 0.f;
    float m = -1e30f;
    f32x16 lacc;
#pragma unroll
    for (int q = 0; q < 16; ++q) lacc[q] = 0.f;
    const u32x4 ones4 = {0x3F803F80u, 0x3F803F80u, 0x3F803F80u, 0x3F803F80u};
    const bf16x8 onesf = (bf16x8)ones4;
    gload(0);
    __syncthreads();
    lstore(0);
    __syncthreads();
    for (int t = 0; t < nkt; ++t) {
        if (t + 1 < nkt) gload(t + 1);
        const char* base = smem + (t & 1) * AT_BUF;
        f32x16 sacc[2];
        bf16x8 kfr[2][6];
#pragma unroll
        for (int kb = 0; kb < 2; ++kb)
#pragma unroll
            for (int ks = 0; ks < 6; ++ks) kfr[kb][ks] = *(const bf16x8*)(base + (kb * 32 + r) * AT_KROW + ks * 32 + h * 16);
        asm volatile("" ::: "memory");
#pragma unroll
        for (int kb = 0; kb < 2; ++kb)
#pragma unroll
            for (int q = 0; q < 16; ++q) sacc[kb][q] = 0.f;
#pragma unroll
        for (int ks = 0; ks < 6; ++ks) {
            sacc[0] = MFMA32(kfr[0][ks], qf[ks], sacc[0]);
            sacc[1] = MFMA32(kfr[1][ks], qf[ks], sacc[1]);
        }
        const char* vb = base + 64 * AT_KROW;
        bf16x8 vfr[2][2][2];
#pragma unroll
        for (int kb = 0; kb < 2; ++kb)
#pragma unroll
            for (int s2 = 0; s2 < 2; ++s2)
#pragma unroll
                for (int d = 0; d < 2; ++d) {
                    const char* a = vb + (d * 32 + r) * AT_VROW + (kb * 32 + 16 * s2 + 4 * h) * 2;
                    const u32x2 lo = *(const u32x2*)a, hi = *(const u32x2*)(a + 16);
                    u32x4 t4 = {lo[0], lo[1], hi[0], hi[1]};
                    vfr[d][kb][s2] = (bf16x8)t4;
                }
        asm volatile("" ::: "memory");
        float mx = fmaxf(sacc[0][0], sacc[1][0]);
        if (VAR != 1) {
#pragma unroll
        for (int q = 1; q < 16; ++q) mx = fmaxf(fmaxf(mx, sacc[0][q]), sacc[1][q]);
        {
            typedef unsigned u2_t __attribute__((ext_vector_type(2)));
            const u2_t sw = __builtin_amdgcn_permlane32_swap(__float_as_uint(mx), __float_as_uint(mx), false, false);
            mx = fmaxf(__uint_as_float(sw[0]), __uint_as_float(sw[1]));
        }
        }
        if (VAR != 1 && __any(mx > m + 8.f)) {
            const float mn = fmaxf(m, mx), alpha = fexp2(m - mn);
            m = mn; lacc[0] *= alpha;
#pragma unroll
            for (int d = 0; d < 2; ++d)
#pragma unroll
                for (int q = 0; q < 16; ++q) o[d][q] *= alpha;
        }
        bf16x8 pf[2][2];
#pragma unroll
        for (int kb = 0; kb < 2; ++kb) {
#pragma unroll
            for (int q = 0; q < 16; ++q) if (VAR != 1) sacc[kb][q] = fexp2(sacc[kb][q] - m);
#pragma unroll
            for (int s2 = 0; s2 < 2; ++s2) {
                u32x4 t4 = {pk2(sacc[kb][8 * s2], sacc[kb][8 * s2 + 1]), pk2(sacc[kb][8 * s2 + 2], sacc[kb][8 * s2 + 3]),
                            pk2(sacc[kb][8 * s2 + 4], sacc[kb][8 * s2 + 5]), pk2(sacc[kb][8 * s2 + 6], sacc[kb][8 * s2 + 7])};
                pf[kb][s2] = (bf16x8)t4;
            }
        }
#pragma unroll
        for (int kb = 0; kb < 2; ++kb)
#pragma unroll
            for (int s2 = 0; s2 < 2; ++s2) {
                lacc = MFMA32(onesf, pf[kb][s2], lacc);
                o[0] = MFMA32(vfr[0][kb][s2], pf[kb][s2], o[0]);
                o[1] = MFMA32(vfr[1][kb][s2], pf[kb][s2], o[1]);
            }
        if (t + 1 < nkt) lstore((t + 1) & 1);
        __syncthreads();
    }
    const float inv = 1.f / lacc[0];
    const int b = bh >> 3, hd = bh & 7;
    bf16* orow = (VAR == 0 ? p.cat : p.yc) + ((size_t)b * SQ + s) * 1024 + 256 + hd * 64;
#pragma unroll
    for (int d = 0; d < 2; ++d)
#pragma unroll
        for (int g = 0; g < 4; ++g) st_bf4(orow + d * 32 + 8 * g + 4 * h, o[d][4 * g] * inv, o[d][4 * g + 1] * inv, o[d][4 * g + 2] * inv, o[d][4 * g + 3] * inv);
}

__device__ __forceinline__ void attn_item64(const Params& p, int bh, int qt, char* smem) {
    const int tid = otid(), lane = tid & 63, wave = tid >> 6, r = lane & 31, h = lane >> 5;
    const int nkt = SQ / 64;
    const int s0 = CTXL + qt * 512 + wave * 64 + r;
    bf16x8 qf[2][6];
#pragma unroll
    for (int qb = 0; qb < 2; ++qb) {
        const bf16* qrow = p.q + ((size_t)(bh >> 3) * SQ + s0 + qb * 32) * 768 + (bh & 7) * 96;
#pragma unroll
        for (int ks = 0; ks < 6; ++ks) qf[qb][ks] = *(const bf16x8*)(qrow + ks * 16 + h * 8);
    }
    const bf16* kbase = p.kf + (size_t)bh * SQ * 96;
    const bf16* vbase = p.vt + (size_t)bh * 64 * SQ;
    const int ko1 = 8192 + tid * 8;
    u32x4 rk0, rv; u32x2 rk1;
    auto gload = [&](int t) {
        const char* kb = (const char*)(kbase + (size_t)t * 64 * 96);
        rk0 = *(const u32x4*)(kb + tid * 16);
        rk1 = *(const u32x2*)(kb + ko1);
        rv = *(const u32x4*)(vbase + (size_t)(tid >> 3) * SQ + t * 64 + (tid & 7) * 8);
    };
    auto lstore = [&](int buf) {
        char* base = smem + buf * AT_BUF;
        *(u32x4*)(base + (tid / 12) * AT_KROW + (tid % 12) * 16) = rk0;
        *(u32x2*)(base + (ko1 / 192) * AT_KROW + (ko1 % 192)) = rk1;
        char* vb = base + 64 * AT_KROW + (tid >> 3) * AT_VROW + (tid & 7) * 16;
        u32x2 a = {rv[0], rv[1]}, b2 = {rv[2], rv[3]};
        *(u32x2*)vb = a; *(u32x2*)(vb + 8) = b2;
    };
    f32x16 o[2][2];
#pragma unroll
    for (int qb = 0; qb < 2; ++qb)
#pragma unroll
        for (int d = 0; d < 2; ++d)
#pragma unroll
            for (int q = 0; q < 16; ++q) o[qb][d][q] = 0.f;
    float m[2] = {-1e30f, -1e30f}, lsum[2] = {0.f, 0.f};
    gload(0);
    __syncthreads();
    lstore(0);
    __syncthreads();
    for (int t = 0; t < nkt; ++t) {
        if (t + 1 < nkt) gload(t + 1);
        const char* base = smem + (t & 1) * AT_BUF;
        f32x16 sacc[2][2];
#pragma unroll
        for (int kb = 0; kb < 2; ++kb) {
            bf16x8 kfr[6];
#pragma unroll
            for (int ks = 0; ks < 6; ++ks) kfr[ks] = *(const bf16x8*)(base + (kb * 32 + r) * AT_KROW + ks * 32 + h * 16);
#pragma unroll
            for (int qb = 0; qb < 2; ++qb)
#pragma unroll
                for (int q = 0; q < 16; ++q) sacc[qb][kb][q] = 0.f;
#pragma unroll
            for (int ks = 0; ks < 6; ++ks) {
                sacc[0][kb] = MFMA32(kfr[ks], qf[0][ks], sacc[0][kb]);
                sacc[1][kb] = MFMA32(kfr[ks], qf[1][ks], sacc[1][kb]);
            }
        }
        bf16x8 pf[2][2][2];
#pragma unroll
        for (int qb = 0; qb < 2; ++qb) {
            float mx = fmaxf(sacc[qb][0][0], sacc[qb][1][0]);
#pragma unroll
            for (int q = 1; q < 16; ++q) mx = fmaxf(fmaxf(mx, sacc[qb][0][q]), sacc[qb][1][q]);
            {
                typedef unsigned u2_t __attribute__((ext_vector_type(2)));
                const u2_t sw = __builtin_amdgcn_permlane32_swap(__float_as_uint(mx), __float_as_uint(mx), false, false);
                mx = fmaxf(__uint_as_float(sw[0]), __uint_as_float(sw[1]));
            }
            if (__any(mx > m[qb] + 8.f)) {
                const float mn = fmaxf(m[qb], mx), alpha = fexp2(m[qb] - mn);
                m[qb] = mn; lsum[qb] *= alpha;
#pragma unroll
                for (int d = 0; d < 2; ++d)
#pragma unroll
                    for (int q = 0; q < 16; ++q) o[qb][d][q] *= alpha;
            }
#pragma unroll
            for (int kb = 0; kb < 2; ++kb) {
#pragma unroll
                for (int q = 0; q < 16; ++q) { const float e = fexp2(sacc[qb][kb][q] - m[qb]); sacc[qb][kb][q] = e; lsum[qb] += e; }
#pragma unroll
                for (int s2 = 0; s2 < 2; ++s2) {
                    u32x4 t4 = {pk2(sacc[qb][kb][8 * s2], sacc[qb][kb][8 * s2 + 1]), pk2(sacc[qb][kb][8 * s2 + 2], sacc[qb][kb][8 * s2 + 3]),
                                pk2(sacc[qb][kb][8 * s2 + 4], sacc[qb][kb][8 * s2 + 5]), pk2(sacc[qb][kb][8 * s2 + 6], sacc[qb][kb][8 * s2 + 7])};
                    pf[qb][kb][s2] = (bf16x8)t4;
                }
            }
        }
        const char* vb = base + 64 * AT_KROW;
#pragma unroll
        for (int kb = 0; kb < 2; ++kb)
#pragma unroll
            for (int s2 = 0; s2 < 2; ++s2)
#pragma unroll
                for (int d = 0; d < 2; ++d) {
                    const char* a = vb + (d * 32 + r) * AT_VROW + (kb * 32 + 16 * s2 + 4 * h) * 2;
                    const u32x2 lo = *(const u32x2*)a, hi = *(const u32x2*)(a + 16);
                    u32x4 t4 = {lo[0], lo[1], hi[0], hi[1]};
                    const bf16x8 vf = (bf16x8)t4;
                    o[0][d] = MFMA32(vf, pf[0][kb][s2], o[0][d]);
                    o[1][d] = MFMA32(vf, pf[1][kb][s2], o[1][d]);
                }
        if (t + 1 < nkt) lstore((t + 1) & 1);
        __syncthreads();
    }
    const int b = bh >> 3, hd = bh & 7;
    char* st = smem + 2 * AT_BUF + wave * (64 * 144);
#pragma unroll
    for (int qb = 0; qb < 2; ++qb) {
        float l = lsum[qb]; l += __shfl_xor(l, 32, 64);
        const float inv = 1.f / l;
#pragma unroll
        for (int d = 0; d < 2; ++d)
#pragma unroll
            for (int g = 0; g < 4; ++g) {
                u32x2 v; v[0] = pk2(o[qb][d][4 * g] * inv, o[qb][d][4 * g + 1] * inv); v[1] = pk2(o[qb][d][4 * g + 2] * inv, o[qb][d][4 * g + 3] * inv);
                *(u32x2*)(st + (qb * 32 + r) * 144 + (d * 32 + 8 * g + 4 * h) * 2) = v;
            }
    }
    __builtin_amdgcn_wave_barrier();
    bf16* obase = p.cat + ((size_t)b * SQ + CTXL + qt * 512 + wave * 64) * 1024 + 256 + hd * 64;
#pragma unroll
    for (int it = 0; it < 8; ++it) {
        const int row = it * 8 + (lane >> 3), c8 = lane & 7;
        const u32x4 v = *(const u32x4*)(st + row * 144 + c8 * 16);
        *(u32x4*)(obase + (size_t)row * 1024 + c8 * 8) = v;
    }
    __builtin_amdgcn_wave_barrier();
}

#define ML_ROWB 144
__device__ __forceinline__ float logsigmoid_(float x) { return fminf(x, 0.f) - log1pf(expf(-fabsf(x))); }
__device__ __forceinline__ float scan_sum(float v, int lane) { (void)lane; return dpp_scan_sum(v); }
__device__ __forceinline__ float scan_max(float v, int lane) { (void)lane; return dpp_scan_max(v); }
#define MLA_SLOT (64 * ML_ROWB + 96 * ML_ROWB + 256)
__device__ __forceinline__ void phase_ml_a(const Params& p, int l, int item, char* smem) {
    const int tid = otid(), lane = tid & 63, us = tid >> 7, tl = tid & 127, hw = (tid >> 6) & 1, r = lane & 31, h = lane >> 5;
    const int u = item * 4 + us;
    const int c = u % NCH, dir = (u / NCH) & 1, hd = (u / (NCH * 2)) & 3, b = u / (NCH * 8);
    const int tok0 = b * SQ + c * 64;
    char* sl = smem + us * MLA_SLOT;
    bf16* s_kt = (bf16*)sl; bf16* s_vt = (bf16*)(sl + 64 * ML_ROWB); float* s_e = (float*)(sl + 160 * ML_ROWB);
    const int pq = tl >> 3, part = tl & 7;
    u32x4 kv[4], vv[4];
#pragma unroll
    for (int i = 0; i < 4; ++i) {
        const int pos = pq * 4 + i;
        kv[i] = *(const u32x4*)(p.qkc + (size_t)(tok0 + pos) * 512 + 256 + hd * 64 + part * 8);
        vv[i] = *(const u32x4*)(p.z + (size_t)(tok0 + pos) * ZW + Z_MLV + hd * 64 + part * 8);
    }
    if (hw == 0) {
        const int pos = dir ? 63 - lane : lane, tok = tok0 + pos;
        const float gi = p.gates[(size_t)tok * 16 + dir * 4 + hd] + p.gate_b[l * 16 + dir * 4 + hd];
        const float gf = p.gates[(size_t)tok * 16 + 8 + dir * 4 + hd] + p.gate_b[l * 16 + 8 + dir * 4 + hd];
        const float bc = scan_sum(logsigmoid_(gf), lane);
        const float bl = readlane_f(bc, 63);
        const float we = bl - bc + gi;
        const float ml = wave_max(we);
        s_e[pos] = expf(we - ml);
        if (lane == 0) { p.mlstat[(size_t)u * 4] = ml; p.mlstat[(size_t)u * 4 + 1] = bl; }
    }
    __syncthreads();
    {
        float e[4];
#pragma unroll
        for (int i = 0; i < 4; ++i) e[i] = s_e[pq * 4 + i];
#pragma unroll
        for (int j = 0; j < 8; ++j) {
            float kx[4]; unsigned vx[4];
#pragma unroll
            for (int i = 0; i < 4; ++i) {
                const unsigned kw = kv[i][j >> 1], vw = vv[i][j >> 1];
                kx[i] = ((j & 1) ? bfhi(kw) : bflo(kw)) * e[i];
                vx[i] = (j & 1) ? (vw >> 16) : (vw & 0xffffu);
            }
            u32x2 ko = {pk2(kx[0], kx[1]), pk2(kx[2], kx[3])};
            u32x2 vo = {vx[0] | (vx[1] << 16), vx[2] | (vx[3] << 16)};
            *(u32x2*)((char*)s_kt + (part * 8 + j) * ML_ROWB + pq * 8) = ko;
            *(u32x2*)((char*)s_vt + (part * 8 + j) * ML_ROWB + pq * 8) = vo;
        }
    }
    if (tl < 64) s_vt[64 * 72 + tl] = 0x3F80;
    __syncthreads();
    f32x16 acc[3];
#pragma unroll
    for (int rt = 0; rt < 3; ++rt)
#pragma unroll
        for (int q = 0; q < 16; ++q) acc[rt][q] = 0.f;
#pragma unroll
    for (int ks = 0; ks < 4; ++ks) {
        const bf16x8 ktf = *(const bf16x8*)((const char*)s_kt + (hw * 32 + r) * ML_ROWB + ks * 32 + h * 16);
#pragma unroll
        for (int rt = 0; rt < 3; ++rt) {
            const bf16x8 vtf = *(const bf16x8*)((const char*)s_vt + (rt * 32 + r) * ML_ROWB + ks * 32 + h * 16);
            acc[rt] = MFMA32(vtf, ktf, acc[rt]);
        }
    }
    bf16* cl = p.cloc + (size_t)u * CLOC_STRIDE;
#pragma unroll
    for (int rt = 0; rt < 2; ++rt)
#pragma unroll
        for (int q = 0; q < 16; ++q) { const int d = rt * 32 + (q & 3) + 8 * (q >> 2) + 4 * h; cl[d * 64 + hw * 32 + r] = f2bf(acc[rt][q]); }
    if (h == 0) cl[64 * 64 + hw * 32 + r] = f2bf(acc[2][0]);
}
#define MLC_SLOT (64 * ML_ROWB + 64 * ML_ROWB + 96 * ML_ROWB + 1024)
__device__ __forceinline__ void phase_ml_c(const Params& p, int l, int item, char* smem) {
    const int tid = otid(), lane = tid & 63, us = tid >> 7, tl = tid & 127, hw = (tid >> 6) & 1, r = lane & 31, h = lane >> 5;
    const int pair = us >> 1, dir = us & 1, pr = item * 2 + pair;
    const int c = pr % NCH, hd = (pr / NCH) & 3, b = pr / (NCH * 4);
    const int u = ((b * 4 + hd) * 2 + dir) * NCH + c;
    const int tok0 = b * SQ + c * 64;
    char* sl = smem + us * MLC_SLOT;
    char* s_k = sl; char* s_vt = sl + 64 * ML_ROWB; char* s_ci = sl + 128 * ML_ROWB;
    float* s_bm = (float*)(sl + 224 * ML_ROWB); float* s_a1 = s_bm + 64; float* s_wi = s_bm + 128; float* s_em = s_bm + 192;
    {
        const int pq = tl >> 3, part = tl & 7;
        u32x4 vv[4];
#pragma unroll
        for (int i = 0; i < 4; ++i) {
            const int pos = pq * 4 + i;
            const u32x4 kv = *(const u32x4*)(p.qkc + (size_t)(tok0 + pos) * 512 + 256 + hd * 64 + part * 8);
            *(u32x4*)(s_k + pos * ML_ROWB + part * 16) = kv;
            vv[i] = *(const u32x4*)(p.z + (size_t)(tok0 + pos) * ZW + Z_MLV + hd * 64 + part * 8);
        }
#pragma unroll
        for (int j = 0; j < 8; ++j) {
            unsigned vx[4];
#pragma unroll
            for (int i = 0; i < 4; ++i) { const unsigned vw = vv[i][j >> 1]; vx[i] = (j & 1) ? (vw >> 16) : (vw & 0xffffu); }
            u32x2 vo = {vx[0] | (vx[1] << 16), vx[2] | (vx[3] << 16)};
            *(u32x2*)(s_vt + (part * 8 + j) * ML_ROWB + pq * 8) = vo;
        }
    }
#pragma unroll
    for (int q = 0; q < 5; ++q) {
        const int idx = tl + 128 * q;
        if (idx < 520) { const int row = idx >> 3, part = idx & 7; *(u32x4*)(s_ci + row * ML_ROWB + part * 16) = *(const u32x4*)(p.cloc + (size_t)u * CLOC_STRIDE + row * 64 + part * 8); }
    }
    const int t = hw * 32 + r;
    bf16x8 qf[4];
#pragma unroll
    for (int ks = 0; ks < 4; ++ks) qf[ks] = *(const bf16x8*)(p.qkc + (size_t)(tok0 + t) * 512 + hd * 64 + ks * 16 + h * 8);
    if (hw == 0) {
        const int pos = dir ? 63 - lane : lane, tok = tok0 + pos;
        const float gi = p.gates[(size_t)tok * 16 + dir * 4 + hd] + p.gate_b[l * 16 + dir * 4 + hd];
        const float gf = p.gates[(size_t)tok * 16 + 8 + dir * 4 + hd] + p.gate_b[l * 16 + 8 + dir * 4 + hd];
        const float bc = scan_sum(logsigmoid_(gf), lane);
        const float a1 = gi - bc;
        const float pm = scan_max(a1, lane);
        const float li = bc + p.mlstat[(size_t)u * 4 + 2];
        const float mt = fmaxf(li, bc + pm);
        s_bm[pos] = (bc - mt) * LOG2E; s_a1[pos] = a1 * LOG2E; s_wi[pos] = expf(li - mt); s_em[pos] = expf(-mt);
    }
    __syncthreads();
    f32x16 sacc[2];
#pragma unroll
    for (int sb = 0; sb < 2; ++sb) {
#pragma unroll
        for (int q = 0; q < 16; ++q) sacc[sb][q] = 0.f;
#pragma unroll
        for (int ks = 0; ks < 4; ++ks) sacc[sb] = MFMA32(*(const bf16x8*)(s_k + (sb * 32 + r) * ML_ROWB + ks * 32 + h * 16), qf[ks], sacc[sb]);
    }
    const float bt = s_bm[t], wi = s_wi[t], em = s_em[t];
    float dsum = 0.f;
    bf16x8 pf[2][2];
#pragma unroll
    for (int sb = 0; sb < 2; ++sb) {
#pragma unroll
        for (int q = 0; q < 16; ++q) {
            const int sp = sb * 32 + (q & 3) + 8 * (q >> 2) + 4 * h;
            const bool valid = dir ? (sp >= t) : (sp <= t);
            const float v = valid ? sacc[sb][q] * fexp2(bt + s_a1[sp]) : 0.f;
            sacc[sb][q] = v; dsum += v;
        }
#pragma unroll
        for (int s2 = 0; s2 < 2; ++s2) {
            u32x4 t4 = {pk2(sacc[sb][8 * s2], sacc[sb][8 * s2 + 1]), pk2(sacc[sb][8 * s2 + 2], sacc[sb][8 * s2 + 3]),
                        pk2(sacc[sb][8 * s2 + 4], sacc[sb][8 * s2 + 5]), pk2(sacc[sb][8 * s2 + 6], sacc[sb][8 * s2 + 7])};
            pf[sb][s2] = (bf16x8)t4;
        }
    }
    f32x16 an[3];
#pragma unroll
    for (int rt = 0; rt < 3; ++rt) {
#pragma unroll
        for (int q = 0; q < 16; ++q) an[rt][q] = 0.f;
#pragma unroll
        for (int ks = 0; ks < 4; ++ks) an[rt] = MFMA32(*(const bf16x8*)(s_ci + (rt * 32 + r) * ML_ROWB + ks * 32 + h * 16), qf[ks], an[rt]);
    }
#pragma unroll
    for (int rt = 0; rt < 2; ++rt)
#pragma unroll
        for (int q = 0; q < 16; ++q) an[rt][q] *= wi;
    const float ninq = __shfl(an[2][0], r, 64);
#pragma unroll
    for (int d = 0; d < 2; ++d)
#pragma unroll
        for (int sb = 0; sb < 2; ++sb)
#pragma unroll
            for (int s2 = 0; s2 < 2; ++s2) {
                const char* a = s_vt + (d * 32 + r) * ML_ROWB + (sb * 32 + 16 * s2 + 4 * h) * 2;
                const u32x2 lo = *(const u32x2*)a, hi = *(const u32x2*)(a + 16);
                u32x4 t4 = {lo[0], lo[1], hi[0], hi[1]};
                an[d] = MFMA32((bf16x8)t4, pf[sb][s2], an[d]);
            }
    dsum += __shfl_xor(dsum, 32, 64);
    const float den = dsum + wi * ninq;
    const float inv = 1.f / fmaxf(fabsf(den), em);
    __syncthreads();
    float* hs = (float*)(smem + pair * 2 * MLC_SLOT) + dir * 64 * 65;
#pragma unroll
    for (int d = 0; d < 2; ++d)
#pragma unroll
        for (int q = 0; q < 16; ++q) { const int dd = d * 32 + (q & 3) + 8 * (q >> 2) + 4 * h; hs[t * 65 + dd] = an[d][q] * inv; }
    __syncthreads();
    {
        const int tp = tid & 255, tt = tp >> 2, qd = tp & 3;
        const float* h0 = (const float*)(smem + pair * 2 * MLC_SLOT) + tt * 65 + qd * 16;
        const bf16* orow = p.z + (size_t)(tok0 + tt) * ZW + Z_MLO + hd * 64 + qd * 16;
        const u32x4 o0 = *(const u32x4*)orow, o1 = *(const u32x4*)(orow + 8);
        float v[16]; float sm = 0.f;
#pragma unroll
        for (int j = 0; j < 16; ++j) {
            const unsigned w = j < 8 ? o0[j >> 1] : o1[(j - 8) >> 1];
            const float og = (j & 1) ? bfhi(w) : bflo(w);
            v[j] = sigmoidf_(og) * (h0[j] + h0[64 * 65 + j]); sm += v[j];
        }
        sm += __shfl_xor(sm, 1, 64); sm += __shfl_xor(sm, 2, 64);
        const float mu = sm * (1.f / 64.f);
        float vq = 0.f;
#pragma unroll
        for (int j = 0; j < 16; ++j) { v[j] -= mu; vq += v[j] * v[j]; }
        vq += __shfl_xor(vq, 1, 64); vq += __shfl_xor(vq, 2, 64);
        const float rs = rsqrtf(vq * (1.f / 64.f) + LN_EPS);
        const float* ng = p.ml_norm_g + l * 256 + hd * 64 + qd * 16;
        bf16* dst = p.cat + (size_t)(tok0 + tt) * 1024 + 768 + hd * 64 + qd * 16;
#pragma unroll
        for (int j = 0; j < 16; j += 4) st_bf4(dst + j, v[j] * rs * ng[j], v[j + 1] * rs * ng[j + 1], v[j + 2] * rs * ng[j + 2], v[j + 3] * rs * ng[j + 3]);
    }
}

#define PROBE_REPEAT 0
#ifndef DBG_STOP
#define DBG_STOP 0
#endif
#ifndef DBG_L
#define DBG_L 0
#endif
__device__ __forceinline__ void dbg_scan(const Params& p, const void* base, size_t rows, size_t stride, size_t c0, size_t c1, bool isbf, int bit = 0) {
    const size_t cpr = (c1 - c0) >> 4, total = rows * cpr;
    unsigned cs = 0, nf = 0;
    for (size_t i = (size_t)blockIdx.x * 512 + threadIdx.x; i < total; i += (size_t)gridDim.x * 512) {
        const size_t r = i / cpr, c = i - r * cpr;
        const u32x4 v = *(const u32x4*)((const char*)base + r * stride + c0 + c * 16);
#pragma unroll
        for (int k = 0; k < 4; ++k) {
            const unsigned w = v[k]; cs += w * 2654435761u + (w >> 7);
            if (isbf) { if ((w & 0x7F80u) >= 0x4480u || ((w >> 16) & 0x7F80u) >= 0x4480u) ++nf; }
            else { if ((w & 0x7F800000u) >= 0x44800000u) ++nf; }
        }
    }
    atomicAdd(&p.ctr[250], cs); if (nf) atomicOr(&p.ctr[251], 1u << bit);
}
#define SMEM_HDR 512
#define SMEM_BYTES (SMEM_HDR + 6 * ASTAT_SLAB + 8 * 32 * STG_ROWB)
#define NCTR 512

typedef const Params __attribute__((address_space(4)))* kparams_t;
__device__ __forceinline__ const Params& fresh_params() {
    kparams_t q = (kparams_t)__builtin_amdgcn_kernarg_segment_ptr();
    asm volatile("" : "+s"(q));
    return *(const Params*)q;
}
#define STAGE_BEGIN { const Params& p = fresh_params();
#define STAGE_END }
extern "C" __global__ void __launch_bounds__(512) mega_kernel(Params p_in) {
    (void)p_in;
    extern __shared__ __attribute__((aligned(16))) char smem_raw[];
    int* s_item = (int*)(smem_raw + 16);
    int* s_int = (int*)(smem_raw + 64);
    char* sm = smem_raw + SMEM_HDR;
    if (threadIdx.x == 0) *(uint4*)smem_raw = make_uint4(0u, 0u, 0u, 0u);
    __syncthreads();
    XcdBarrier bar = xcd_barrier_post(fresh_params().bar, (volatile LAS unsigned*)smem_raw);

    STAGE_BEGIN
    run_items(p.ctr + 0, 192, s_item, [&](int it) { job_modv(p, it, sm); });
    run_items(p.ctr + 1, 1, s_item, [&](int) { job_rope_tab(p); });
    run_items(p.ctr + 2, 64, s_item, [&](int it) { job_s5_tables(p, it, sm); });
    STAGE_END
    xcd_barrier(bar);

#if DBG_STOP
#define DBG_CHECK(N) if (DBG_STOP == (N) && l == DBG_L) break;
#else
#define DBG_CHECK(N)
#endif
    for (int l = 0; l < 2; ++l) {
        unsigned* C = fresh_params().ctr + 8 + l * 64;
        if (l == 0) {
            STAGE_BEGIN
            run_items(C + 0, CVT_SMALL, s_item, [&](int it) { job_cvt_small(p, 0, it, sm); });
            run_items(C + 1, 1024, s_item, [&](int it) { job_s5_expand(p, 0, it); });
            phase_ln_mod(p, 0, 0);
            STAGE_END
            xcd_barrier(bar);
        }
        DBG_CHECK(1)
        STAGE_BEGIN
        {
            g8::GridOrder S8; S8.A = (const char*)p.h; S8.Bt = (const char*)p.bt_in; S8.K = 1024; S8.nM = NTOK / 256; S8.nN = 7; S8.nwg = S8.nM * S8.nN; S8.G = (int)gridDim.x; S8.c = (int)blockIdx.x; S8.skipctx = 0;
            EpiInproj8 e8; e8.ug = p.ug; e8.z = p.z; e8.gates = p.gates;
            __syncthreads();
            g8::gemm_phase<false, true>((LAS unsigned char*)sm, 1024, S8, e8);
        }
        STAGE_END
        xcd_barrier(bar);
        DBG_CHECK(2)
        STAGE_BEGIN
        run_items(C + 4, 16 * 9 * 2, s_item, [&](int it) {
            const int g = it / 18, r = it % 18, mt = r >> 1, nt = r & 1;
            const Seg sg[1] = {{p.ug + (size_t)g * NROWP * 1024, p.gg + (size_t)g * 256 * 1024, 1024, 1024, 1024}};
            EpiF32 e; e.C = p.ff + (size_t)g * NROWP * 256; e.ldc = 256; e.mvalid = NROW; e.nvalid = 256;
            gemm_tile<128, 1>(sg, nullptr, mt * 128, nt * 128, e, sm);
        });
        phase_post_inproj(p, l, 0);
        STAGE_END
        xcd_barrier(bar);
        DBG_CHECK(3)
        STAGE_BEGIN
        run_items(C + 6, 32, s_item, [&](int it) { job_s5_carry(p, l, it); });
        run_items(C + 7, NUNIT / 4, s_item, [&](int it) { phase_ml_a(p, l, it, sm); });
        run_items(C + 8, NTOK / 128, s_item, [&](int mt) {
            EpiQ e; e.rq = p.rq; e.tab = p.rope_tab; e.q = p.q; e.stg = sm + 6 * ASTAT_SLAB;
            gemm_astat<4>(p.z + Z_QC, ZW, nullptr, mt * 128, p.bt_q, 256, 6, e, sm);
        });
        run_items(C + 9, NTOK / 128, s_item, [&](int mt) {
            EpiKV e; e.rkv = p.rkv; e.kf = p.kf; e.vt = p.vt; e.stg = sm + 6 * ASTAT_SLAB;
            gemm_astat<2>(p.z + Z_KVC, ZW, nullptr, mt * 128, p.bt_kv, 128, 8, e, sm);
        });
        STAGE_END
        xcd_barrier(bar);
        DBG_CHECK(4)
        STAGE_BEGIN
        run_items(C + 12, 64 * 16, s_item, [&](int it) { attn_item64(p, it >> 4, it & 15, sm); });
        if (l == 0) run_items(C + 59, 64, s_item, [&](int it) { attn_item<0>(p, it, 0, sm); });
        run_items(C + 10, 64 * 5, s_item, [&](int it) { job_ml_carry(p, it); });
        run_items(C + 11, 16 * 9 * 4, s_item, [&](int it) {
            const int g = it / 36, r = it % 36, mt = r >> 2, nt = r & 3;
            const Seg sg[2] = {{p.ug + (size_t)g * NROWP * 1024, p.wg + (size_t)g * 1024 * 1024, 1024, 1024, 1024},
                               {p.sin_ + (size_t)g * NROWP * 256, p.eg + (size_t)g * 1024 * 256, 256, 256, 256}};
            EpiS5Y e; e.gs = p.gs; e.g = g;
            gemm_tile<128, 2, 256>(sg, nullptr, mt * 128, nt * 256, e, sm);
        });
        STAGE_END
        xcd_barrier(bar);
        DBG_CHECK(5)
        STAGE_BEGIN
        run_items(C + 13, NTOK / 128, s_item, [&](int mt) {
            EpiGlu e; e.gs = p.gs; e.bias = p.glu_b + l * 256; e.cat = p.cat; e.stg = sm + 6 * ASTAT_SLAB;
            gemm_astat<4>(p.gs, 256, nullptr, mt * 128, p.bt_glu, 256, 2, e, sm);
        });
        run_items(C + 14, NB * 4 * NCH / 2, s_item, [&](int it) { phase_ml_c(p, l, it, sm); });
        STAGE_END
        xcd_barrier(bar);
        DBG_CHECK(6)
        STAGE_BEGIN
        {
            g8::GridOrder S8; S8.A = (const char*)p.cat; S8.Bt = (const char*)p.bt_out; S8.K = 1024; S8.skipctx = (l == 1); S8.nM = S8.skipctx ? NB * 32 : NTOK / 256; S8.nN = 4; S8.nwg = S8.nM * S8.nN; S8.G = (int)gridDim.x; S8.c = (int)blockIdx.x;
            EpiBf16_8 e8; e8.C = p.z; e8.ldc = 1024;
            __syncthreads();
            g8::gemm_phase<false, true>((LAS unsigned char*)sm, 1024, S8, e8);
        }
        run_items(C + 63, CVT_EXPERT, s_item, [&](int it) { job_cvt_expert(p, l, it, sm); });
        STAGE_END
        xcd_barrier(bar);
        DBG_CHECK(7)
        STAGE_BEGIN
        phase_post_mixer<0>(p, l, 0);
        STAGE_END
        xcd_barrier(bar);
        DBG_CHECK(8)
        STAGE_BEGIN
        run_items(C + 17, l == 1 ? NB * 32 : NTOK / 256, s_item, [&](int it0) {
            const int it = (l == 1) ? (it0 >> 5) * 33 + 1 + (it0 & 31) : it0;
            const Seg sg[2] = {{p.h, p.bt_rhi, 1024, 1024, 1024}, {p.cat, p.bt_rhi, 1024, 1024, 1024}};
            EpiRouterSum e; e.C = p.logits; e.stg = sm;
            gemm_tile<256, 2>(sg, nullptr, it * 256, 0, e, sm);
        });
        STAGE_END
        xcd_barrier(bar);
        DBG_CHECK(9)
        STAGE_BEGIN
        phase_route(p, l, 0, sm);
        run_items(C + 19, (NB * MOE_SLOTS / 4 + 2047) / 2048, s_item, [&](int it) {
            const u32x4 zz = {0u, 0u, 0u, 0u};
            for (int k = 0; k < 4; ++k) { const int idx = it * 2048 + k * 512 + otid(); if (idx < NB * MOE_SLOTS / 4) { ((u32x4*)p.slottok)[idx] = zz; ((u32x4*)p.slotgate)[idx] = zz; } }
        });
        STAGE_END
        xcd_barrier(bar);
        DBG_CHECK(10)
        STAGE_BEGIN
        run_items(C + 20, NB, s_item, [&](int it) { job_tiles(p, l, it, s_int); });
        job_slots(p, l, 0, s_int);
        STAGE_END
        xcd_barrier(bar);
        DBG_CHECK(11)
        for (int sgi = 0; sgi < NB + 2; ++sgi) {
            STAGE_BEGIN
            if (sgi < NB) {
                const int b = sgi;
                UpOrder S8; S8.A = (const char*)p.h; S8.Bt = (const char*)p.bt_up; S8.slottok = p.slottok + (size_t)b * MOE_SLOTS; S8.ue = p.up_e + b * UPU_STRIDE; S8.ur = p.up_row + b * UPU_STRIDE;
                S8.nu2 = 2 * p.up_n[b]; S8.G = (int)gridDim.x; S8.c = (int)blockIdx.x;
                EpiUp8 e8; e8.slotgate = p.slotgate + (size_t)b * MOE_SLOTS; e8.hc = (b & 1) ? p.hc1 : p.hc;
                __syncthreads();
                g8::gemm_phase<true>((LAS unsigned char*)sm, 1024, S8, e8);
            }
            if (sgi >= 2) { const int b = sgi - 2; const bf16* yb = (b & 1) ? p.yc1 : p.yc; phase_combine(p, l, b, 0, yb, sm); }
            if (l == 0 && sgi == NB + 1) {
                run_items(C + 64 + 0, CVT_SMALL, s_item, [&](int it) { job_cvt_small(p, 1, it, sm); });
                run_items(C + 64 + 1, 1024, s_item, [&](int it) { job_s5_expand(p, 1, it); });
            }
            if (sgi >= 1 && sgi <= NB) {
                const int b = sgi - 1;
                const bf16* hb = (b & 1) ? p.hc1 : p.hc; bf16* yb = (b & 1) ? p.yc1 : p.yc;
                run_items_xcd(p.ctr + 256 + ((l * 8 + b) * 2 + 1) * 8, p.xl_cnt + b * 8, 1, (int)(bar.x & 7u), s_item, [&](int x, int it) {
                    const int t = p.xl_tile[(size_t)(b * 8 + x) * XL_STRIDE + it], ex = p.tile_e[b * MOE_TILES + t];
                    gemm_astat256<4, true>(hb, 256, t * 128, p.bt_dn + (size_t)ex * 1024 * 256, 256, 4, yb, 1024, sm);
                });
            }
            STAGE_END
            xcd_barrier(bar);
        }
        DBG_CHECK(12)
    }
#if DBG_STOP
    {
        const Params& p = fresh_params();
        const size_t T = NTOK;
        if (DBG_STOP == 1) { dbg_scan(p, p.h, T, 2048, 0, 2048, true); dbg_scan(p, p.bt_in, NINP, 2048, 0, 2048, true); dbg_scan(p, p.bt_up, 65 * 512, 2048, 0, 2048, true); dbg_scan(p, p.bt_dn, 65 * 1024, 512, 0, 512, true);
                             dbg_scan(p, p.wg, 16 * 1024, 2048, 0, 2048, true); dbg_scan(p, p.eg, 16 * 1024, 512, 0, 512, true); dbg_scan(p, p.gg, 16 * 256, 2048, 0, 2048, true); dbg_scan(p, p.modv, 18, 6144 * 4, 0, 6144 * 4, false); }
        if (DBG_STOP == 2) { dbg_scan(p, p.z, T, ZW * 2, 0, ZW * 2, true); dbg_scan(p, p.gates, T, 64, 0, 64, false); for (int g = 0; g < 16; ++g) dbg_scan(p, p.ug + (size_t)g * NROWP * 1024, NROW, 2048, 0, 2048, true); }
        if (DBG_STOP == 3) { for (int g = 0; g < 16; ++g) dbg_scan(p, p.ff + (size_t)g * NROWP * 256, NROW, 1024, 0, 1024, false); dbg_scan(p, p.qkc, T, 1024, 0, 1024, true); dbg_scan(p, p.rq, 1, T * 4, 0, T * 4, false); dbg_scan(p, p.rkv, 1, T * 4, 0, T * 4, false); dbg_scan(p, p.kf, T * 8, 192, 128, 192, true); }
        if (DBG_STOP == 4) { dbg_scan(p, p.cloc, (size_t)NUNIT * 65, 128, 0, 64, true, 0); dbg_scan(p, p.cloc, (size_t)NUNIT * 65, 128, 64, 128, true, 1);
                             dbg_scan(p, p.cloc, NUNIT, CLOC_STRIDE * 2, 0, 4096, true, 2); dbg_scan(p, p.cloc, NUNIT, CLOC_STRIDE * 2, 4096, 8192, true, 3); dbg_scan(p, p.cloc, NUNIT, CLOC_STRIDE * 2, 8192, 8320, true, 4); }
        if (DBG_STOP == 5) { dbg_scan(p, p.cloc, NUNIT, CLOC_STRIDE * 2, 0, CLOC_STRIDE * 2, true); dbg_scan(p, p.gs, T, 512, 0, 512, true); dbg_scan(p, p.cat, T, 2048, 512, 1536, true); }
        if (DBG_STOP == 6) {
            dbg_scan(p, p.z, T, ZW * 2, 0, ZW * 2, true, 0); dbg_scan(p, p.gates, T, 64, 0, 64, false, 0); for (int g = 0; g < 16; ++g) dbg_scan(p, p.ug + (size_t)g * NROWP * 1024, NROW, 2048, 0, 2048, true, 0);
            dbg_scan(p, p.qkc, T, 1024, 0, 1024, true, 0); dbg_scan(p, p.rq, 1, T * 4, 0, T * 4, false, 0); dbg_scan(p, p.rkv, 1, T * 4, 0, T * 4, false, 0);
            for (int g = 0; g < 16; ++g) { dbg_scan(p, p.ff + (size_t)g * NROWP * 256, NROW, 1024, 0, 1024, false, 1); dbg_scan(p, p.sin_ + (size_t)g * NROWP * 256, NROW, 512, 0, 512, true, 1); }
            dbg_scan(p, p.gs, T, 512, 0, 512, true, 1); dbg_scan(p, p.cat, T, 2048, 0, 512, true, 1);
            dbg_scan(p, p.q, T * 8, 192, 0, 192, true, 2); dbg_scan(p, p.kf, T * 8, 192, 0, 192, true, 2); dbg_scan(p, p.vt, (size_t)NB * 8 * 64, SQ * 2, 0, SQ * 2, true, 2);
            dbg_scan(p, p.cat, T, 2048, 512, 1536, true, 3);
            dbg_scan(p, p.cloc, NUNIT, CLOC_STRIDE * 2, 0, CLOC_STRIDE * 2, true, 4); dbg_scan(p, p.cat, T, 2048, 1536, 2048, true, 4);
        }
        if (DBG_STOP == 7) { dbg_scan(p, p.z, T, 2048, 0, 2048, true); }
        if (DBG_STOP == 8) { dbg_scan(p, p.out, (size_t)NB * SEQL, 4096, 0, 4096, false); dbg_scan(p, p.ctxres, NB * CTXL, 4096, 0, 4096, false); dbg_scan(p, p.h, T, 2048, 0, 2048, true); dbg_scan(p, p.cat, T, 2048, 0, 2048, true); }
        if (DBG_STOP == 9) { dbg_scan(p, p.logits, T, 256, 0, 256, false); }
        if (DBG_STOP == 10) { dbg_scan(p, p.tope, T, 32, 0, 32, false); dbg_scan(p, p.gatew, T, 32, 0, 32, false); }
        if (DBG_STOP == 12) { dbg_scan(p, p.out, (size_t)NB * SEQL, 4096, 0, 4096, false); dbg_scan(p, p.ctxres, NB * CTXL, 4096, 0, 4096, false); }
        xcd_barrier(bar);
        const unsigned cs = __hip_atomic_load(&p.ctr[250], __ATOMIC_RELAXED, __HIP_MEMORY_SCOPE_AGENT), nf = __hip_atomic_load(&p.ctr[251], __ATOMIC_RELAXED, __HIP_MEMORY_SCOPE_AGENT);
        const float code = (DBG_STOP == 6 || DBG_STOP == 4) ? 1.f + (float)nf : 1.f + (nf ? 4.f : 0.f) + (float)((cs >> 3) & 3u);
        const f32x4 cv = {code, code, code, code};
        for (size_t i = (size_t)blockIdx.x * 512 + threadIdx.x; i < (size_t)NB * SEQL * DM / 4; i += (size_t)gridDim.x * 512) ((f32x4*)p.out)[i] = cv;
    }
#endif
}

static inline size_t al256(size_t x) { return (x + 255) & ~(size_t)255; }

extern "C" void kernel_launch(void* const* d_in, const int* in_sizes, int n_in, void* d_out, int out_size, void* d_ws, size_t ws_size, hipStream_t stream) {
    (void)in_sizes; (void)n_in; (void)out_size;
    Params p; memset(&p, 0, sizeof(p));
    const float* const* in = (const float* const*)d_in;
    p.x = in[0]; p.c = in[1]; p.ctx = in[2]; p.c_ctx = in[3]; p.ada_w = in[4]; p.ada_b = in[5]; p.w_in = in[6];
    p.lam_re = in[7]; p.lam_im = in[8]; p.log_step = in[9]; p.b_re = in[10]; p.b_im = in[11]; p.c_re = in[12]; p.c_im = in[13];
    p.s5_d = in[14]; p.glu_w = in[15]; p.glu_b = in[16]; p.q_norm = in[17]; p.w_q_up = in[18]; p.kv_norm = in[19]; p.w_kv_up = in[20];
    p.conv_w = in[21]; p.conv_b = in[22]; p.gate_b = in[23]; p.ml_norm_g = in[24]; p.w_out = in[25]; p.ln1_g = in[26]; p.ln1_b = in[27];
    p.ln2_g = in[28]; p.ln2_b = in[29]; p.router_w = in[30]; p.router_bias = in[31]; p.ew_gate = in[32]; p.ew_up = in[33]; p.ew_down = in[34];
    p.sw_gate = in[35]; p.sw_up = in[36]; p.sw_down = in[37];
    p.out = (float*)d_out;

    char* ws = (char*)d_ws; size_t off = 0;
    auto take = [&](size_t bytes) { char* r = ws + off; off += al256(bytes); return r; };
    const size_t zero_bytes = al256(XCD_BAR_WORDS * 4) + al256(NCTR * 4) + al256(2 * 8 * 64 * 4);
    p.bar = (unsigned*)take(XCD_BAR_WORDS * 4); p.ctr = (unsigned*)take(NCTR * 4); p.moe_cnt = (int*)take(2 * 8 * 64 * 4);
    p.modv = (float*)take((size_t)2 * 9 * 6144 * 4); p.rope_tab = (float*)take(1024 * 2 * 4);
    p.klag = (float*)take((size_t)64 * 16384 * 4); p.pw = (float*)take((size_t)64 * 64 * 65 * 8); p.bbar = (float*)take((size_t)64 * 1024 * 8);
    p.ctxres = (float*)take((size_t)NB * CTXL * DM * 4); p.gates = (float*)take((size_t)NTOK * 16 * 4);
    p.rq = (float*)take((size_t)NTOK * 4); p.rkv = (float*)take((size_t)NTOK * 4); p.mlstat = (float*)take((size_t)NUNIT * 4 * 4);
    p.bt_in = (bf16*)take((size_t)NINP * 1024 * 2); p.bt_q = (bf16*)take((size_t)768 * 256 * 2); p.bt_kv = (bf16*)take((size_t)1024 * 128 * 2);
    p.bt_glu = (bf16*)take((size_t)256 * 256 * 2); p.bt_out = (bf16*)take((size_t)1024 * 1024 * 2);
    p.bt_rhi = (bf16*)take((size_t)128 * 1024 * 2); p.bt_rlo = p.bt_rhi + (size_t)64 * 1024;
    p.bt_up = (bf16*)take((size_t)65 * 512 * 1024 * 2); p.bt_dn = (bf16*)take((size_t)65 * 1024 * 256 * 2);
    p.wg = (bf16*)take((size_t)16 * 1024 * 1024 * 2); p.eg = (bf16*)take((size_t)16 * 1024 * 256 * 2); p.gg = (bf16*)take((size_t)16 * 256 * 1024 * 2);
    {
        const size_t qkc_b = al256((size_t)NTOK * 512 * 2), cloc_b = al256((size_t)NUNIT * CLOC_STRIDE * 2), h_b = al256((size_t)NTOK * DM * 2);
        const size_t reg = (qkc_b + cloc_b) > h_b ? (qkc_b + cloc_b) : h_b;
        char* r = take(reg); p.h = (bf16*)r; p.qkc = (bf16*)r; p.cloc = (bf16*)(r + qkc_b);
    }
    p.z = (bf16*)take((size_t)NTOK * ZW * 2);
    p.cat = (bf16*)take((size_t)NTOK * DM * 2);
    {
        const size_t ug_b = al256((size_t)16 * NROWP * 1024 * 2), sin_b = al256((size_t)16 * NROWP * 256 * 2), ff_b = al256((size_t)16 * NROWP * 256 * 4), gs_b = al256((size_t)NTOK * 256 * 2);
        const size_t s5_total = ug_b + sin_b + ff_b + gs_b;
        const size_t lg_b = al256((size_t)NTOK * 64 * 4), t8_b = al256((size_t)NTOK * 8 * 4), sl_b = al256((size_t)NB * MOE_SLOTS * 4), te_b = al256((size_t)NB * MOE_TILES * 4), nt_b = al256(64), xl_b = al256((size_t)NB * 8 * XL_STRIDE * 4), xc_b = al256(NB * 8 * 4), uu_b = al256((size_t)NB * UPU_STRIDE * 4);
        const size_t rt_total = lg_b + 4 * t8_b + 2 * sl_b + te_b + nt_b + xl_b + xc_b + 2 * uu_b + 256;
        char* r = take(s5_total > rt_total ? s5_total : rt_total);
        p.ug = (bf16*)r; p.sin_ = (bf16*)(r + ug_b); p.ff = (float*)(r + ug_b + sin_b); p.gs = (bf16*)(r + ug_b + sin_b + ff_b);
        char* q = r;
        p.logits = (float*)q; q += lg_b; p.tope = (int*)q; q += t8_b; p.pos = (int*)q; q += t8_b; p.tokslot = (int*)q; q += t8_b; p.gatew = (float*)q; q += t8_b;
        p.slottok = (int*)q; q += sl_b; p.slotgate = (float*)q; q += sl_b; p.tile_e = (int*)q; q += te_b; p.ntb = (int*)q; q += nt_b; p.xl_tile = (int*)q; q += xl_b; p.xl_cnt = (int*)q; q += xc_b; p.up_e = (int*)q; q += uu_b; p.up_row = (int*)q; q += uu_b; p.up_n = (int*)q; q += 256;
    }
    {
        const size_t q_b = al256((size_t)NTOK * 768 * 2), kf_b = q_b, vt_b = al256((size_t)NTOK * 512 * 2);
        const size_t hc_b = al256((size_t)MOE_SLOTS * 256 * 2), yc_b = al256((size_t)MOE_SLOTS * 1024 * 2);
        const size_t a_total = q_b + kf_b + vt_b, m_total = hc_b + yc_b;
        char* r = take(a_total > m_total ? a_total : m_total);
        p.q = (bf16*)r; p.kf = (bf16*)(r + q_b); p.vt = (bf16*)(r + q_b + kf_b);
        p.yc = (bf16*)r;
        p.yc1 = p.z; p.hc = p.cat; p.hc1 = (bf16*)((char*)p.cat + hc_b);
        if (yc_b > al256((size_t)NTOK * ZW * 2) || 2 * hc_b > al256((size_t)NTOK * DM * 2) || yc_b > a_total) { fprintf(stderr, "MoE buffers do not fit\n"); return; }
    }
    if (off > ws_size) { fprintf(stderr, "workspace too small: need %zu have %zu\n", off, ws_size); return; }

    static int configured = 0;
    if (!configured) { hipFuncSetAttribute((const void*)mega_kernel, hipFuncAttributeMaxDynamicSharedMemorySize, SMEM_BYTES); configured = 1; }
    int dev = 0, cus = 0; hipGetDevice(&dev); hipDeviceGetAttribute(&cus, hipDeviceAttributeMultiprocessorCount, dev);
    if (cus <= 0) cus = 256;
    hipMemsetAsync(d_ws, 0, zero_bytes, stream);
    hipLaunchKernelGGL(mega_kernel, dim3(cus), dim3(512), SMEM_BYTES, stream, p);
}
```
